# Optimizing an MI355X kernel written in HIP

```python
import jax
import jax.numpy as jnp
from jax import lax
import numpy as np

D_MODEL = 1024
BATCH = 2
SEQ = 16384
DEPTH = 2

HEAD_DIM = 64
ROPE_THETA = 10000.0
NORM_EPS = 1e-6

MOBA_HEADS = 8
MOBA_BLOCK = 256
MOBA_TOPK = 3
MOBA_Q_CHUNK = 128
MOBA_WIDTH = MOBA_HEADS * HEAD_DIM
RET_HEADS = 4
RET_QK_DIM = 64
RET_V_DIM = 128
RET_CHUNK = 128
RET_THETA = 10000.0
RET_QK_WIDTH = RET_HEADS * RET_QK_DIM
RET_V_WIDTH = RET_HEADS * RET_V_DIM
EVEN_IN_WIDTH = 3 * MOBA_WIDTH + 2 * RET_QK_WIDTH + 2 * RET_V_WIDTH
EVEN_MIX_WIDTH = MOBA_WIDTH + RET_V_WIDTH

DIL_HEADS = D_MODEL // HEAD_DIM
DIL_PATTERNS = ((128, 1), (512, 4), (2048, 16))
DIL_BLOCK = 128
ODD_IN_WIDTH = 3 * DIL_HEADS * HEAD_DIM
ODD_MIX_WIDTH = DIL_HEADS * HEAD_DIM

MOE_GROUPS = 4
MOE_EXPERTS_PER_GROUP = 8
MOE_EXPERTS = MOE_GROUPS * MOE_EXPERTS_PER_GROUP
MOE_TOPK = 2
MOE_HIDDEN = D_MODEL // 2
MOE_ROW_BLOCK = 128

kernel_name = 'hybrid_moba_retnet_dilated_hmoe'


def rms_norm(x, gain):
    xf = x.astype(jnp.float32)
    y = xf * lax.rsqrt(jnp.mean(xf * xf, axis=-1, keepdims=True) + NORM_EPS)
    return (y * gain.astype(jnp.float32)).astype(x.dtype)


def split_heads(t, n_heads):
    b, s, _ = t.shape
    return t.reshape(b, s, n_heads, -1).transpose(0, 2, 1, 3)


def merge_heads(t):
    b, h, s, d = t.shape
    return t.transpose(0, 2, 1, 3).reshape(b, s, h * d)


def rotary(x):
    s, dh = x.shape[2], x.shape[3]
    half = dh // 2
    inv_freq = 1.0 / (ROPE_THETA ** (jnp.arange(half, dtype=jnp.float32) * (2.0 / dh)))
    ang = jnp.arange(s, dtype=jnp.float32)[:, None] * inv_freq[None, :]
    cos, sin = jnp.cos(ang), jnp.sin(ang)
    xf = x.astype(jnp.float32)
    x1, x2 = xf[..., :half], xf[..., half:]
    return jnp.concatenate([x1 * cos - x2 * sin, x1 * sin + x2 * cos], axis=-1).astype(x.dtype)


def retnet_rotation(x):
    s, dk = x.shape[2], x.shape[3]
    half = dk // 2
    freq = 1.0 / (RET_THETA ** jnp.linspace(0.0, 1.0, half, dtype=jnp.float32))
    ang = jnp.arange(s, dtype=jnp.float32)[:, None] * freq[None, :]
    cos, sin = jnp.cos(ang), jnp.sin(ang)
    xf = x.astype(jnp.float32).reshape(x.shape[:-1] + (half, 2))
    xe, xo = xf[..., 0], xf[..., 1]
    out = jnp.stack([xe * cos - xo * sin, xe * sin + xo * cos], axis=-1)
    return out.reshape(x.shape).astype(x.dtype)


def moba_attention(q, k, v):
    b, h, s, dh = q.shape
    n_blk = -(-s // MOBA_BLOCK)
    sp = n_blk * MOBA_BLOCK
    pad = ((0, 0), (0, 0), (0, sp - s), (0, 0))
    q, k, v = jnp.pad(q, pad), jnp.pad(k, pad), jnp.pad(v, pad)
    scale = dh ** -0.5
    k_blocks = k.reshape(b, h, n_blk, MOBA_BLOCK, dh)
    v_blocks = v.reshape(b, h, n_blk, MOBA_BLOCK, dh)
    k_mean = k_blocks.astype(jnp.float32).mean(axis=3).astype(q.dtype)
    gate = jnp.einsum('bhsd,bhnd->bhsn', q, k_mean).astype(jnp.float32)
    q_blk = jnp.arange(sp) // MOBA_BLOCK
    fully_past = jnp.arange(n_blk)[None, :] < q_blk[:, None]
    gate = jnp.where(fully_past, gate, -jnp.inf)
    n_sel = min(MOBA_TOPK, n_blk)
    _, sel = lax.top_k(gate, n_sel)
    sel_ok = sel < q_blk[:, None]
    bi = jnp.arange(b)[:, None, None, None]
    hi = jnp.arange(h)[None, :, None, None]
    n_chunk = sp // MOBA_Q_CHUNK

    def chunk(c):
        q0 = c * MOBA_Q_CHUNK
        blk = q0 // MOBA_BLOCK
        qc = lax.dynamic_slice_in_dim(q, q0, MOBA_Q_CHUNK, axis=2)
        k_own = lax.dynamic_slice_in_dim(k, blk * MOBA_BLOCK, MOBA_BLOCK, axis=2)
        v_own = lax.dynamic_slice_in_dim(v, blk * MOBA_BLOCK, MOBA_BLOCK, axis=2)
        sel_c = lax.dynamic_slice_in_dim(sel, q0, MOBA_Q_CHUNK, axis=2)
        ok_c = lax.dynamic_slice_in_dim(sel_ok, q0, MOBA_Q_CHUNK, axis=2)
        k_sel = k_blocks[bi, hi, sel_c]
        v_sel = v_blocks[bi, hi, sel_c]
        qpos = q0 + jnp.arange(MOBA_Q_CHUNK)
        kpos = blk * MOBA_BLOCK + jnp.arange(MOBA_BLOCK)
        s_own = jnp.einsum('bhqd,bhkd->bhqk', qc, k_own).astype(jnp.float32) * scale
        s_own = jnp.where(kpos[None, :] <= qpos[:, None], s_own, -jnp.inf)
        s_sel = jnp.einsum('bhqd,bhqnkd->bhqnk', qc, k_sel).astype(jnp.float32) * scale
        s_sel = jnp.where(ok_c[..., None], s_sel, -jnp.inf)
        s_all = jnp.concatenate([s_own, s_sel.reshape(b, h, MOBA_Q_CHUNK, n_sel * MOBA_BLOCK)], axis=-1)
        p = jax.nn.softmax(s_all, axis=-1).astype(v.dtype)
        p_own = p[..., :MOBA_BLOCK]
        p_sel = p[..., MOBA_BLOCK:].reshape(b, h, MOBA_Q_CHUNK, n_sel, MOBA_BLOCK)
        return (jnp.einsum('bhqk,bhkd->bhqd', p_own, v_own)
                + jnp.einsum('bhqnk,bhqnkd->bhqd', p_sel, v_sel))

    out = lax.map(chunk, jnp.arange(n_chunk))
    return out.transpose(1, 2, 0, 3, 4).reshape(b, h, sp, dh)[:, :, :s]


def retention(q, k, v):
    b, h, s, dk = q.shape
    dv = v.shape[-1]
    c = RET_CHUNK
    n = s // c
    log_gamma = jnp.log(1.0 - 2.0 ** (-5.0 - jnp.arange(h, dtype=jnp.float32)))
    qf = q.astype(jnp.float32).reshape(b, h, n, c, dk)
    kf = k.astype(jnp.float32).reshape(b, h, n, c, dk) * (dk ** -0.5)
    vf = v.astype(jnp.float32).reshape(b, h, n, c, dv)
    pos = jnp.arange(c, dtype=jnp.float32)
    rel = pos[:, None] - pos[None, :]
    decay = jnp.where(rel >= 0, jnp.exp(log_gamma[:, None, None] * jnp.maximum(rel, 0.0)), 0.0)
    scores = jnp.einsum('bhnid,bhnjd->bhnij', qf, kf) * decay[None, :, None]
    intra = jnp.einsum('bhnij,bhnje->bhnie', scores, vf)
    k_tail = kf * jnp.exp(log_gamma[:, None] * (c - 1.0 - pos))[None, :, None, :, None]
    chunk_state = jnp.einsum('bhnjd,bhnje->nbhde', k_tail, vf)
    gamma_c = jnp.exp(log_gamma * c)[None, :, None, None]

    def step(r, u):
        return gamma_c * r + u, r

    _, r_prev = lax.scan(step, jnp.zeros((b, h, dk, dv), jnp.float32), chunk_state)
    q_head = qf * jnp.exp(log_gamma[:, None] * (pos + 1.0))[None, :, None, :, None]
    inter = jnp.einsum('bhnid,nbhde->bhnie', q_head, r_prev)
    y = (intra + inter).reshape(b, h, s, dv)
    mu = jnp.mean(y, axis=-1, keepdims=True)
    var = jnp.mean(jnp.square(y - mu), axis=-1, keepdims=True)
    return ((y - mu) * lax.rsqrt(var + NORM_EPS)).astype(v.dtype)


def dilated_branch(q, k, v, window, dil):
    b, h, s, dh = q.shape
    w_d = window // dil
    blk = DIL_BLOCK
    n_blk = -(-s // (dil * blk))
    length = n_blk * blk
    sp = length * dil
    pad = ((0, 0), (0, 0), (0, sp - s), (0, 0))
    q, k, v = jnp.pad(q, pad), jnp.pad(k, pad), jnp.pad(v, pad)

    def decimate(t):
        return t.reshape(b, h, length, dil, dh).transpose(0, 1, 3, 2, 4).reshape(b, h, dil, n_blk, blk, dh)

    def with_prev(t):
        prev = jnp.concatenate([jnp.zeros_like(t[:, :, :, :1]), t[:, :, :, :-1]], axis=3)
        return jnp.concatenate([prev, t], axis=4)

    qd = decimate(q)
    kc = with_prev(decimate(k))
    vc = with_prev(decimate(v))
    a = jnp.arange(blk)[:, None]
    e = jnp.arange(2 * blk)[None, :]
    dist = blk + a - e
    band = (dist >= 0) & (dist <= w_d)
    not_before_start = (jnp.arange(n_blk)[:, None, None] > 0) | (e >= blk)[None]
    mask = band[None] & not_before_start
    sc = jnp.einsum('bhrnqd,bhrnkd->bhrnqk', qd, kc).astype(jnp.float32) * (dh ** -0.5)
    sc = jnp.where(mask, sc, -jnp.inf)
    m = jnp.max(sc, axis=-1, keepdims=True)
    p = jnp.exp(sc - m)
    den = jnp.sum(p, axis=-1, keepdims=True)
    o = jnp.einsum('bhrnqk,bhrnkd->bhrnqd', (p / den).astype(v.dtype), vc)
    lse = (m + jnp.log(den))[..., 0]
    o = o.reshape(b, h, dil, length, dh).transpose(0, 1, 3, 2, 4).reshape(b, h, sp, dh)[:, :, :s]
    lse = lse.reshape(b, h, dil, length).transpose(0, 1, 3, 2).reshape(b, h, sp)[:, :, :s]
    return o, lse


def dilated_mixture(q, k, v):
    branches = [dilated_branch(q, k, v, w, d) for (w, d) in DIL_PATTERNS]
    lses = jnp.stack([l for (_, l) in branches], axis=0)
    wts = jax.nn.softmax(lses, axis=0)
    out = wts[0][..., None] * branches[0][0].astype(jnp.float32)
    for i in range(1, len(branches)):
        out = out + wts[i][..., None] * branches[i][0].astype(jnp.float32)
    return out.astype(q.dtype)


def even_mixer(h, w_in, w_out):
    proj = h @ w_in
    s1 = MOBA_WIDTH
    s2 = 2 * MOBA_WIDTH
    s3 = 3 * MOBA_WIDTH
    s4 = s3 + RET_QK_WIDTH
    s5 = s4 + RET_QK_WIDTH
    s6 = s5 + RET_V_WIDTH
    aq, ak, av, rq, rk, rv, rg = jnp.split(proj, [s1, s2, s3, s4, s5, s6], axis=-1)
    a_out = moba_attention(rotary(split_heads(aq, MOBA_HEADS)),
                           rotary(split_heads(ak, MOBA_HEADS)),
                           split_heads(av, MOBA_HEADS))
    r_out = retention(retnet_rotation(split_heads(rq, RET_HEADS)),
                      retnet_rotation(split_heads(rk, RET_HEADS)),
                      split_heads(rv, RET_HEADS))
    r_out = merge_heads(r_out) * jax.nn.silu(rg)
    return jnp.concatenate([merge_heads(a_out), r_out], axis=-1) @ w_out


def odd_mixer(h, w_in, w_out):
    q, k, v = jnp.split(h @ w_in, 3, axis=-1)
    o = dilated_mixture(rotary(split_heads(q, DIL_HEADS)),
                        rotary(split_heads(k, DIL_HEADS)),
                        split_heads(v, DIL_HEADS))
    return merge_heads(o) @ w_out


def hier_moe(h, w_group, b_group, w_fine, b_fine, w_gate, w_up, w_down):
    b, s, d = h.shape
    n_tok = b * s
    x2 = h.reshape(n_tok, d)
    g_logits = (x2 @ w_group).astype(jnp.float32) + b_group.astype(jnp.float32)
    g_prob = jax.nn.softmax(g_logits, axis=-1)
    g_val, grp = lax.top_k(g_prob, 1)
    f_logits = ((x2 @ w_fine).astype(jnp.float32) + b_fine.astype(jnp.float32)).reshape(
        n_tok, MOE_GROUPS, MOE_EXPERTS_PER_GROUP)
    f_in_group = jnp.take_along_axis(f_logits, grp[:, :, None], axis=1)[:, 0]
    top_v, top_i = lax.top_k(f_in_group, MOE_TOPK)
    gates = g_val * jax.nn.softmax(top_v, axis=-1)
    expert = grp * MOE_EXPERTS_PER_GROUP + top_i
    n_assign = n_tok * MOE_TOPK
    e_flat = expert.reshape(-1)
    t_flat = jnp.repeat(jnp.arange(n_tok, dtype=jnp.int32), MOE_TOPK)
    g_flat = gates.reshape(-1)
    order = jnp.argsort(e_flat)
    e_s, t_s, g_s = e_flat[order], t_flat[order], g_flat[order]
    counts = jnp.bincount(e_flat, length=MOE_EXPERTS)
    starts = jnp.cumsum(counts) - counts
    padded = ((counts + MOE_ROW_BLOCK - 1) // MOE_ROW_BLOCK) * MOE_ROW_BLOCK
    p_ends = jnp.cumsum(padded)
    p_starts = p_ends - padded
    dest = p_starts[e_s] + (jnp.arange(n_assign) - starts[e_s])
    n_blocks = -(-n_assign // MOE_ROW_BLOCK) + MOE_EXPERTS
    n_rows = n_blocks * MOE_ROW_BLOCK
    row_tok = jnp.zeros((n_rows,), jnp.int32).at[dest].set(t_s)
    row_gate = jnp.zeros((n_rows,), jnp.float32).at[dest].set(g_s)
    blk_start = jnp.arange(n_blocks) * MOE_ROW_BLOCK
    blk_exp = jnp.minimum(jnp.searchsorted(p_ends, blk_start, side='right'), MOE_EXPERTS - 1)

    def expert_block(args):
        tok, e = args
        xb = x2[tok]
        hid = jax.nn.silu(xb @ w_gate[e]) * (xb @ w_up[e])
        return hid @ w_down[e]

    ys = lax.map(expert_block, (row_tok.reshape(n_blocks, MOE_ROW_BLOCK), blk_exp)).reshape(n_rows, d)
    out = jnp.zeros((n_tok, d), jnp.float32).at[row_tok].add(ys.astype(jnp.float32) * row_gate[:, None])
    return out.astype(h.dtype).reshape(b, s, d)


def setup_inputs(seed: int = 0) -> dict:
    key = jax.random.key(seed)
    ks = jax.random.split(key, 17)
    n_even = (DEPTH + 1) // 2
    n_odd = DEPTH // 2

    def dense(k, shape, fan_in):
        return jax.random.normal(k, shape, jnp.float32) * (fan_in ** -0.5)

    def gain(k, shape):
        return 1.0 + 0.02 * jax.random.normal(k, shape, jnp.float32)

    return {
        'x': jax.random.normal(ks[0], (BATCH, SEQ, D_MODEL), jnp.float32),
        'mix_norm_even': gain(ks[1], (n_even, D_MODEL)),
        'w_in_even': dense(ks[2], (n_even, D_MODEL, EVEN_IN_WIDTH), D_MODEL),
        'w_out_even': dense(ks[3], (n_even, EVEN_MIX_WIDTH, D_MODEL), EVEN_MIX_WIDTH),
        'mix_norm_odd': gain(ks[4], (n_odd, D_MODEL)),
        'w_in_odd': dense(ks[5], (n_odd, D_MODEL, ODD_IN_WIDTH), D_MODEL),
        'w_out_odd': dense(ks[6], (n_odd, ODD_MIX_WIDTH, D_MODEL), ODD_MIX_WIDTH),
        'ffn_norm': gain(ks[7], (DEPTH, D_MODEL)),
        'w_router_group': dense(ks[8], (DEPTH, D_MODEL, MOE_GROUPS), D_MODEL),
        'b_router_group': 0.01 * jax.random.normal(ks[9], (DEPTH, MOE_GROUPS), jnp.float32),
        'w_router_expert': dense(ks[10], (DEPTH, D_MODEL, MOE_EXPERTS), D_MODEL),
        'b_router_expert': 0.01 * jax.random.normal(ks[11], (DEPTH, MOE_EXPERTS), jnp.float32),
        'w_expert_gate': dense(ks[12], (DEPTH, MOE_EXPERTS, D_MODEL, MOE_HIDDEN), D_MODEL),
        'w_expert_up': dense(ks[13], (DEPTH, MOE_EXPERTS, D_MODEL, MOE_HIDDEN), D_MODEL),
        'w_expert_down': dense(ks[14], (DEPTH, MOE_EXPERTS, MOE_HIDDEN, D_MODEL), MOE_HIDDEN),
        'final_norm': gain(ks[15], (D_MODEL,)),
    }


def reference(x, mix_norm_even, w_in_even, w_out_even, mix_norm_odd, w_in_odd, w_out_odd,
              ffn_norm, w_router_group, b_router_group, w_router_expert, b_router_expert,
              w_expert_gate, w_expert_up, w_expert_down, final_norm):
    h = x
    for layer in range(DEPTH):
        i = layer // 2
        if layer % 2 == 0:
            h = h + even_mixer(rms_norm(h, mix_norm_even[i]), w_in_even[i], w_out_even[i])
        else:
            h = h + odd_mixer(rms_norm(h, mix_norm_odd[i]), w_in_odd[i], w_out_odd[i])
        h = h + hier_moe(rms_norm(h, ffn_norm[layer]), w_router_group[layer], b_router_group[layer],
                         w_router_expert[layer], b_router_expert[layer], w_expert_gate[layer],
                         w_expert_up[layer], w_expert_down[layer])
    return rms_norm(h, final_norm)
```

```cpp
#include <hip/hip_runtime.h>
#include <cstdio>
#include <cstdint>

typedef unsigned short bf16_t;
__device__ __forceinline__ float bf2f(bf16_t v) { return __uint_as_float(((unsigned)v) << 16); }
__device__ __forceinline__ bf16_t f2bf(float f) { unsigned u = __float_as_uint(f); return (bf16_t)((u + 0x7fffu + ((u >> 16) & 1u)) >> 16); }

constexpr int NB = 2, S = 16384, D = 1024, NTOK = NB * S;
constexpr int PW = 3072;
constexpr int NEXP = 32, HID = 512;
constexpr int MP_MAX = 2 * NTOK + NEXP * 256;
constexpr float EPS = 1e-6f;

constexpr size_t MiB = 1u << 20;
constexpr size_t WS_CTL = 0, CTL_BYTES = 2 * MiB;
constexpr size_t WS_ROT = 2 * MiB, WS_RET = 6 * MiB;
constexpr size_t WS_KMEAN = 10 * MiB;
constexpr size_t WS_TOKE = 12 * MiB, WS_TOKG = 13 * MiB, WS_POS = 14 * MiB;
constexpr size_t WS_RSTATE = 16 * MiB, WS_RPREV = 48 * MiB;
constexpr size_t WS_XN = 80 * MiB, WS_AO = 144 * MiB, WS_BIG = 208 * MiB, WS_HS = 416 * MiB, WS_END = 492 * MiB;
constexpr int CW_CNT = 0;
constexpr int CW_CUR = 64;
constexpr int CW_PST = 128;
constexpr int CW_NT = 256;
constexpr int CW_TEXP = 512;
constexpr int CW_ROWTOK = 4096;
constexpr int CW_ROWGATE = 4096 + 2 * MP_MAX;
static_assert((CW_ROWGATE + 2 * MP_MAX) * 4 <= (int)CTL_BYTES, "ctl");

__device__ __forceinline__ float wave_sum(float v) {
#pragma unroll
    for (int o = 32; o > 0; o >>= 1) v += __shfl_xor(v, o);
    return v;
}
__device__ __forceinline__ float silu(float x) { return x / (1.0f + __expf(-x)); }

__global__ void k_tables(float2* rot, float2* ret) {
    int i = blockIdx.x * blockDim.x + threadIdx.x;
    if (i >= S * 32) return;
    int pos = i >> 5, j = i & 31;
    float inv = 1.0f / powf(10000.0f, (float)j * (2.0f / 64.0f));
    float ang = (float)pos * inv;
    rot[i] = make_float2(cosf(ang), sinf(ang));
    float fr = 1.0f / powf(10000.0f, (float)j / 31.0f);
    float a2 = (float)pos * fr;
    ret[i] = make_float2(cosf(a2), sinf(a2));
}

__global__ void k_rmsnorm(const float* __restrict__ src, const float* __restrict__ gain, bf16_t* __restrict__ xn) {
    int row = (blockIdx.x * blockDim.x + threadIdx.x) >> 6, lane = threadIdx.x & 63;
    if (row >= NTOK) return;
    const float4* xr = (const float4*)(src + (size_t)row * D);
    float4 v[4]; float ss = 0.f;
#pragma unroll
    for (int j = 0; j < 4; ++j) { v[j] = xr[64 * j + lane]; ss += v[j].x * v[j].x + v[j].y * v[j].y + v[j].z * v[j].z + v[j].w * v[j].w; }
    ss = wave_sum(ss);
    float rstd = rsqrtf(ss * (1.0f / D) + EPS);
#pragma unroll
    for (int j = 0; j < 4; ++j) {
        float4 g = ((const float4*)gain)[64 * j + lane];
        ushort4 o; o.x = f2bf(v[j].x * rstd * g.x); o.y = f2bf(v[j].y * rstd * g.y); o.z = f2bf(v[j].z * rstd * g.z); o.w = f2bf(v[j].w * rstd * g.w);
        ((ushort4*)(xn + (size_t)row * D))[64 * j + lane] = o;
    }
}

struct GemmArgs {
    const bf16_t* A; const int* rowidx;
    const float* W; const float* W2;
    const int* tile_exp; const int* ntiles;
    size_t wstride;
    int lda, ldw, M, N, K, pad;
};
template <bool DUAL, class Epi>
__global__ void __launch_bounds__(256) k_gemm_naive(GemmArgs g, Epi epi) {
    __shared__ float As[16][65];
    __shared__ float Bs[16][64];
    __shared__ float Bs2[DUAL ? 16 : 1][64];
    const int tid = threadIdx.x, tx = tid & 15, ty = tid >> 4;
    const int row0 = blockIdx.y * 64, col0 = blockIdx.x * 64;
    const float* W = g.W; const float* W2 = g.W2;
    if (g.tile_exp) {
        if (row0 >= g.ntiles[0] * 256) return;
        int e = g.tile_exp[row0 >> 8];
        W += (size_t)e * g.wstride; if (DUAL) W2 += (size_t)e * g.wstride;
    }
    float acc[4][4] = {}, acc2[4][4] = {};
    const int ar = tid >> 2, ak = (tid & 3) * 4;
    int arow = row0 + ar; if (g.rowidx) arow = g.rowidx[arow];
    const bf16_t* ap = g.A + (size_t)arow * g.lda + ak;
    const int bk = tid >> 4, bc = (tid & 15) * 4;
    const int cc[4] = {2 * tx, 2 * tx + 1, 2 * tx + 32, 2 * tx + 33};
    for (int k0 = 0; k0 < g.K; k0 += 16) {
        ushort4 a4 = *(const ushort4*)(ap + k0);
        As[ak + 0][ar] = bf2f(a4.x); As[ak + 1][ar] = bf2f(a4.y); As[ak + 2][ar] = bf2f(a4.z); As[ak + 3][ar] = bf2f(a4.w);
        float4 b4 = *(const float4*)(W + (size_t)(k0 + bk) * g.ldw + col0 + bc);
        Bs[bk][bc] = b4.x; Bs[bk][bc + 1] = b4.y; Bs[bk][bc + 2] = b4.z; Bs[bk][bc + 3] = b4.w;
        if (DUAL) { float4 c4 = *(const float4*)(W2 + (size_t)(k0 + bk) * g.ldw + col0 + bc);
            Bs2[bk][bc] = c4.x; Bs2[bk][bc + 1] = c4.y; Bs2[bk][bc + 2] = c4.z; Bs2[bk][bc + 3] = c4.w; }
        __syncthreads();
#pragma unroll
        for (int k = 0; k < 16; ++k) {
            float a[4], b[4], b2[4];
#pragma unroll
            for (int i = 0; i < 4; ++i) a[i] = As[k][ty * 4 + i];
#pragma unroll
            for (int j = 0; j < 4; ++j) { b[j] = Bs[k][cc[j]]; if (DUAL) b2[j] = Bs2[k][cc[j]]; }
#pragma unroll
            for (int i = 0; i < 4; ++i)
#pragma unroll
                for (int j = 0; j < 4; ++j) { acc[i][j] += a[i] * b[j]; if (DUAL) acc2[i][j] += a[i] * b2[j]; }
        }
        __syncthreads();
    }
#pragma unroll
    for (int i = 0; i < 4; ++i) epi(row0 + ty * 4 + i, col0, tx, acc[i], acc2[i]);
}

struct EpiInproj {
    bf16_t* P; const float2* rot; const float2* ret; int mode, pad;
    __device__ void operator()(int row, int col0, int tx, float* v, float*) const {
        const int pos = row & (S - 1);
        float o[4] = {v[0], v[1], v[2], v[3]};
        int kind;
        if (mode == 0) kind = col0 < 1024 ? 1 : (col0 < 1536 ? 0 : (col0 < 1792 ? 2 : (col0 < 2048 ? 3 : 0)));
        else kind = col0 < 2048 ? 1 : 0;
        if (kind == 1) {
            float2 c0 = rot[pos * 32 + 2 * tx], c1 = rot[pos * 32 + 2 * tx + 1];
            o[0] = v[0] * c0.x - v[2] * c0.y; o[2] = v[0] * c0.y + v[2] * c0.x;
            o[1] = v[1] * c1.x - v[3] * c1.y; o[3] = v[1] * c1.y + v[3] * c1.x;
        } else if (kind >= 2) {
            float2 c0 = ret[pos * 32 + tx], c1 = ret[pos * 32 + tx + 16];
            o[0] = v[0] * c0.x - v[1] * c0.y; o[1] = v[0] * c0.y + v[1] * c0.x;
            o[2] = v[2] * c1.x - v[3] * c1.y; o[3] = v[2] * c1.y + v[3] * c1.x;
            if (kind == 3) { o[0] *= 0.125f; o[1] *= 0.125f; o[2] *= 0.125f; o[3] *= 0.125f; }
        }
        bf16_t* p = P + (size_t)row * PW + col0 + 2 * tx;
        *(ushort2*)p = make_ushort2(f2bf(o[0]), f2bf(o[1]));
        *(ushort2*)(p + 32) = make_ushort2(f2bf(o[2]), f2bf(o[3]));
    }
};
struct EpiOutproj {
    const float* res; float* hout;
    __device__ void operator()(int row, int col0, int tx, float* v, float*) const {
        size_t o = (size_t)row * D + col0 + 2 * tx;
        float2 r0 = *(const float2*)(res + o), r1 = *(const float2*)(res + o + 32);
        *(float2*)(hout + o) = make_float2(r0.x + v[0], r0.y + v[1]);
        *(float2*)(hout + o + 32) = make_float2(r1.x + v[2], r1.y + v[3]);
    }
};
struct EpiMoe1 {
    bf16_t* Hs;
    __device__ void operator()(int row, int col0, int tx, float* v, float* v2) const {
        bf16_t* p = Hs + (size_t)row * HID + col0 + 2 * tx;
        *(ushort2*)p = make_ushort2(f2bf(silu(v[0]) * v2[0]), f2bf(silu(v[1]) * v2[1]));
        *(ushort2*)(p + 32) = make_ushort2(f2bf(silu(v[2]) * v2[2]), f2bf(silu(v[3]) * v2[3]));
    }
};
struct EpiMoe2 {
    bf16_t* ys; const float* rowgate;
    __device__ void operator()(int row, int col0, int tx, float* v, float*) const {
        float gt = rowgate[row];
        bf16_t* p = ys + (size_t)row * D + col0 + 2 * tx;
        *(ushort2*)p = make_ushort2(f2bf(v[0] * gt), f2bf(v[1] * gt));
        *(ushort2*)(p + 32) = make_ushort2(f2bf(v[2] * gt), f2bf(v[3] * gt));
    }
};

__global__ void k_kmean(const bf16_t* __restrict__ P, float* __restrict__ kmean) {
    int i = blockIdx.x * blockDim.x + threadIdx.x;
    if (i >= NB * 8 * 64 * 64) return;
    int d = i & 63, n = (i >> 6) & 63, h = (i >> 12) & 7, b = i >> 15;
    float s = 0.f;
    const bf16_t* p = P + ((size_t)(b * S + n * 256)) * PW + 512 + h * 64 + d;
    for (int j = 0; j < 256; ++j) s += bf2f(p[(size_t)j * PW]);
    kmean[i] = s * (1.0f / 256.0f);
}
__device__ __forceinline__ void soft_key(float& m, float& l, float* o, const float* q, const bf16_t* kr, const bf16_t* vr, float scale) {
    float s = 0.f;
#pragma unroll
    for (int c = 0; c < 8; ++c) { uint4 u = ((const uint4*)kr)[c]; const unsigned w[4] = {u.x, u.y, u.z, u.w};
#pragma unroll
        for (int t = 0; t < 4; ++t) { s += q[c * 8 + 2 * t] * __uint_as_float(w[t] << 16) + q[c * 8 + 2 * t + 1] * __uint_as_float(w[t] & 0xffff0000u); } }
    s *= scale;
    float mn = fmaxf(m, s), al = __expf(m - mn), p = __expf(s - mn);
    l = l * al + p; m = mn;
#pragma unroll
    for (int c = 0; c < 8; ++c) { uint4 u = ((const uint4*)vr)[c]; const unsigned w[4] = {u.x, u.y, u.z, u.w};
#pragma unroll
        for (int t = 0; t < 4; ++t) { o[c * 8 + 2 * t] = o[c * 8 + 2 * t] * al + p * __uint_as_float(w[t] << 16); o[c * 8 + 2 * t + 1] = o[c * 8 + 2 * t + 1] * al + p * __uint_as_float(w[t] & 0xffff0000u); } }
}
__global__ void __launch_bounds__(256) k_moba_naive(const bf16_t* __restrict__ P, const float* __restrict__ kmean, bf16_t* __restrict__ AO) {
    int i = blockIdx.x * blockDim.x + threadIdx.x;
    if (i >= NB * 8 * S) return;
    int pos = i & (S - 1), h = (i >> 14) & 7, b = i >> 17;
    size_t tok = (size_t)b * S + pos;
    float q[64];
    { const bf16_t* qp = P + tok * PW + h * 64;
#pragma unroll
      for (int d = 0; d < 64; ++d) q[d] = bf2f(qp[d]); }
    int qb = pos >> 8;
    float bv[3] = {-INFINITY, -INFINITY, -INFINITY}; int bi[3] = {-1, -1, -1};
    const float* km = kmean + ((size_t)(b * 8 + h) * 64) * 64;
    for (int n = 0; n < qb; ++n) {
        float g = 0.f;
#pragma unroll
        for (int d = 0; d < 64; ++d) g += q[d] * km[n * 64 + d];
        if (g > bv[0]) { bv[2] = bv[1]; bi[2] = bi[1]; bv[1] = bv[0]; bi[1] = bi[0]; bv[0] = g; bi[0] = n; }
        else if (g > bv[1]) { bv[2] = bv[1]; bi[2] = bi[1]; bv[1] = g; bi[1] = n; }
        else if (g > bv[2]) { bv[2] = g; bi[2] = n; }
    }
    float m = -1e30f, l = 0.f, o[64];
#pragma unroll
    for (int d = 0; d < 64; ++d) o[d] = 0.f;
    const bf16_t* Kb = P + ((size_t)b * S) * PW + 512 + h * 64;
    const bf16_t* Vb = P + ((size_t)b * S) * PW + 1024 + h * 64;
    for (int key = qb * 256; key <= pos; ++key) soft_key(m, l, o, q, Kb + (size_t)key * PW, Vb + (size_t)key * PW, 0.125f);
    for (int s3 = 0; s3 < 3; ++s3) {
        if (bi[s3] < 0) continue;
        int k0 = bi[s3] * 256;
        for (int key = k0; key < k0 + 256; ++key) soft_key(m, l, o, q, Kb + (size_t)key * PW, Vb + (size_t)key * PW, 0.125f);
    }
    float il = 1.0f / l;
    bf16_t* op = AO + tok * D + h * 64;
#pragma unroll
    for (int d = 0; d < 64; ++d) op[d] = f2bf(o[d] * il);
}

__global__ void __launch_bounds__(256) k_dilated_naive(const bf16_t* __restrict__ P, bf16_t* __restrict__ AO) {
    int i = blockIdx.x * blockDim.x + threadIdx.x;
    if (i >= NB * 16 * S) return;
    int pos = i & (S - 1), h = (i >> 14) & 15, b = i >> 18;
    size_t tok = (size_t)b * S + pos;
    float q[64];
    { const bf16_t* qp = P + tok * PW + h * 64;
#pragma unroll
      for (int d = 0; d < 64; ++d) q[d] = bf2f(qp[d]); }
    float m = -1e30f, l = 0.f, o[64];
#pragma unroll
    for (int d = 0; d < 64; ++d) o[d] = 0.f;
    const bf16_t* Kb = P + ((size_t)b * S) * PW + 1024 + h * 64;
    const bf16_t* Vb = P + ((size_t)b * S) * PW + 2048 + h * 64;
    for (int br = 0; br < 3; ++br) {
        int dil = br == 0 ? 1 : (br == 1 ? 4 : 16);
        for (int t = 0; t <= 128; ++t) {
            int key = pos - t * dil; if (key < 0) break;
            soft_key(m, l, o, q, Kb + (size_t)key * PW, Vb + (size_t)key * PW, 0.125f);
        }
    }
    float il = 1.0f / l;
    bf16_t* op = AO + tok * D + h * 64;
#pragma unroll
    for (int d = 0; d < 64; ++d) op[d] = f2bf(o[d] * il);
}

__device__ __forceinline__ float ret_loggamma(int h) { return logf(1.0f - exp2f(-5.0f - (float)h)); }
__global__ void k_ret_state(const bf16_t* __restrict__ P, float* __restrict__ state) {
    size_t i = (size_t)blockIdx.x * blockDim.x + threadIdx.x;
    if (i >= (size_t)NB * 4 * 128 * 64 * 128) return;
    int e = i & 127, d = (i >> 7) & 63, n = (i >> 13) & 127, h = (i >> 20) & 3, b = (int)(i >> 22);
    float lg = ret_loggamma(h);
    const bf16_t* kp = P + ((size_t)(b * S + n * 128)) * PW + 1792 + h * 64 + d;
    const bf16_t* vp = P + ((size_t)(b * S + n * 128)) * PW + 2048 + h * 128 + e;
    float s = 0.f;
    for (int j = 0; j < 128; ++j) s += bf2f(kp[(size_t)j * PW]) * __expf(lg * (float)(127 - j)) * bf2f(vp[(size_t)j * PW]);
    state[i] = s;
}
__global__ void k_ret_scan(const float* __restrict__ state, float* __restrict__ rprev) {
    int i = blockIdx.x * blockDim.x + threadIdx.x;
    if (i >= NB * 4 * 8192) return;
    int de = i & 8191, bh = i >> 13, h = bh & 3;
    float gc = __expf(ret_loggamma(h) * 128.0f), r = 0.f;
    for (int n = 0; n < 128; ++n) { size_t o = ((size_t)bh * 128 + n) * 8192 + de; rprev[o] = r; r = gc * r + state[o]; }
}
__global__ void __launch_bounds__(256) k_ret_out(const bf16_t* __restrict__ P, const float* __restrict__ rprev, bf16_t* __restrict__ AO) {
    int t = blockIdx.x * blockDim.x + threadIdx.x;
    if (t >= NTOK * 16) return;
    int qt = t & 3, h = (t >> 2) & 3, tok = t >> 4, b = tok >> 14, pos = tok & (S - 1), ii = pos & 127, n = pos >> 7;
    float lg = ret_loggamma(h);
    float q[64];
    { const bf16_t* qp = P + (size_t)tok * PW + 1536 + h * 64;
#pragma unroll
      for (int d = 0; d < 64; ++d) q[d] = bf2f(qp[d]); }
    float acc[32];
#pragma unroll
    for (int e = 0; e < 32; ++e) acc[e] = 0.f;
    const float* rp = rprev + ((size_t)(b * 4 + h) * 128 + n) * 8192 + qt * 32;
    { const bf16_t* qp = P + (size_t)tok * PW + 1536 + h * 64;
      for (int d = 0; d < 64; ++d) { float qd = bf2f(qp[d]);
#pragma unroll
        for (int e = 0; e < 32; ++e) acc[e] += qd * rp[d * 128 + e]; } }
    float sc = __expf(lg * (float)(ii + 1));
#pragma unroll
    for (int e = 0; e < 32; ++e) acc[e] *= sc;
    const bf16_t* Kb = P + (size_t)(tok - ii) * PW + 1792 + h * 64;
    const bf16_t* Vb = P + (size_t)(tok - ii) * PW + 2048 + h * 128 + qt * 32;
    for (int j = 0; j <= ii; ++j) {
        const bf16_t* kr = Kb + (size_t)j * PW; float s = 0.f;
#pragma unroll
        for (int d = 0; d < 64; ++d) s += q[d] * bf2f(kr[d]);
        s *= __expf(lg * (float)(ii - j));
        const bf16_t* vr = Vb + (size_t)j * PW;
#pragma unroll
        for (int e = 0; e < 32; ++e) acc[e] += s * bf2f(vr[e]);
    }
    float sum = 0.f;
#pragma unroll
    for (int e = 0; e < 32; ++e) sum += acc[e];
    sum += __shfl_xor(sum, 1); sum += __shfl_xor(sum, 2);
    float mu = sum * (1.0f / 128.0f), sq = 0.f;
#pragma unroll
    for (int e = 0; e < 32; ++e) { float dlt = acc[e] - mu; sq += dlt * dlt; }
    sq += __shfl_xor(sq, 1); sq += __shfl_xor(sq, 2);
    float rs = rsqrtf(sq * (1.0f / 128.0f) + EPS);
    const bf16_t* gp = P + (size_t)tok * PW + 2560 + h * 128 + qt * 32;
    bf16_t* op = AO + (size_t)tok * D + 512 + h * 128 + qt * 32;
#pragma unroll
    for (int e = 0; e < 32; ++e) op[e] = f2bf((acc[e] - mu) * rs * silu(bf2f(gp[e])));
}

__global__ void __launch_bounds__(256) k_router(const float* __restrict__ h, const float* __restrict__ gain, const float* __restrict__ wg, const float* __restrict__ bg,
                                               const float* __restrict__ wf, const float* __restrict__ bfine, bf16_t* __restrict__ xn, int2* __restrict__ toke, float2* __restrict__ tokg, unsigned* __restrict__ cnt) {
    int row = (blockIdx.x * blockDim.x + threadIdx.x) >> 6, lane = threadIdx.x & 63;
    if (row >= NTOK) return;
    const float4* xr = (const float4*)(h + (size_t)row * D);
    float4 v[4]; float ss = 0.f;
#pragma unroll
    for (int j = 0; j < 4; ++j) { v[j] = xr[64 * j + lane]; ss += v[j].x * v[j].x + v[j].y * v[j].y + v[j].z * v[j].z + v[j].w * v[j].w; }
    ss = wave_sum(ss);
    float rstd = rsqrtf(ss * (1.0f / D) + EPS);
    float xv[16];
#pragma unroll
    for (int j = 0; j < 4; ++j) {
        float4 g = ((const float4*)gain)[64 * j + lane];
        xv[4 * j] = v[j].x * rstd * g.x; xv[4 * j + 1] = v[j].y * rstd * g.y; xv[4 * j + 2] = v[j].z * rstd * g.z; xv[4 * j + 3] = v[j].w * rstd * g.w;
        ushort4 o; o.x = f2bf(xv[4 * j]); o.y = f2bf(xv[4 * j + 1]); o.z = f2bf(xv[4 * j + 2]); o.w = f2bf(xv[4 * j + 3]);
        ((ushort4*)(xn + (size_t)row * D))[64 * j + lane] = o;
    }
    float gl[4] = {0.f, 0.f, 0.f, 0.f};
#pragma unroll
    for (int j = 0; j < 4; ++j)
#pragma unroll
        for (int c = 0; c < 4; ++c) { int k = (64 * j + lane) * 4 + c; float4 w = ((const float4*)wg)[k];
            gl[0] += xv[4 * j + c] * w.x; gl[1] += xv[4 * j + c] * w.y; gl[2] += xv[4 * j + c] * w.z; gl[3] += xv[4 * j + c] * w.w; }
#pragma unroll
    for (int c = 0; c < 4; ++c) gl[c] = wave_sum(gl[c]) + bg[c];
    int grp = 0; float gm = gl[0];
#pragma unroll
    for (int c = 1; c < 4; ++c) if (gl[c] > gm) { gm = gl[c]; grp = c; }
    float gs = 0.f;
#pragma unroll
    for (int c = 0; c < 4; ++c) gs += __expf(gl[c] - gm);
    float gval = 1.0f / gs;
    float fl[8] = {0.f, 0.f, 0.f, 0.f, 0.f, 0.f, 0.f, 0.f};
#pragma unroll
    for (int j = 0; j < 4; ++j)
#pragma unroll
        for (int c = 0; c < 4; ++c) { int k = (64 * j + lane) * 4 + c; const float4* w = (const float4*)(wf + (size_t)k * 32 + grp * 8);
            float4 w0 = w[0], w1 = w[1]; float x = xv[4 * j + c];
            fl[0] += x * w0.x; fl[1] += x * w0.y; fl[2] += x * w0.z; fl[3] += x * w0.w; fl[4] += x * w1.x; fl[5] += x * w1.y; fl[6] += x * w1.z; fl[7] += x * w1.w; }
#pragma unroll
    for (int c = 0; c < 8; ++c) fl[c] = wave_sum(fl[c]) + bfine[grp * 8 + c];
    int i0 = 0; float v0 = fl[0];
#pragma unroll
    for (int c = 1; c < 8; ++c) if (fl[c] > v0) { v0 = fl[c]; i0 = c; }
    int i1 = -1; float v1 = -INFINITY;
#pragma unroll
    for (int c = 0; c < 8; ++c) if (c != i0 && fl[c] > v1) { v1 = fl[c]; i1 = c; }
    float w0 = 1.0f / (1.0f + __expf(v1 - v0)), w1 = 1.0f - w0;
    if (lane == 0) {
        int e0 = grp * 8 + i0, e1 = grp * 8 + i1;
        toke[row] = make_int2(e0, e1); tokg[row] = make_float2(gval * w0, gval * w1);
        atomicAdd(&cnt[e0], 1u); atomicAdd(&cnt[e1], 1u);
    }
}
__global__ void k_moe_plan(const unsigned* cnt, unsigned* pst, unsigned* ntiles, int* texp) {
    if (threadIdx.x != 0 || blockIdx.x != 0) return;
    unsigned p = 0;
    for (int e = 0; e < NEXP; ++e) { pst[e] = p; unsigned pad = ((cnt[e] + 255u) / 256u) * 256u; for (unsigned t = p / 256; t < (p + pad) / 256; ++t) texp[t] = e; p += pad; }
    pst[NEXP] = p; ntiles[0] = p / 256;
}
__global__ void k_moe_scatter(const int2* toke, const float2* tokg, const unsigned* pst, unsigned* cur, int* rowtok, float* rowgate, int2* pos) {
    int tok = blockIdx.x * blockDim.x + threadIdx.x;
    if (tok >= NTOK) return;
    int2 e = toke[tok]; float2 g = tokg[tok];
    unsigned d0 = pst[e.x] + atomicAdd(&cur[e.x], 1u), d1 = pst[e.y] + atomicAdd(&cur[e.y], 1u);
    rowtok[d0] = tok; rowgate[d0] = g.x; rowtok[d1] = tok; rowgate[d1] = g.y;
    pos[tok] = make_int2((int)d0, (int)d1);
}
__global__ void __launch_bounds__(256) k_combine(float* __restrict__ h, const bf16_t* __restrict__ ys, const int2* __restrict__ pos, const float* __restrict__ gain, bf16_t* __restrict__ xn, int final) {
    int row = (blockIdx.x * blockDim.x + threadIdx.x) >> 6, lane = threadIdx.x & 63;
    if (row >= NTOK) return;
    int2 p = pos[row];
    float4* xr = (float4*)(h + (size_t)row * D);
    const ushort4* y0 = (const ushort4*)(ys + (size_t)p.x * D); const ushort4* y1 = (const ushort4*)(ys + (size_t)p.y * D);
    float4 v[4]; float ss = 0.f;
#pragma unroll
    for (int j = 0; j < 4; ++j) { v[j] = xr[64 * j + lane]; ushort4 a = y0[64 * j + lane], c = y1[64 * j + lane];
        v[j].x += bf2f(a.x) + bf2f(c.x); v[j].y += bf2f(a.y) + bf2f(c.y); v[j].z += bf2f(a.z) + bf2f(c.z); v[j].w += bf2f(a.w) + bf2f(c.w);
        ss += v[j].x * v[j].x + v[j].y * v[j].y + v[j].z * v[j].z + v[j].w * v[j].w; }
    ss = wave_sum(ss);
    float rstd = rsqrtf(ss * (1.0f / D) + EPS);
#pragma unroll
    for (int j = 0; j < 4; ++j) {
        float4 g = ((const float4*)gain)[64 * j + lane];
        float4 o = make_float4(v[j].x * rstd * g.x, v[j].y * rstd * g.y, v[j].z * rstd * g.z, v[j].w * rstd * g.w);
        if (final) xr[64 * j + lane] = o;
        else { xr[64 * j + lane] = v[j]; ushort4 ob; ob.x = f2bf(o.x); ob.y = f2bf(o.y); ob.z = f2bf(o.z); ob.w = f2bf(o.w); ((ushort4*)(xn + (size_t)row * D))[64 * j + lane] = ob; }
    }
}

extern "C" void kernel_launch(void* const* d_in, const int* in_sizes, int n_in, void* d_out, int out_size, void* d_ws, size_t ws_size, hipStream_t stream) {
    if (n_in != 16 || ws_size < WS_END || out_size != NTOK * D) { fprintf(stderr, "kernel_launch: unexpected sizes n_in %d ws %zu out %d\n", n_in, ws_size, out_size); return; }
    const float* x = (const float*)d_in[0];
    const float* mix_norm_even = (const float*)d_in[1]; const float* w_in_even = (const float*)d_in[2]; const float* w_out_even = (const float*)d_in[3];
    const float* mix_norm_odd = (const float*)d_in[4]; const float* w_in_odd = (const float*)d_in[5]; const float* w_out_odd = (const float*)d_in[6];
    const float* ffn_norm = (const float*)d_in[7]; const float* w_rg = (const float*)d_in[8]; const float* b_rg = (const float*)d_in[9];
    const float* w_re = (const float*)d_in[10]; const float* b_re = (const float*)d_in[11];
    const float* w_eg = (const float*)d_in[12]; const float* w_eu = (const float*)d_in[13]; const float* w_ed = (const float*)d_in[14];
    const float* final_norm = (const float*)d_in[15];
    unsigned char* ws = (unsigned char*)d_ws;
    float* hbuf = (float*)d_out;
    unsigned* ctl = (unsigned*)(ws + WS_CTL);
    float2* rot = (float2*)(ws + WS_ROT); float2* ret = (float2*)(ws + WS_RET);
    float* kmean = (float*)(ws + WS_KMEAN);
    int2* toke = (int2*)(ws + WS_TOKE); float2* tokg = (float2*)(ws + WS_TOKG); int2* pos = (int2*)(ws + WS_POS);
    float* rstate = (float*)(ws + WS_RSTATE); float* rprev = (float*)(ws + WS_RPREV);
    bf16_t* xn = (bf16_t*)(ws + WS_XN); bf16_t* ao = (bf16_t*)(ws + WS_AO); bf16_t* big = (bf16_t*)(ws + WS_BIG); bf16_t* hs = (bf16_t*)(ws + WS_HS);

    (void)hipMemsetAsync(ws + WS_CTL, 0, CTL_BYTES, stream);
    k_tables<<<(S * 32 + 255) / 256, 256, 0, stream>>>(rot, ret);
    k_rmsnorm<<<NTOK / 4, 256, 0, stream>>>(x, mix_norm_even, xn);

    auto moe = [&](int layer) {
        unsigned* cnt = ctl + CW_CNT + 32 * layer; unsigned* cur = ctl + CW_CUR + 32 * layer; unsigned* pst = ctl + CW_PST + 40 * layer;
        unsigned* ntl = ctl + CW_NT + layer; int* texp = (int*)(ctl + CW_TEXP + 320 * layer);
        int* rowtok = (int*)(ctl + CW_ROWTOK + layer * MP_MAX); float* rowgate = (float*)(ctl + CW_ROWGATE + layer * MP_MAX);
        k_router<<<NTOK / 4, 256, 0, stream>>>(hbuf, ffn_norm + layer * D, w_rg + (size_t)layer * D * 4, b_rg + layer * 4, w_re + (size_t)layer * D * 32, b_re + layer * 32, xn, toke, tokg, cnt);
        k_moe_plan<<<1, 64, 0, stream>>>(cnt, pst, ntl, texp);
        k_moe_scatter<<<NTOK / 256, 256, 0, stream>>>(toke, tokg, pst, cur, rowtok, rowgate, pos);
        GemmArgs g1{xn, rowtok, w_eg + (size_t)layer * NEXP * D * HID, w_eu + (size_t)layer * NEXP * D * HID, texp, (const int*)ntl, (size_t)D * HID, D, HID, MP_MAX, HID, D, 0};
        k_gemm_naive<true, EpiMoe1><<<dim3(HID / 64, MP_MAX / 64), 256, 0, stream>>>(g1, EpiMoe1{hs});
        GemmArgs g2{hs, nullptr, w_ed + (size_t)layer * NEXP * HID * D, nullptr, texp, (const int*)ntl, (size_t)HID * D, HID, D, MP_MAX, D, HID, 0};
        k_gemm_naive<false, EpiMoe2><<<dim3(D / 64, MP_MAX / 64), 256, 0, stream>>>(g2, EpiMoe2{big, rowgate});
    };

    { GemmArgs g{xn, nullptr, w_in_even, nullptr, nullptr, nullptr, 0, D, PW, NTOK, PW, D, 0};
      k_gemm_naive<false, EpiInproj><<<dim3(PW / 64, NTOK / 64), 256, 0, stream>>>(g, EpiInproj{big, rot, ret, 0, 0}); }
    k_kmean<<<NB * 8 * 64 * 64 / 256, 256, 0, stream>>>(big, kmean);
    k_ret_state<<<NB * 4 * 128 * 64 * 128 / 256, 256, 0, stream>>>(big, rstate);
    k_moba_naive<<<NB * 8 * S / 256, 256, 0, stream>>>(big, kmean, ao);
    k_ret_scan<<<NB * 4 * 8192 / 256, 256, 0, stream>>>(rstate, rprev);
    k_ret_out<<<NTOK * 16 / 256, 256, 0, stream>>>(big, rprev, ao);
    { GemmArgs g{ao, nullptr, w_out_even, nullptr, nullptr, nullptr, 0, D, D, NTOK, D, D, 0};
      k_gemm_naive<false, EpiOutproj><<<dim3(D / 64, NTOK / 64), 256, 0, stream>>>(g, EpiOutproj{x, hbuf}); }
    moe(0);
    k_combine<<<NTOK / 4, 256, 0, stream>>>(hbuf, big, pos, mix_norm_odd, xn, 0);
    { GemmArgs g{xn, nullptr, w_in_odd, nullptr, nullptr, nullptr, 0, D, PW, NTOK, PW, D, 0};
      k_gemm_naive<false, EpiInproj><<<dim3(PW / 64, NTOK / 64), 256, 0, stream>>>(g, EpiInproj{big, rot, ret, 1, 0}); }
    k_dilated_naive<<<NB * 16 * S / 256, 256, 0, stream>>>(big, ao);
    { GemmArgs g{ao, nullptr, w_out_odd, nullptr, nullptr, nullptr, 0, D, D, NTOK, D, D, 0};
      k_gemm_naive<false, EpiOutproj><<<dim3(D / 64, NTOK / 64), 256, 0, stream>>>(g, EpiOutproj{hbuf, hbuf}); }
    moe(1);
    k_combine<<<NTOK / 4, 256, 0, stream>>>(hbuf, big, pos, final_norm, xn, 1);
}
```

```cpp
#include <hip/hip_runtime.h>
#include <hip/hip_cooperative_groups.h>
namespace cg = cooperative_groups;
#include <cstdio>
#include <cstdint>

typedef unsigned short bf16_t;
__device__ __forceinline__ float bf2f(bf16_t v) { return __uint_as_float(((unsigned)v) << 16); }
__device__ __forceinline__ bf16_t f2bf(float f) { unsigned u = __float_as_uint(f); return (bf16_t)((u + 0x7fffu + ((u >> 16) & 1u)) >> 16); }

constexpr int NB = 2, S = 16384, D = 1024, NTOK = NB * S;
constexpr int PW = 3072;
constexpr int NEXP = 32, HID = 512;
constexpr int MP_MAX = 2 * NTOK + NEXP * 256;
constexpr float EPS = 1e-6f;

constexpr size_t MiB = 1u << 20;
constexpr size_t WS_CTL = 0, CTL_BYTES = 2 * MiB;
constexpr size_t WS_ROT = 2 * MiB, WS_RET = 6 * MiB;
constexpr size_t WS_KMEAN = 10 * MiB;
constexpr size_t WS_TOKE = 12 * MiB, WS_TOKG = 13 * MiB, WS_POS = 14 * MiB;
constexpr size_t WS_RSTATE = 16 * MiB, WS_RPREV = 48 * MiB;
constexpr size_t WS_XN = 80 * MiB, WS_AO = 144 * MiB, WS_BIG = 208 * MiB, WS_HS = 416 * MiB, WS_END = 492 * MiB;
constexpr int CW_CNT = 0;
constexpr int CW_CUR = 64;
constexpr int CW_PST = 128;
constexpr int CW_NT = 256;
constexpr int CW_TEXP = 512;
constexpr int CW_ROWTOK = 4096;
constexpr int CW_ROWGATE = 4096 + 2 * MP_MAX;
static_assert((CW_ROWGATE + 2 * MP_MAX) * 4 <= (int)CTL_BYTES, "ctl");

__device__ __forceinline__ float wave_sum(float v) {
#pragma unroll
    for (int o = 32; o > 0; o >>= 1) v += __shfl_xor(v, o);
    return v;
}
__device__ __forceinline__ float silu(float x) { return x / (1.0f + __expf(-x)); }

__device__ __forceinline__ void d_tables(int vb, float2* rot, float2* ret) {
    int i = vb * blockDim.x + threadIdx.x;
    if (i >= S * 32) return;
    int pos = i >> 5, j = i & 31;
    float inv = 1.0f / powf(10000.0f, (float)j * (2.0f / 64.0f));
    float ang = (float)pos * inv;
    rot[i] = make_float2(cosf(ang), sinf(ang));
    float fr = 1.0f / powf(10000.0f, (float)j / 31.0f);
    float a2 = (float)pos * fr;
    ret[i] = make_float2(cosf(a2), sinf(a2));
}

__device__ __forceinline__ void d_rmsnorm(int vb, const float* __restrict__ src, const float* __restrict__ gain, bf16_t* __restrict__ xn) {
    int row = (vb * blockDim.x + threadIdx.x) >> 6, lane = threadIdx.x & 63;
    if (row >= NTOK) return;
    const float4* xr = (const float4*)(src + (size_t)row * D);
    float4 v[4]; float ss = 0.f;
#pragma unroll
    for (int j = 0; j < 4; ++j) { v[j] = xr[64 * j + lane]; ss += v[j].x * v[j].x + v[j].y * v[j].y + v[j].z * v[j].z + v[j].w * v[j].w; }
    ss = wave_sum(ss);
    float rstd = rsqrtf(ss * (1.0f / D) + EPS);
#pragma unroll
    for (int j = 0; j < 4; ++j) {
        float4 g = ((const float4*)gain)[64 * j + lane];
        ushort4 o; o.x = f2bf(v[j].x * rstd * g.x); o.y = f2bf(v[j].y * rstd * g.y); o.z = f2bf(v[j].z * rstd * g.z); o.w = f2bf(v[j].w * rstd * g.w);
        ((ushort4*)(xn + (size_t)row * D))[64 * j + lane] = o;
    }
}

struct GemmArgs {
    const bf16_t* A; const int* rowidx;
    const float* W; const float* W2;
    const int* tile_exp; const int* ntiles;
    size_t wstride;
    int lda, ldw, M, N, K, pad;
};
template <bool DUAL, class Epi>
__device__ __forceinline__ void d_gemm_naive(int vb, const GemmArgs& g, const Epi& epi) {
    __shared__ float As[16][65];
    __shared__ float Bs[16][64];
    __shared__ float Bs2[DUAL ? 16 : 1][64];
    const int tid = threadIdx.x, tx = tid & 15, ty = tid >> 4;
    const int nbx = g.N / 64; const int row0 = (vb / nbx) * 64, col0 = (vb % nbx) * 64;
    const float* W = g.W; const float* W2 = g.W2;
    if (g.tile_exp) {
        if (row0 >= g.ntiles[0] * 256) return;
        int e = g.tile_exp[row0 >> 8];
        W += (size_t)e * g.wstride; if (DUAL) W2 += (size_t)e * g.wstride;
    }
    float acc[4][4] = {}, acc2[4][4] = {};
    const int ar = tid >> 2, ak = (tid & 3) * 4;
    int arow = row0 + ar; if (g.rowidx) arow = g.rowidx[arow];
    const bf16_t* ap = g.A + (size_t)arow * g.lda + ak;
    const int bk = tid >> 4, bc = (tid & 15) * 4;
    const int cc[4] = {2 * tx, 2 * tx + 1, 2 * tx + 32, 2 * tx + 33};
    for (int k0 = 0; k0 < g.K; k0 += 16) {
        ushort4 a4 = *(const ushort4*)(ap + k0);
        As[ak + 0][ar] = bf2f(a4.x); As[ak + 1][ar] = bf2f(a4.y); As[ak + 2][ar] = bf2f(a4.z); As[ak + 3][ar] = bf2f(a4.w);
        float4 b4 = *(const float4*)(W + (size_t)(k0 + bk) * g.ldw + col0 + bc);
        Bs[bk][bc] = b4.x; Bs[bk][bc + 1] = b4.y; Bs[bk][bc + 2] = b4.z; Bs[bk][bc + 3] = b4.w;
        if (DUAL) { float4 c4 = *(const float4*)(W2 + (size_t)(k0 + bk) * g.ldw + col0 + bc);
            Bs2[bk][bc] = c4.x; Bs2[bk][bc + 1] = c4.y; Bs2[bk][bc + 2] = c4.z; Bs2[bk][bc + 3] = c4.w; }
        __syncthreads();
#pragma unroll
        for (int k = 0; k < 16; ++k) {
            float a[4], b[4], b2[4];
#pragma unroll
            for (int i = 0; i < 4; ++i) a[i] = As[k][ty * 4 + i];
#pragma unroll
            for (int j = 0; j < 4; ++j) { b[j] = Bs[k][cc[j]]; if (DUAL) b2[j] = Bs2[k][cc[j]]; }
#pragma unroll
            for (int i = 0; i < 4; ++i)
#pragma unroll
                for (int j = 0; j < 4; ++j) { acc[i][j] += a[i] * b[j]; if (DUAL) acc2[i][j] += a[i] * b2[j]; }
        }
        __syncthreads();
    }
#pragma unroll
    for (int i = 0; i < 4; ++i) epi(row0 + ty * 4 + i, col0, tx, acc[i], acc2[i]);
}

struct EpiInproj {
    bf16_t* P; const float2* rot; const float2* ret; int mode, pad;
    __device__ void operator()(int row, int col0, int tx, float* v, float*) const {
        const int pos = row & (S - 1);
        float o[4] = {v[0], v[1], v[2], v[3]};
        int kind;
        if (mode == 0) kind = col0 < 1024 ? 1 : (col0 < 1536 ? 0 : (col0 < 1792 ? 2 : (col0 < 2048 ? 3 : 0)));
        else kind = col0 < 2048 ? 1 : 0;
        if (kind == 1) {
            float2 c0 = rot[pos * 32 + 2 * tx], c1 = rot[pos * 32 + 2 * tx + 1];
            o[0] = v[0] * c0.x - v[2] * c0.y; o[2] = v[0] * c0.y + v[2] * c0.x;
            o[1] = v[1] * c1.x - v[3] * c1.y; o[3] = v[1] * c1.y + v[3] * c1.x;
        } else if (kind >= 2) {
            float2 c0 = ret[pos * 32 + tx], c1 = ret[pos * 32 + tx + 16];
            o[0] = v[0] * c0.x - v[1] * c0.y; o[1] = v[0] * c0.y + v[1] * c0.x;
            o[2] = v[2] * c1.x - v[3] * c1.y; o[3] = v[2] * c1.y + v[3] * c1.x;
            if (kind == 3) { o[0] *= 0.125f; o[1] *= 0.125f; o[2] *= 0.125f; o[3] *= 0.125f; }
        }
        bf16_t* p = P + (size_t)row * PW + col0 + 2 * tx;
        *(ushort2*)p = make_ushort2(f2bf(o[0]), f2bf(o[1]));
        *(ushort2*)(p + 32) = make_ushort2(f2bf(o[2]), f2bf(o[3]));
    }
};
struct EpiOutproj {
    const float* res; float* hout;
    __device__ void operator()(int row, int col0, int tx, float* v, float*) const {
        size_t o = (size_t)row * D + col0 + 2 * tx;
        float2 r0 = *(const float2*)(res + o), r1 = *(const float2*)(res + o + 32);
        *(float2*)(hout + o) = make_float2(r0.x + v[0], r0.y + v[1]);
        *(float2*)(hout + o + 32) = make_float2(r1.x + v[2], r1.y + v[3]);
    }
};
struct EpiMoe1 {
    bf16_t* Hs;
    __device__ void operator()(int row, int col0, int tx, float* v, float* v2) const {
        bf16_t* p = Hs + (size_t)row * HID + col0 + 2 * tx;
        *(ushort2*)p = make_ushort2(f2bf(silu(v[0]) * v2[0]), f2bf(silu(v[1]) * v2[1]));
        *(ushort2*)(p + 32) = make_ushort2(f2bf(silu(v[2]) * v2[2]), f2bf(silu(v[3]) * v2[3]));
    }
};
struct EpiMoe2 {
    bf16_t* ys; const float* rowgate;
    __device__ void operator()(int row, int col0, int tx, float* v, float*) const {
        float gt = rowgate[row];
        bf16_t* p = ys + (size_t)row * D + col0 + 2 * tx;
        *(ushort2*)p = make_ushort2(f2bf(v[0] * gt), f2bf(v[1] * gt));
        *(ushort2*)(p + 32) = make_ushort2(f2bf(v[2] * gt), f2bf(v[3] * gt));
    }
};

__device__ __forceinline__ void d_kmean(int vb, const bf16_t* __restrict__ P, float* __restrict__ kmean) {
    int i = vb * blockDim.x + threadIdx.x;
    if (i >= NB * 8 * 64 * 64) return;
    int d = i & 63, n = (i >> 6) & 63, h = (i >> 12) & 7, b = i >> 15;
    float s = 0.f;
    const bf16_t* p = P + ((size_t)(b * S + n * 256)) * PW + 512 + h * 64 + d;
    for (int j = 0; j < 256; ++j) s += bf2f(p[(size_t)j * PW]);
    kmean[i] = s * (1.0f / 256.0f);
}
__device__ __forceinline__ void soft_key(float& m, float& l, float* o, const float* q, const bf16_t* kr, const bf16_t* vr, float scale) {
    float s = 0.f;
#pragma unroll
    for (int c = 0; c < 8; ++c) { uint4 u = ((const uint4*)kr)[c]; const unsigned w[4] = {u.x, u.y, u.z, u.w};
#pragma unroll
        for (int t = 0; t < 4; ++t) { s += q[c * 8 + 2 * t] * __uint_as_float(w[t] << 16) + q[c * 8 + 2 * t + 1] * __uint_as_float(w[t] & 0xffff0000u); } }
    s *= scale;
    float mn = fmaxf(m, s), al = __expf(m - mn), p = __expf(s - mn);
    l = l * al + p; m = mn;
#pragma unroll
    for (int c = 0; c < 8; ++c) { uint4 u = ((const uint4*)vr)[c]; const unsigned w[4] = {u.x, u.y, u.z, u.w};
#pragma unroll
        for (int t = 0; t < 4; ++t) { o[c * 8 + 2 * t] = o[c * 8 + 2 * t] * al + p * __uint_as_float(w[t] << 16); o[c * 8 + 2 * t + 1] = o[c * 8 + 2 * t + 1] * al + p * __uint_as_float(w[t] & 0xffff0000u); } }
}
__device__ __forceinline__ void d_moba_naive(int vb, const bf16_t* __restrict__ P, const float* __restrict__ kmean, bf16_t* __restrict__ AO) {
    int i = vb * blockDim.x + threadIdx.x;
    if (i >= NB * 8 * S) return;
    int pos = i & (S - 1), h = (i >> 14) & 7, b = i >> 17;
    size_t tok = (size_t)b * S + pos;
    float q[64];
    { const bf16_t* qp = P + tok * PW + h * 64;
#pragma unroll
      for (int d = 0; d < 64; ++d) q[d] = bf2f(qp[d]); }
    int qb = pos >> 8;
    float bv[3] = {-INFINITY, -INFINITY, -INFINITY}; int bi[3] = {-1, -1, -1};
    const float* km = kmean + ((size_t)(b * 8 + h) * 64) * 64;
    for (int n = 0; n < qb; ++n) {
        float g = 0.f;
#pragma unroll
        for (int d = 0; d < 64; ++d) g += q[d] * km[n * 64 + d];
        if (g > bv[0]) { bv[2] = bv[1]; bi[2] = bi[1]; bv[1] = bv[0]; bi[1] = bi[0]; bv[0] = g; bi[0] = n; }
        else if (g > bv[1]) { bv[2] = bv[1]; bi[2] = bi[1]; bv[1] = g; bi[1] = n; }
        else if (g > bv[2]) { bv[2] = g; bi[2] = n; }
    }
    float m = -1e30f, l = 0.f, o[64];
#pragma unroll
    for (int d = 0; d < 64; ++d) o[d] = 0.f;
    const bf16_t* Kb = P + ((size_t)b * S) * PW + 512 + h * 64;
    const bf16_t* Vb = P + ((size_t)b * S) * PW + 1024 + h * 64;
    for (int key = qb * 256; key <= pos; ++key) soft_key(m, l, o, q, Kb + (size_t)key * PW, Vb + (size_t)key * PW, 0.125f);
    for (int s3 = 0; s3 < 3; ++s3) {
        if (bi[s3] < 0) continue;
        int k0 = bi[s3] * 256;
        for (int key = k0; key < k0 + 256; ++key) soft_key(m, l, o, q, Kb + (size_t)key * PW, Vb + (size_t)key * PW, 0.125f);
    }
    float il = 1.0f / l;
    bf16_t* op = AO + tok * D + h * 64;
#pragma unroll
    for (int d = 0; d < 64; ++d) op[d] = f2bf(o[d] * il);
}

__device__ __forceinline__ void d_dilated_naive(int vb, const bf16_t* __restrict__ P, bf16_t* __restrict__ AO) {
    int i = vb * blockDim.x + threadIdx.x;
    if (i >= NB * 16 * S) return;
    int pos = i & (S - 1), h = (i >> 14) & 15, b = i >> 18;
    size_t tok = (size_t)b * S + pos;
    float q[64];
    { const bf16_t* qp = P + tok * PW + h * 64;
#pragma unroll
      for (int d = 0; d < 64; ++d) q[d] = bf2f(qp[d]); }
    float m = -1e30f, l = 0.f, o[64];
#pragma unroll
    for (int d = 0; d < 64; ++d) o[d] = 0.f;
    const bf16_t* Kb = P + ((size_t)b * S) * PW + 1024 + h * 64;
    const bf16_t* Vb = P + ((size_t)b * S) * PW + 2048 + h * 64;
    for (int br = 0; br < 3; ++br) {
        int dil = br == 0 ? 1 : (br == 1 ? 4 : 16);
        for (int t = 0; t <= 128; ++t) {
            int key = pos - t * dil; if (key < 0) break;
            soft_key(m, l, o, q, Kb + (size_t)key * PW, Vb + (size_t)key * PW, 0.125f);
        }
    }
    float il = 1.0f / l;
    bf16_t* op = AO + tok * D + h * 64;
#pragma unroll
    for (int d = 0; d < 64; ++d) op[d] = f2bf(o[d] * il);
}

__device__ __forceinline__ float ret_loggamma(int h) { return logf(1.0f - exp2f(-5.0f - (float)h)); }
__device__ __forceinline__ void d_ret_state(int vb, const bf16_t* __restrict__ P, float* __restrict__ state) {
    size_t i = (size_t)vb * blockDim.x + threadIdx.x;
    if (i >= (size_t)NB * 4 * 128 * 64 * 128) return;
    int e = i & 127, d = (i >> 7) & 63, n = (i >> 13) & 127, h = (i >> 20) & 3, b = (int)(i >> 22);
    float lg = ret_loggamma(h);
    const bf16_t* kp = P + ((size_t)(b * S + n * 128)) * PW + 1792 + h * 64 + d;
    const bf16_t* vp = P + ((size_t)(b * S + n * 128)) * PW + 2048 + h * 128 + e;
    float s = 0.f;
    for (int j = 0; j < 128; ++j) s += bf2f(kp[(size_t)j * PW]) * __expf(lg * (float)(127 - j)) * bf2f(vp[(size_t)j * PW]);
    state[i] = s;
}
__device__ __forceinline__ void d_ret_scan(int vb, const float* __restrict__ state, float* __restrict__ rprev) {
    int i = vb * blockDim.x + threadIdx.x;
    if (i >= NB * 4 * 8192) return;
    int de = i & 8191, bh = i >> 13, h = bh & 3;
    float gc = __expf(ret_loggamma(h) * 128.0f), r = 0.f;
    for (int n = 0; n < 128; ++n) { size_t o = ((size_t)bh * 128 + n) * 8192 + de; rprev[o] = r; r = gc * r + state[o]; }
}
__device__ __forceinline__ void d_ret_out(int vb, const bf16_t* __restrict__ P, const float* __restrict__ rprev, bf16_t* __restrict__ AO) {
    int t = vb * blockDim.x + threadIdx.x;
    if (t >= NTOK * 16) return;
    int qt = t & 3, h = (t >> 2) & 3, tok = t >> 4, b = tok >> 14, pos = tok & (S - 1), ii = pos & 127, n = pos >> 7;
    float lg = ret_loggamma(h);
    float q[64];
    { const bf16_t* qp = P + (size_t)tok * PW + 1536 + h * 64;
#pragma unroll
      for (int d = 0; d < 64; ++d) q[d] = bf2f(qp[d]); }
    float acc[32];
#pragma unroll
    for (int e = 0; e < 32; ++e) acc[e] = 0.f;
    const float* rp = rprev + ((size_t)(b * 4 + h) * 128 + n) * 8192 + qt * 32;
    { const bf16_t* qp = P + (size_t)tok * PW + 1536 + h * 64;
      for (int d = 0; d < 64; ++d) { float qd = bf2f(qp[d]);
#pragma unroll
        for (int e = 0; e < 32; ++e) acc[e] += qd * rp[d * 128 + e]; } }
    float sc = __expf(lg * (float)(ii + 1));
#pragma unroll
    for (int e = 0; e < 32; ++e) acc[e] *= sc;
    const bf16_t* Kb = P + (size_t)(tok - ii) * PW + 1792 + h * 64;
    const bf16_t* Vb = P + (size_t)(tok - ii) * PW + 2048 + h * 128 + qt * 32;
    for (int j = 0; j <= ii; ++j) {
        const bf16_t* kr = Kb + (size_t)j * PW; float s = 0.f;
#pragma unroll
        for (int d = 0; d < 64; ++d) s += q[d] * bf2f(kr[d]);
        s *= __expf(lg * (float)(ii - j));
        const bf16_t* vr = Vb + (size_t)j * PW;
#pragma unroll
        for (int e = 0; e < 32; ++e) acc[e] += s * bf2f(vr[e]);
    }
    float sum = 0.f;
#pragma unroll
    for (int e = 0; e < 32; ++e) sum += acc[e];
    sum += __shfl_xor(sum, 1); sum += __shfl_xor(sum, 2);
    float mu = sum * (1.0f / 128.0f), sq = 0.f;
#pragma unroll
    for (int e = 0; e < 32; ++e) { float dlt = acc[e] - mu; sq += dlt * dlt; }
    sq += __shfl_xor(sq, 1); sq += __shfl_xor(sq, 2);
    float rs = rsqrtf(sq * (1.0f / 128.0f) + EPS);
    const bf16_t* gp = P + (size_t)tok * PW + 2560 + h * 128 + qt * 32;
    bf16_t* op = AO + (size_t)tok * D + 512 + h * 128 + qt * 32;
#pragma unroll
    for (int e = 0; e < 32; ++e) op[e] = f2bf((acc[e] - mu) * rs * silu(bf2f(gp[e])));
}

__device__ __forceinline__ void d_router(int vb, const float* __restrict__ h, const float* __restrict__ gain, const float* __restrict__ wg, const float* __restrict__ bg,
                                               const float* __restrict__ wf, const float* __restrict__ bfine, bf16_t* __restrict__ xn, int2* __restrict__ toke, float2* __restrict__ tokg, unsigned* __restrict__ cnt) {
    int row = (vb * blockDim.x + threadIdx.x) >> 6, lane = threadIdx.x & 63;
    if (row >= NTOK) return;
    const float4* xr = (const float4*)(h + (size_t)row * D);
    float4 v[4]; float ss = 0.f;
#pragma unroll
    for (int j = 0; j < 4; ++j) { v[j] = xr[64 * j + lane]; ss += v[j].x * v[j].x + v[j].y * v[j].y + v[j].z * v[j].z + v[j].w * v[j].w; }
    ss = wave_sum(ss);
    float rstd = rsqrtf(ss * (1.0f / D) + EPS);
    float xv[16];
#pragma unroll
    for (int j = 0; j < 4; ++j) {
        float4 g = ((const float4*)gain)[64 * j + lane];
        xv[4 * j] = v[j].x * rstd * g.x; xv[4 * j + 1] = v[j].y * rstd * g.y; xv[4 * j + 2] = v[j].z * rstd * g.z; xv[4 * j + 3] = v[j].w * rstd * g.w;
        ushort4 o; o.x = f2bf(xv[4 * j]); o.y = f2bf(xv[4 * j + 1]); o.z = f2bf(xv[4 * j + 2]); o.w = f2bf(xv[4 * j + 3]);
        ((ushort4*)(xn + (size_t)row * D))[64 * j + lane] = o;
    }
    float gl[4] = {0.f, 0.f, 0.f, 0.f};
#pragma unroll
    for (int j = 0; j < 4; ++j)
#pragma unroll
        for (int c = 0; c < 4; ++c) { int k = (64 * j + lane) * 4 + c; float4 w = ((const float4*)wg)[k];
            gl[0] += xv[4 * j + c] * w.x; gl[1] += xv[4 * j + c] * w.y; gl[2] += xv[4 * j + c] * w.z; gl[3] += xv[4 * j + c] * w.w; }
#pragma unroll
    for (int c = 0; c < 4; ++c) gl[c] = wave_sum(gl[c]) + bg[c];
    int grp = 0; float gm = gl[0];
#pragma unroll
    for (int c = 1; c < 4; ++c) if (gl[c] > gm) { gm = gl[c]; grp = c; }
    float gs = 0.f;
#pragma unroll
    for (int c = 0; c < 4; ++c) gs += __expf(gl[c] - gm);
    float gval = 1.0f / gs;
    float fl[8] = {0.f, 0.f, 0.f, 0.f, 0.f, 0.f, 0.f, 0.f};
#pragma unroll
    for (int j = 0; j < 4; ++j)
#pragma unroll
        for (int c = 0; c < 4; ++c) { int k = (64 * j + lane) * 4 + c; const float4* w = (const float4*)(wf + (size_t)k * 32 + grp * 8);
            float4 w0 = w[0], w1 = w[1]; float x = xv[4 * j + c];
            fl[0] += x * w0.x; fl[1] += x * w0.y; fl[2] += x * w0.z; fl[3] += x * w0.w; fl[4] += x * w1.x; fl[5] += x * w1.y; fl[6] += x * w1.z; fl[7] += x * w1.w; }
#pragma unroll
    for (int c = 0; c < 8; ++c) fl[c] = wave_sum(fl[c]) + bfine[grp * 8 + c];
    int i0 = 0; float v0 = fl[0];
#pragma unroll
    for (int c = 1; c < 8; ++c) if (fl[c] > v0) { v0 = fl[c]; i0 = c; }
    int i1 = -1; float v1 = -INFINITY;
#pragma unroll
    for (int c = 0; c < 8; ++c) if (c != i0 && fl[c] > v1) { v1 = fl[c]; i1 = c; }
    float w0 = 1.0f / (1.0f + __expf(v1 - v0)), w1 = 1.0f - w0;
    if (lane == 0) {
        int e0 = grp * 8 + i0, e1 = grp * 8 + i1;
        toke[row] = make_int2(e0, e1); tokg[row] = make_float2(gval * w0, gval * w1);
        atomicAdd(&cnt[e0], 1u); atomicAdd(&cnt[e1], 1u);
    }
}
__device__ __forceinline__ void d_moe_plan(int vb, const unsigned* cnt, unsigned* pst, unsigned* ntiles, int* texp) {
    if (threadIdx.x != 0 || vb != 0) return;
    unsigned p = 0;
    for (int e = 0; e < NEXP; ++e) { pst[e] = p; unsigned pad = ((cnt[e] + 255u) / 256u) * 256u; for (unsigned t = p / 256; t < (p + pad) / 256; ++t) texp[t] = e; p += pad; }
    pst[NEXP] = p; ntiles[0] = p / 256;
}
__device__ __forceinline__ void d_moe_scatter(int vb, const int2* toke, const float2* tokg, const unsigned* pst, unsigned* cur, int* rowtok, float* rowgate, int2* pos) {
    int tok = vb * blockDim.x + threadIdx.x;
    if (tok >= NTOK) return;
    int2 e = toke[tok]; float2 g = tokg[tok];
    unsigned d0 = pst[e.x] + atomicAdd(&cur[e.x], 1u), d1 = pst[e.y] + atomicAdd(&cur[e.y], 1u);
    rowtok[d0] = tok; rowgate[d0] = g.x; rowtok[d1] = tok; rowgate[d1] = g.y;
    pos[tok] = make_int2((int)d0, (int)d1);
}
__device__ __forceinline__ void d_combine(int vb, float* __restrict__ h, const bf16_t* __restrict__ ys, const int2* __restrict__ pos, const float* __restrict__ gain, bf16_t* __restrict__ xn, int final) {
    int row = (vb * blockDim.x + threadIdx.x) >> 6, lane = threadIdx.x & 63;
    if (row >= NTOK) return;
    int2 p = pos[row];
    float4* xr = (float4*)(h + (size_t)row * D);
    const ushort4* y0 = (const ushort4*)(ys + (size_t)p.x * D); const ushort4* y1 = (const ushort4*)(ys + (size_t)p.y * D);
    float4 v[4]; float ss = 0.f;
#pragma unroll
    for (int j = 0; j < 4; ++j) { v[j] = xr[64 * j + lane]; ushort4 a = y0[64 * j + lane], c = y1[64 * j + lane];
        v[j].x += bf2f(a.x) + bf2f(c.x); v[j].y += bf2f(a.y) + bf2f(c.y); v[j].z += bf2f(a.z) + bf2f(c.z); v[j].w += bf2f(a.w) + bf2f(c.w);
        ss += v[j].x * v[j].x + v[j].y * v[j].y + v[j].z * v[j].z + v[j].w * v[j].w; }
    ss = wave_sum(ss);
    float rstd = rsqrtf(ss * (1.0f / D) + EPS);
#pragma unroll
    for (int j = 0; j < 4; ++j) {
        float4 g = ((const float4*)gain)[64 * j + lane];
        float4 o = make_float4(v[j].x * rstd * g.x, v[j].y * rstd * g.y, v[j].z * rstd * g.z, v[j].w * rstd * g.w);
        if (final) xr[64 * j + lane] = o;
        else { xr[64 * j + lane] = v[j]; ushort4 ob; ob.x = f2bf(o.x); ob.y = f2bf(o.y); ob.z = f2bf(o.z); ob.w = f2bf(o.w); ((ushort4*)(xn + (size_t)row * D))[64 * j + lane] = ob; }
    }
}

struct Params {
    const float *x, *mix_norm_even, *w_in_even, *w_out_even, *mix_norm_odd, *w_in_odd, *w_out_odd, *ffn_norm, *w_rg, *b_rg, *w_re, *b_re, *w_eg, *w_eu, *w_ed, *final_norm;
    float* hbuf; unsigned char* ws;
};
#define FOR_VB(n) for (int vb = blockIdx.x; vb < (int)(n); vb += gridDim.x)
constexpr int NTH = 256;

__device__ __forceinline__ void moe_phases(const Params& p, cg::grid_group& grid, int layer) {
    unsigned char* ws = p.ws; unsigned* ctl = (unsigned*)(ws + WS_CTL);
    unsigned* cnt = ctl + CW_CNT + 32 * layer; unsigned* cur = ctl + CW_CUR + 32 * layer; unsigned* pst = ctl + CW_PST + 40 * layer;
    unsigned* ntl = ctl + CW_NT + layer; int* texp = (int*)(ctl + CW_TEXP + 320 * layer);
    int* rowtok = (int*)(ctl + CW_ROWTOK + layer * MP_MAX); float* rowgate = (float*)(ctl + CW_ROWGATE + layer * MP_MAX);
    int2* toke = (int2*)(ws + WS_TOKE); float2* tokg = (float2*)(ws + WS_TOKG); int2* pos = (int2*)(ws + WS_POS);
    bf16_t* xn = (bf16_t*)(ws + WS_XN); bf16_t* big = (bf16_t*)(ws + WS_BIG); bf16_t* hs = (bf16_t*)(ws + WS_HS);
    FOR_VB(NTOK * 64 / NTH) d_router(vb, p.hbuf, p.ffn_norm + layer * D, p.w_rg + (size_t)layer * D * 4, p.b_rg + layer * 4, p.w_re + (size_t)layer * D * 32, p.b_re + layer * 32, xn, toke, tokg, cnt);
    grid.sync();
    if (blockIdx.x == 0) d_moe_plan(0, cnt, pst, ntl, texp);
    grid.sync();
    FOR_VB(NTOK / NTH) d_moe_scatter(vb, toke, tokg, pst, cur, rowtok, rowgate, pos);
    grid.sync();
    { GemmArgs g1{xn, rowtok, p.w_eg + (size_t)layer * NEXP * D * HID, p.w_eu + (size_t)layer * NEXP * D * HID, texp, (const int*)ntl, (size_t)D * HID, D, HID, MP_MAX, HID, D, 0};
      EpiMoe1 e1{hs};
      FOR_VB((HID / 64) * (MP_MAX / 64)) d_gemm_naive<true, EpiMoe1>(vb, g1, e1); }
    grid.sync();
    { GemmArgs g2{hs, nullptr, p.w_ed + (size_t)layer * NEXP * HID * D, nullptr, texp, (const int*)ntl, (size_t)HID * D, HID, D, MP_MAX, D, HID, 0};
      EpiMoe2 e2{big, rowgate};
      FOR_VB((D / 64) * (MP_MAX / 64)) d_gemm_naive<false, EpiMoe2>(vb, g2, e2); }
    grid.sync();
}

__global__ void __launch_bounds__(NTH) mega(Params p) {
    cg::grid_group grid = cg::this_grid();
    unsigned char* ws = p.ws;
    float2* rot = (float2*)(ws + WS_ROT); float2* ret = (float2*)(ws + WS_RET);
    float* kmean = (float*)(ws + WS_KMEAN);
    int2* pos = (int2*)(ws + WS_POS);
    float* rstate = (float*)(ws + WS_RSTATE); float* rprev = (float*)(ws + WS_RPREV);
    bf16_t* xn = (bf16_t*)(ws + WS_XN); bf16_t* ao = (bf16_t*)(ws + WS_AO); bf16_t* big = (bf16_t*)(ws + WS_BIG);
    float* hbuf = p.hbuf;

    FOR_VB(S * 32 / NTH) d_tables(vb, rot, ret);
    FOR_VB(NTOK * 64 / NTH) d_rmsnorm(vb, p.x, p.mix_norm_even, xn);
    grid.sync();
    { GemmArgs g{xn, nullptr, p.w_in_even, nullptr, nullptr, nullptr, 0, D, PW, NTOK, PW, D, 0}; EpiInproj e{big, rot, ret, 0, 0};
      FOR_VB((PW / 64) * (NTOK / 64)) d_gemm_naive<false, EpiInproj>(vb, g, e); }
    grid.sync();
    FOR_VB(NB * 8 * 64 * 64 / NTH) d_kmean(vb, big, kmean);
    FOR_VB(NB * 4 * 128 * 64 * 128 / NTH) d_ret_state(vb, big, rstate);
    grid.sync();
    FOR_VB(NB * 4 * 8192 / NTH) d_ret_scan(vb, rstate, rprev);
    FOR_VB(NB * 8 * S / NTH) d_moba_naive(vb, big, kmean, ao);
    grid.sync();
    FOR_VB(NTOK * 16 / NTH) d_ret_out(vb, big, rprev, ao);
    grid.sync();
    { GemmArgs g{ao, nullptr, p.w_out_even, nullptr, nullptr, nullptr, 0, D, D, NTOK, D, D, 0}; EpiOutproj e{p.x, hbuf};
      FOR_VB((D / 64) * (NTOK / 64)) d_gemm_naive<false, EpiOutproj>(vb, g, e); }
    grid.sync();
    moe_phases(p, grid, 0);
    FOR_VB(NTOK * 64 / NTH) d_combine(vb, hbuf, big, pos, p.mix_norm_odd, xn, 0);
    grid.sync();
    { GemmArgs g{xn, nullptr, p.w_in_odd, nullptr, nullptr, nullptr, 0, D, PW, NTOK, PW, D, 0}; EpiInproj e{big, rot, ret, 1, 0};
      FOR_VB((PW / 64) * (NTOK / 64)) d_gemm_naive<false, EpiInproj>(vb, g, e); }
    grid.sync();
    FOR_VB(NB * 16 * S / NTH) d_dilated_naive(vb, big, ao);
    grid.sync();
    { GemmArgs g{ao, nullptr, p.w_out_odd, nullptr, nullptr, nullptr, 0, D, D, NTOK, D, D, 0}; EpiOutproj e{hbuf, hbuf};
      FOR_VB((D / 64) * (NTOK / 64)) d_gemm_naive<false, EpiOutproj>(vb, g, e); }
    grid.sync();
    moe_phases(p, grid, 1);
    FOR_VB(NTOK * 64 / NTH) d_combine(vb, hbuf, big, pos, p.final_norm, xn, 1);
}

extern "C" void kernel_launch(void* const* d_in, const int* in_sizes, int n_in, void* d_out, int out_size, void* d_ws, size_t ws_size, hipStream_t stream) {
    if (n_in != 16 || ws_size < WS_END || out_size != NTOK * D) { fprintf(stderr, "kernel_launch: unexpected sizes n_in %d ws %zu out %d\n", n_in, ws_size, out_size); return; }
    static int grid_blocks = 0;
    if (!grid_blocks) {
        int dev = 0, cus = 0, per_cu = 0;
        (void)hipGetDevice(&dev);
        (void)hipDeviceGetAttribute(&cus, hipDeviceAttributeMultiprocessorCount, dev);
        (void)hipOccupancyMaxActiveBlocksPerMultiprocessor(&per_cu, mega, NTH, 0);
        if (per_cu < 1) per_cu = 1;
        grid_blocks = cus * per_cu;
        fprintf(stderr, "kernel_launch: cus %d per_cu %d grid %d\n", cus, per_cu, grid_blocks);
    }
    Params p{};
    const float** pp = (const float**)&p;
    for (int i = 0; i < 16; ++i) pp[i] = (const float*)d_in[i];
    p.hbuf = (float*)d_out; p.ws = (unsigned char*)d_ws;
    (void)hipMemsetAsync((unsigned char*)d_ws + WS_CTL, 0, CTL_BYTES, stream);
    void* args[] = {&p};
    hipError_t e = hipLaunchCooperativeKernel((void*)mega, dim3(grid_blocks), dim3(NTH), args, 0, stream);
    if (e != hipSuccess) fprintf(stderr, "cooperative launch failed: %s (grid %d)\n", hipGetErrorString(e), grid_blocks);
}
```

```cpp
#include <hip/hip_runtime.h>
#include <hip/hip_cooperative_groups.h>
#include <cstdio>
#include <cstdint>
namespace cg = cooperative_groups;

typedef unsigned short bf16_t;
__device__ __forceinline__ float bf2f(bf16_t v) { return __uint_as_float(((unsigned)v) << 16); }
__device__ __forceinline__ bf16_t f2bf(float f) { unsigned u = __float_as_uint(f); return (bf16_t)((u + 0x7fffu + ((u >> 16) & 1u)) >> 16); }

constexpr int NB = 2, S = 16384, D = 1024, NTOK = NB * S;
constexpr int PW = 3072;
constexpr int NEXP = 32, HID = 512;
constexpr int MP_MAX = 2 * NTOK + NEXP * 256;
constexpr float EPS = 1e-6f;
constexpr int NTH = 512, NWAVES = 8;

constexpr size_t MiB = 1u << 20;
constexpr size_t WS_CTL = 0, CTL_BYTES = 2 * MiB;
constexpr size_t WS_ROT = 2 * MiB, WS_RET = 6 * MiB;
constexpr size_t WS_KMEAN = 10 * MiB;
constexpr size_t WS_TOKE = 12 * MiB, WS_TOKG = 13 * MiB, WS_POS = 14 * MiB;
constexpr size_t WS_WIN0 = 16 * MiB, WS_WOUT0 = 22 * MiB, WS_WIN1 = 24 * MiB, WS_WOUT1 = 30 * MiB;
constexpr size_t WS_WEXP = 32 * MiB;
constexpr size_t WEXP_E = 3 * MiB / 2;
constexpr size_t WS_XN = 128 * MiB, WS_AO = 128 * MiB;
constexpr size_t WS_BIG = 192 * MiB;
constexpr size_t WS_HS = 400 * MiB, WS_RSTATE = 400 * MiB, WS_RPREV = 432 * MiB;
constexpr size_t WS_END = 476 * MiB;
constexpr int CW_CNT = 0;
constexpr int CW_CUR = 64;
constexpr int CW_PST = 128;
constexpr int CW_NT = 256;
constexpr int CW_TEXP = 512;
constexpr int CW_ROWGATE = 4096;
static_assert((CW_ROWGATE + 2 * MP_MAX) * 4 <= (int)CTL_BYTES, "ctl");

__device__ __forceinline__ float wave_sum(float v) {
#pragma unroll
    for (int o = 32; o > 0; o >>= 1) v += __shfl_xor(v, o);
    return v;
}
__device__ __forceinline__ int my_lane() { int l; asm volatile("v_mbcnt_lo_u32_b32 %0, -1, 0\n\tv_mbcnt_hi_u32_b32 %0, -1, %0" : "=v"(l)); return l; }
__device__ __forceinline__ float silu(float x) { return x / (1.0f + __expf(-x)); }

__device__ __forceinline__ void d_tables(int vb, float2* rot, float2* ret) {
    int i = vb * blockDim.x + threadIdx.x;
    if (i >= S * 32) return;
    int pos = i >> 5, j = i & 31;
    float inv = 1.0f / powf(10000.0f, (float)j * (2.0f / 64.0f));
    float ang = (float)pos * inv;
    rot[i] = make_float2(cosf(ang), sinf(ang));
    float fr = 1.0f / powf(10000.0f, (float)j / 31.0f);
    float a2 = (float)pos * fr;
    ret[i] = make_float2(cosf(a2), sinf(a2));
}

__device__ __forceinline__ void d_rmsnorm(int vb, const float* __restrict__ src, const float* __restrict__ gain, bf16_t* __restrict__ xn) {
    int row = (vb * blockDim.x + threadIdx.x) >> 6, lane = threadIdx.x & 63;
    if (row >= NTOK) return;
    const float4* xr = (const float4*)(src + (size_t)row * D);
    float4 v[4]; float ss = 0.f;
#pragma unroll
    for (int j = 0; j < 4; ++j) { v[j] = xr[64 * j + lane]; ss += v[j].x * v[j].x + v[j].y * v[j].y + v[j].z * v[j].z + v[j].w * v[j].w; }
    ss = wave_sum(ss);
    float rstd = rsqrtf(ss * (1.0f / D) + EPS);
#pragma unroll
    for (int j = 0; j < 4; ++j) {
        float4 g = ((const float4*)gain)[64 * j + lane];
        ushort4 o; o.x = f2bf(v[j].x * rstd * g.x); o.y = f2bf(v[j].y * rstd * g.y); o.z = f2bf(v[j].z * rstd * g.z); o.w = f2bf(v[j].w * rstd * g.w);
        ((ushort4*)(xn + (size_t)row * D))[64 * j + lane] = o;
    }
}


namespace pg8 {
#define PG8_LAS __attribute__((address_space(3)))
typedef unsigned short bf16_t;
typedef short bf16x8 __attribute__((ext_vector_type(8)));
typedef float f32x4 __attribute__((ext_vector_type(4)));
typedef unsigned u32x4 __attribute__((ext_vector_type(4)));
constexpr int BM = 256, BK = 64, HALF = 128, HTB = HALF * BK * 2  , STAGE_BYTES = 8 * HTB, NXCD = 8, WGM = 8;

__host__ __device__ __forceinline__ int lds_byte(int r, int c) { const int st = (r >> 4) * 2 + (c >> 5), rr = r & 15, cc = c & 31, ob = rr * 64 + cc * 2; return st * 1024 + (ob ^ (((ob >> 9) & 1) << 5)); }
__host__ __device__ __forceinline__ void stage_rc(int b, int& R, int& C) { const int st = b / 1024, sb = b % 1024, swz = sb ^ (((sb >> 9) & 1) << 5); R = (st >> 1) * 16 + swz / 64; C = (st & 1) * 32 + (swz % 64) / 2; }
__host__ __device__ __forceinline__ int perm32(int rho) { const int n = rho >> 4, i = rho & 15; return 8 * (i >> 2) + 4 * n + (i & 3); }

struct Unit { int pm, pn; };
struct Gemm { const bf16_t* A; const bf16_t* Bt; int M, N, K; };

struct StaticOrder {
    int nM, nN, nwg, G, c;
    __host__ __device__ void init(int M, int N, int G_, int c_) { nM = M / BM; nN = N / BM; nwg = nM * nN; G = G_; c = c_; }
    __host__ __device__ bool next(int i, Unit& u) const {
        const long L = (long)i * G + c; if (L >= nwg) return false;
        int wgid = (int)L; { const int q = nwg / NXCD, r = nwg % NXCD, xcd = wgid % NXCD, off = wgid / NXCD; wgid = (xcd < r ? xcd * (q + 1) : r * (q + 1) + (xcd - r) * q) + off; }
        const int nig = WGM * nN, gid = wgid / nig, fm = gid * WGM, gsz = (nM - fm) < WGM ? (nM - fm) : WGM;
        u.pm = fm + ((wgid % nig) % gsz); u.pn = (wgid % nig) / gsz; return true;
    }
    __device__ __forceinline__ void a_ready(const Unit&) const {}
    __device__ __forceinline__ void done(const Unit&) const {}
    __device__ __forceinline__ size_t boff(const Unit&) const { return 0; }
};


__device__ __forceinline__ unsigned cvt_pk_bf16(float lo, float hi) { unsigned r; asm volatile("v_cvt_pk_bf16_f32 %0, %1, %2" : "=v"(r) : "v"(lo), "v"(hi)); return r; }
__device__ __forceinline__ u32x4 pack8(const f32x4& a, const f32x4& b) { u32x4 w; w.x = cvt_pk_bf16(a[0], a[1]); w.y = cvt_pk_bf16(a[2], a[3]); w.z = cvt_pk_bf16(b[0], b[1]); w.w = cvt_pk_bf16(b[2], b[3]); return w; }
struct MoeOrder : StaticOrder {
    const int* texp; size_t estride_bytes;
    __device__ __forceinline__ size_t boff(const Unit& u) const { return (size_t)texp[u.pm] * estride_bytes; }
};
struct EpiInprojF {
    static constexpr bool PERM = true, AFTER_DRAIN = false;
    bf16_t* P; const float2* rot; const float2* ret; int mode, pad;
    __device__ __forceinline__ void operator()(const f32x4 (&acc)[2][2][4][2], const Unit& u, int wr, int wc, int fr, int fq) const {
        int kind;
        if (mode == 0) kind = u.pn < 4 ? 1 : (u.pn < 6 ? 0 : (u.pn == 6 ? 2 : (u.pn == 7 ? 3 : 0)));
        else kind = u.pn < 8 ? 1 : 0;
        const int row0 = u.pm * BM + wr * 64 + fr;
#pragma unroll
        for (int ai = 0; ai < 2; ++ai)
#pragma unroll
            for (int m = 0; m < 4; ++m) {
                const int row = row0 + ai * HALF + m * 16, pos = row & (S - 1);
                bf16_t* rp = P + (size_t)row * PW + u.pn * BM;
                if (kind == 1) {
                    const f32x4* t = (const f32x4*)(rot + pos * 32 + 8 * fq);
                    f32x4 o1[2], o2[2];
#pragma unroll
                    for (int n = 0; n < 2; ++n) { const f32x4 ta = t[2 * n], tb = t[2 * n + 1]; const f32x4 x1 = acc[ai][0][m][n], x2 = acc[ai][1][m][n];
                        o1[n][0] = x1[0] * ta[0] - x2[0] * ta[1]; o2[n][0] = x1[0] * ta[1] + x2[0] * ta[0];
                        o1[n][1] = x1[1] * ta[2] - x2[1] * ta[3]; o2[n][1] = x1[1] * ta[3] + x2[1] * ta[2];
                        o1[n][2] = x1[2] * tb[0] - x2[2] * tb[1]; o2[n][2] = x1[2] * tb[1] + x2[2] * tb[0];
                        o1[n][3] = x1[3] * tb[2] - x2[3] * tb[3]; o2[n][3] = x1[3] * tb[3] + x2[3] * tb[2]; }
                    *(u32x4*)(rp + 64 * wc + 8 * fq) = pack8(o1[0], o1[1]);
                    *(u32x4*)(rp + 64 * wc + 32 + 8 * fq) = pack8(o2[0], o2[1]);
                } else if (kind >= 2) {
                    const f32x4* t = (const f32x4*)(ret + pos * 32 + 16 * (wc & 1) + 4 * fq);
                    const f32x4 ta = t[0], tb = t[1]; const float sc = kind == 3 ? 0.125f : 1.0f;
#pragma unroll
                    for (int bj = 0; bj < 2; ++bj) { const f32x4 x0 = acc[ai][bj][m][0], x1 = acc[ai][bj][m][1]; f32x4 o0, o1;
                        o0[0] = (x0[0] * ta[0] - x0[1] * ta[1]) * sc; o0[1] = (x0[0] * ta[1] + x0[1] * ta[0]) * sc;
                        o0[2] = (x0[2] * ta[2] - x0[3] * ta[3]) * sc; o0[3] = (x0[2] * ta[3] + x0[3] * ta[2]) * sc;
                        o1[0] = (x1[0] * tb[0] - x1[1] * tb[1]) * sc; o1[1] = (x1[0] * tb[1] + x1[1] * tb[0]) * sc;
                        o1[2] = (x1[2] * tb[2] - x1[3] * tb[3]) * sc; o1[3] = (x1[2] * tb[3] + x1[3] * tb[2]) * sc;
                        *(u32x4*)(rp + bj * HALF + 32 * wc + 8 * fq) = pack8(o0, o1); }
                } else {
#pragma unroll
                    for (int bj = 0; bj < 2; ++bj) *(u32x4*)(rp + bj * HALF + 32 * wc + 8 * fq) = pack8(acc[ai][bj][m][0], acc[ai][bj][m][1]);
                }
            }
    }
};
struct EpiOutprojF {
    static constexpr bool PERM = false, AFTER_DRAIN = false;
    const float* res; float* hout;
    __device__ __forceinline__ void operator()(const f32x4 (&acc)[2][2][4][2], const Unit& u, int wr, int wc, int fr, int fq) const {
        const int row0 = u.pm * BM + wr * 64 + fr, col0 = u.pn * BM + wc * 32 + 4 * fq;
#pragma unroll
        for (int ai = 0; ai < 2; ++ai)
#pragma unroll
            for (int m = 0; m < 4; ++m) { const size_t off = (size_t)(row0 + ai * HALF + m * 16) * D + col0;
#pragma unroll
                for (int bj = 0; bj < 2; ++bj)
#pragma unroll
                    for (int n = 0; n < 2; ++n) { const f32x4 r = *(const f32x4*)(res + off + bj * HALF + n * 16); *(f32x4*)(hout + off + bj * HALF + n * 16) = r + acc[ai][bj][m][n]; } }
    }
};
struct EpiMoe1F {
    static constexpr bool PERM = true, AFTER_DRAIN = false;
    bf16_t* Hs;
    __device__ __forceinline__ void operator()(const f32x4 (&acc)[2][2][4][2], const Unit& u, int wr, int wc, int fr, int fq) const {
        const int row0 = u.pm * BM + wr * 64 + fr;
#pragma unroll
        for (int ai = 0; ai < 2; ++ai)
#pragma unroll
            for (int m = 0; m < 4; ++m) { f32x4 o[2];
#pragma unroll
                for (int n = 0; n < 2; ++n)
#pragma unroll
                    for (int j = 0; j < 4; ++j) o[n][j] = silu(acc[ai][0][m][n][j]) * acc[ai][1][m][n][j];
                *(u32x4*)(Hs + (size_t)(row0 + ai * HALF + m * 16) * HID + u.pn * HALF + 32 * wc + 8 * fq) = pack8(o[0], o[1]); }
    }
};
struct EpiMoe2F {
    static constexpr bool PERM = true, AFTER_DRAIN = false;
    bf16_t* ys; const float* rowgate;
    __device__ __forceinline__ void operator()(const f32x4 (&acc)[2][2][4][2], const Unit& u, int wr, int wc, int fr, int fq) const {
        const int row0 = u.pm * BM + wr * 64 + fr;
#pragma unroll
        for (int ai = 0; ai < 2; ++ai)
#pragma unroll
            for (int m = 0; m < 4; ++m) { const int row = row0 + ai * HALF + m * 16; const float gt = rowgate[row];
#pragma unroll
                for (int bj = 0; bj < 2; ++bj) *(u32x4*)(ys + (size_t)row * D + u.pn * BM + bj * HALF + 32 * wc + 8 * fq) = pack8(acc[ai][bj][m][0] * gt, acc[ai][bj][m][1] * gt); }
    }
};

template <class Epi, class Sched, bool ALIGN_EPI = false, bool SP2 = false>
__device__ __forceinline__ void gemm_phase(PG8_LAS unsigned char* lds, const Gemm g, const Sched& S, const Epi& E) {
    const int wid = __builtin_amdgcn_readfirstlane(threadIdx.x >> 6), lane = my_lane(), tid = wid * 64 + lane, wr = wid >> 2, wc = wid & 3, fr = lane & 15, fq = lane >> 4;
    const int K = g.K, nt = K / BK;
    unsigned voffA[2], voffB[2];
#pragma unroll
    for (int i = 0; i < 2; ++i) { int R, C; stage_rc(tid * 16 + i * 8192, R, C); const int Rb = Epi::PERM ? ((R & ~31) + perm32(R & 31)) : R;
        voffA[i] = (unsigned)(R * K + C) * 2u; voffB[i] = (unsigned)(Rb * K + C) * 2u; }
    const size_t kstep = (size_t)(BK * 2);
    const size_t hstep = (size_t)HALF * K * 2;
    const size_t tstep = 2 * hstep;
    const unsigned ldsw = (unsigned)wid * 1024u;
    const int aoff = lds_byte(wr * 64 + fr, fq * 8), boff = lds_byte(wc * 32 + fr, fq * 8);
#define PG8_SA(b, h) (((b) * 2 + (h)) * HTB)
#define PG8_SB(b, h) ((4 + (b) * 2 + (h)) * HTB)
#define PG8_STAGE(bufoff, gbase, voff) do { _Pragma("unroll") for (int _i = 0; _i < 2; ++_i) \
        __builtin_amdgcn_global_load_lds((const unsigned*)((const char*)(gbase) + (voff)[_i]), (PG8_LAS unsigned*)(lds + (bufoff) + ldsw + _i * 8192), 16, 0, 0); } while (0)
#define PG8_LDA(dst, b, h) do { _Pragma("unroll") for (int m = 0; m < 4; ++m) _Pragma("unroll") for (int k = 0; k < 2; ++k) dst[m][k] = *(const PG8_LAS bf16x8*)(lds + PG8_SA(b, h) + aoff + m * 2048 + k * 1024); } while (0)
#define PG8_LDB(dst, b, h) do { _Pragma("unroll") for (int n = 0; n < 2; ++n) _Pragma("unroll") for (int k = 0; k < 2; ++k) dst[n][k] = *(const PG8_LAS bf16x8*)(lds + PG8_SB(b, h) + boff + n * 2048 + k * 1024); } while (0)
#define PG8_MMA(ai, bj, At, Bt) do { __builtin_amdgcn_s_setprio(1); _Pragma("unroll") for (int m = 0; m < 4; ++m) _Pragma("unroll") for (int n = 0; n < 2; ++n) _Pragma("unroll") for (int k = 0; k < 2; ++k) \
        acc[ai][bj][m][n] = __builtin_amdgcn_mfma_f32_16x16x32_bf16(Bt[n][k], At[m][k], acc[ai][bj][m][n], 0, 0, 0); __builtin_amdgcn_s_setprio(0); } while (0)
#define PG8_WAIT_V(n) asm volatile("s_waitcnt vmcnt(" #n ")" ::: "memory")
#define PG8_WAIT_L(n) asm volatile("s_waitcnt lgkmcnt(" #n ")" ::: "memory")
#define PG8_BAR __builtin_amdgcn_s_barrier()
#define PG8_SCHED __builtin_amdgcn_sched_barrier(0)
    Unit cur, nxt; int ui = 0;
    if (!S.next(0, cur)) return;
    f32x4 acc[2][2][4][2];
#pragma unroll
    for (int a = 0; a < 2; ++a)
#pragma unroll
        for (int b = 0; b < 2; ++b)
#pragma unroll
            for (int m = 0; m < 4; ++m)
#pragma unroll
                for (int n = 0; n < 2; ++n) acc[a][b][m][n] = (f32x4){0.f, 0.f, 0.f, 0.f};
    bf16x8 At[4][2], B0[2][2], B1[2][2];
    const char* cA = (const char*)g.A + (size_t)cur.pm * tstep; const char* cB = (const char*)g.Bt + (size_t)cur.pn * tstep + S.boff(cur);
    S.a_ready(cur);
    if constexpr (SP2) {
        PG8_STAGE(PG8_SB(0, 0), cB, voffB); PG8_STAGE(PG8_SB(0, 1), cB + hstep, voffB); PG8_STAGE(PG8_SA(0, 0), cA, voffA); PG8_STAGE(PG8_SA(0, 1), cA + hstep, voffA);
        if (wr == 1) PG8_BAR;
        PG8_WAIT_V(2); PG8_BAR;
        PG8_STAGE(PG8_SB(1, 0), cB + kstep, voffB); PG8_STAGE(PG8_SA(1, 0), cA + kstep, voffA); PG8_STAGE(PG8_SB(1, 1), cB + hstep + kstep, voffB);
        PG8_WAIT_V(6); PG8_BAR;
    } else {
        PG8_STAGE(PG8_SB(0, 0), cB, voffB); PG8_STAGE(PG8_SA(0, 0), cA, voffA); PG8_STAGE(PG8_SB(0, 1), cB + hstep, voffB); PG8_STAGE(PG8_SA(0, 1), cA + hstep, voffA);
        if (wr == 1) PG8_BAR;
        PG8_WAIT_V(4); PG8_BAR;
        PG8_STAGE(PG8_SB(1, 0), cB + kstep, voffB); PG8_STAGE(PG8_SA(1, 0), cA + kstep, voffA); PG8_STAGE(PG8_SB(1, 1), cB + hstep + kstep, voffB);
        PG8_WAIT_V(6); PG8_BAR;
    }
    for (;;) {
        const bool has_next = S.next(ui + 1, nxt);
        const char* nA = has_next ? (const char*)g.A + (size_t)nxt.pm * tstep : cA; const char* nB = has_next ? (const char*)g.Bt + (size_t)nxt.pn * tstep + S.boff(nxt) : cB;
        for (int t = 0; t < nt; t += 2) {
            const bool last = (t == nt - 2);
            const char* a1 = cA + (size_t)(t + 1) * kstep;
            const char* a2 = last ? nA : cA + (size_t)(t + 2) * kstep; const char* b2 = last ? nB : cB + (size_t)(t + 2) * kstep;
            const char* a3 = a2 + kstep; const char* b3 = b2 + kstep;
            if (last && has_next) S.a_ready(nxt);
            if constexpr (SP2) {
            PG8_LDB(B0, 0, 0); PG8_LDB(B1, 0, 1); PG8_SCHED; PG8_LDA(At, 0, 0); PG8_STAGE(PG8_SA(1, 1), a1 + hstep, voffA);
            PG8_WAIT_V(8); PG8_WAIT_L(0); PG8_BAR; PG8_MMA(0, 0, At, B0); PG8_MMA(0, 1, At, B1); PG8_BAR; PG8_SCHED;
            PG8_LDA(At, 0, 1); PG8_STAGE(PG8_SB(0, 0), b2, voffB); PG8_STAGE(PG8_SB(0, 1), b2 + hstep, voffB); PG8_STAGE(PG8_SA(0, 0), a2, voffA);
            PG8_WAIT_V(8); PG8_WAIT_L(0); PG8_BAR; PG8_MMA(1, 0, At, B0); PG8_MMA(1, 1, At, B1); PG8_BAR; PG8_SCHED;
            PG8_LDB(B0, 1, 0); PG8_LDB(B1, 1, 1); PG8_SCHED; PG8_LDA(At, 1, 0); PG8_STAGE(PG8_SA(0, 1), a2 + hstep, voffA);
            PG8_WAIT_V(8); PG8_WAIT_L(0); PG8_BAR; PG8_MMA(0, 0, At, B0); PG8_MMA(0, 1, At, B1); PG8_BAR; PG8_SCHED;
            PG8_LDA(At, 1, 1); PG8_STAGE(PG8_SB(1, 0), b3, voffB); PG8_STAGE(PG8_SB(1, 1), b3 + hstep, voffB); PG8_STAGE(PG8_SA(1, 0), a3, voffA);
            PG8_WAIT_V(8); PG8_WAIT_L(0); PG8_BAR; PG8_MMA(1, 0, At, B0); PG8_MMA(1, 1, At, B1); PG8_BAR; PG8_SCHED;
            } else {
            PG8_LDB(B0, 0, 0); PG8_SCHED; PG8_LDA(At, 0, 0); PG8_STAGE(PG8_SA(1, 1), a1 + hstep, voffA);
            PG8_WAIT_L(8); PG8_BAR; PG8_WAIT_L(0); PG8_MMA(0, 0, At, B0); PG8_BAR; PG8_SCHED;
            PG8_LDB(B1, 0, 1); PG8_STAGE(PG8_SB(0, 0), b2, voffB);
            PG8_BAR; PG8_WAIT_L(0); PG8_MMA(0, 1, At, B1); PG8_BAR;
            PG8_LDA(At, 0, 1); PG8_STAGE(PG8_SA(0, 0), a2, voffA);
            PG8_BAR; PG8_WAIT_L(0); PG8_MMA(1, 0, At, B0); PG8_BAR; PG8_SCHED;
            PG8_STAGE(PG8_SB(0, 1), b2 + hstep, voffB);
            PG8_WAIT_V(6); PG8_BAR; PG8_MMA(1, 1, At, B1); PG8_BAR;
            PG8_LDB(B0, 1, 0); PG8_SCHED; PG8_LDA(At, 1, 0); PG8_STAGE(PG8_SA(0, 1), a2 + hstep, voffA);
            PG8_WAIT_L(8); PG8_BAR; PG8_WAIT_L(0); PG8_MMA(0, 0, At, B0); PG8_BAR; PG8_SCHED;
            PG8_LDB(B1, 1, 1); PG8_STAGE(PG8_SB(1, 0), b3, voffB);
            PG8_BAR; PG8_WAIT_L(0); PG8_MMA(0, 1, At, B1); PG8_BAR;
            PG8_LDA(At, 1, 1); PG8_STAGE(PG8_SA(1, 0), a3, voffA);
            PG8_BAR; PG8_WAIT_L(0); PG8_MMA(1, 0, At, B0); PG8_BAR; PG8_SCHED;
            PG8_STAGE(PG8_SB(1, 1), b3 + hstep, voffB);
            PG8_WAIT_V(6); PG8_BAR; PG8_MMA(1, 1, At, B1); PG8_BAR;
            }
        }
        if constexpr (ALIGN_EPI) { if (wr == 0) PG8_BAR; }
        if constexpr (!Epi::AFTER_DRAIN) { E(acc, cur, wr, wc, fr, fq); S.done(cur); }
        if (!has_next) break;
#pragma unroll
        for (int a = 0; a < 2; ++a)
#pragma unroll
            for (int b = 0; b < 2; ++b)
#pragma unroll
                for (int m = 0; m < 4; ++m)
#pragma unroll
                    for (int n = 0; n < 2; ++n) acc[a][b][m][n] = (f32x4){0.f, 0.f, 0.f, 0.f};
        cur = nxt; cA = nA; cB = nB; ++ui;
        if constexpr (ALIGN_EPI) { if (wr == 1) PG8_BAR; }
    }
    PG8_WAIT_V(0);
    if constexpr (!ALIGN_EPI) { if (wr == 0) PG8_BAR; }
    PG8_BAR;
    if constexpr (Epi::AFTER_DRAIN) { E.fused(acc, cur, wr, wc, fr, fq, lds, wid, lane); S.done(cur); }
#undef PG8_SA
#undef PG8_SB
#undef PG8_STAGE
#undef PG8_LDA
#undef PG8_LDB
#undef PG8_MMA
#undef PG8_WAIT_V
#undef PG8_WAIT_L
#undef PG8_BAR
#undef PG8_SCHED
}
}

__device__ __forceinline__ void d_kmean(int vb, const bf16_t* __restrict__ P, float* __restrict__ kmean) {
    int i = vb * blockDim.x + threadIdx.x;
    if (i >= NB * 8 * 64 * 64) return;
    int d = i & 63, n = (i >> 6) & 63, h = (i >> 12) & 7, b = i >> 15;
    float s = 0.f;
    const bf16_t* p = P + ((size_t)(b * S + n * 256)) * PW + 512 + h * 64 + d;
    for (int j = 0; j < 256; ++j) s += bf2f(p[(size_t)j * PW]);
    kmean[i] = s * (1.0f / 256.0f);
}
__device__ __forceinline__ void soft_key(float& m, float& l, float* o, const float* q, const bf16_t* kr, const bf16_t* vr, float scale) {
    float s = 0.f;
#pragma unroll
    for (int c = 0; c < 8; ++c) { uint4 u = ((const uint4*)kr)[c]; const unsigned w[4] = {u.x, u.y, u.z, u.w};
#pragma unroll
        for (int t = 0; t < 4; ++t) { s += q[c * 8 + 2 * t] * __uint_as_float(w[t] << 16) + q[c * 8 + 2 * t + 1] * __uint_as_float(w[t] & 0xffff0000u); } }
    s *= scale;
    float mn = fmaxf(m, s), al = __expf(m - mn), p = __expf(s - mn);
    l = l * al + p; m = mn;
#pragma unroll
    for (int c = 0; c < 8; ++c) { uint4 u = ((const uint4*)vr)[c]; const unsigned w[4] = {u.x, u.y, u.z, u.w};
#pragma unroll
        for (int t = 0; t < 4; ++t) { o[c * 8 + 2 * t] = o[c * 8 + 2 * t] * al + p * __uint_as_float(w[t] << 16); o[c * 8 + 2 * t + 1] = o[c * 8 + 2 * t + 1] * al + p * __uint_as_float(w[t] & 0xffff0000u); } }
}
__device__ __forceinline__ void d_moba_naive(int vb, const bf16_t* __restrict__ P, const float* __restrict__ kmean, bf16_t* __restrict__ AO) {
    int i = vb * blockDim.x + threadIdx.x;
    if (i >= NB * 8 * S) return;
    int pos = i & (S - 1), h = (i >> 14) & 7, b = i >> 17;
    size_t tok = (size_t)b * S + pos;
    float q[64];
    { const bf16_t* qp = P + tok * PW + h * 64;
#pragma unroll
      for (int d = 0; d < 64; ++d) q[d] = bf2f(qp[d]); }
    int qb = pos >> 8;
    float bv[3] = {-INFINITY, -INFINITY, -INFINITY}; int bi[3] = {-1, -1, -1};
    const float* km = kmean + ((size_t)(b * 8 + h) * 64) * 64;
    for (int n = 0; n < qb; ++n) {
        float g = 0.f;
#pragma unroll
        for (int d = 0; d < 64; ++d) g += q[d] * km[n * 64 + d];
        if (g > bv[0]) { bv[2] = bv[1]; bi[2] = bi[1]; bv[1] = bv[0]; bi[1] = bi[0]; bv[0] = g; bi[0] = n; }
        else if (g > bv[1]) { bv[2] = bv[1]; bi[2] = bi[1]; bv[1] = g; bi[1] = n; }
        else if (g > bv[2]) { bv[2] = g; bi[2] = n; }
    }
    float m = -1e30f, l = 0.f, o[64];
#pragma unroll
    for (int d = 0; d < 64; ++d) o[d] = 0.f;
    const bf16_t* Kb = P + ((size_t)b * S) * PW + 512 + h * 64;
    const bf16_t* Vb = P + ((size_t)b * S) * PW + 1024 + h * 64;
    for (int key = qb * 256; key <= pos; ++key) soft_key(m, l, o, q, Kb + (size_t)key * PW, Vb + (size_t)key * PW, 0.125f);
    for (int s3 = 0; s3 < 3; ++s3) {
        if (bi[s3] < 0) continue;
        int k0 = bi[s3] * 256;
        for (int key = k0; key < k0 + 256; ++key) soft_key(m, l, o, q, Kb + (size_t)key * PW, Vb + (size_t)key * PW, 0.125f);
    }
    float il = 1.0f / l;
    bf16_t* op = AO + tok * D + h * 64;
#pragma unroll
    for (int d = 0; d < 64; ++d) op[d] = f2bf(o[d] * il);
}

__device__ __forceinline__ void d_dilated_naive(int vb, const bf16_t* __restrict__ P, bf16_t* __restrict__ AO) {
    int i = vb * blockDim.x + threadIdx.x;
    if (i >= NB * 16 * S) return;
    int pos = i & (S - 1), h = (i >> 14) & 15, b = i >> 18;
    size_t tok = (size_t)b * S + pos;
    float q[64];
    { const bf16_t* qp = P + tok * PW + h * 64;
#pragma unroll
      for (int d = 0; d < 64; ++d) q[d] = bf2f(qp[d]); }
    float m = -1e30f, l = 0.f, o[64];
#pragma unroll
    for (int d = 0; d < 64; ++d) o[d] = 0.f;
    const bf16_t* Kb = P + ((size_t)b * S) * PW + 1024 + h * 64;
    const bf16_t* Vb = P + ((size_t)b * S) * PW + 2048 + h * 64;
    for (int br = 0; br < 3; ++br) {
        int dil = br == 0 ? 1 : (br == 1 ? 4 : 16);
        for (int t = 0; t <= 128; ++t) {
            int key = pos - t * dil; if (key < 0) break;
            soft_key(m, l, o, q, Kb + (size_t)key * PW, Vb + (size_t)key * PW, 0.125f);
        }
    }
    float il = 1.0f / l;
    bf16_t* op = AO + tok * D + h * 64;
#pragma unroll
    for (int d = 0; d < 64; ++d) op[d] = f2bf(o[d] * il);
}

__device__ __forceinline__ float ret_loggamma(int h) { return logf(1.0f - exp2f(-5.0f - (float)h)); }
__device__ __forceinline__ void d_ret_state(int vb, const bf16_t* __restrict__ P, float* __restrict__ state) {
    size_t i = (size_t)vb * blockDim.x + threadIdx.x;
    if (i >= (size_t)NB * 4 * 128 * 64 * 128) return;
    int e = i & 127, d = (i >> 7) & 63, n = (i >> 13) & 127, h = (i >> 20) & 3, b = (int)(i >> 22);
    float lg = ret_loggamma(h);
    const bf16_t* kp = P + ((size_t)(b * S + n * 128)) * PW + 1792 + h * 64 + d;
    const bf16_t* vp = P + ((size_t)(b * S + n * 128)) * PW + 2048 + h * 128 + e;
    float s = 0.f;
    for (int j = 0; j < 128; ++j) s += bf2f(kp[(size_t)j * PW]) * __expf(lg * (float)(127 - j)) * bf2f(vp[(size_t)j * PW]);
    state[i] = s;
}
__device__ __forceinline__ void d_ret_scan(int vb, const float* __restrict__ state, float* __restrict__ rprev) {
    int i = vb * blockDim.x + threadIdx.x;
    if (i >= NB * 4 * 8192) return;
    int de = i & 8191, bh = i >> 13, h = bh & 3;
    float gc = __expf(ret_loggamma(h) * 128.0f), r = 0.f;
    for (int n = 0; n < 128; ++n) { size_t o = ((size_t)bh * 128 + n) * 8192 + de; rprev[o] = r; r = gc * r + state[o]; }
}
__device__ __forceinline__ void d_ret_out(int vb, const bf16_t* __restrict__ P, const float* __restrict__ rprev, bf16_t* __restrict__ AO) {
    int t = vb * blockDim.x + threadIdx.x;
    if (t >= NTOK * 16) return;
    int qt = t & 3, h = (t >> 2) & 3, tok = t >> 4, b = tok >> 14, pos = tok & (S - 1), ii = pos & 127, n = pos >> 7;
    float lg = ret_loggamma(h);
    float q[64];
    { const bf16_t* qp = P + (size_t)tok * PW + 1536 + h * 64;
#pragma unroll
      for (int d = 0; d < 64; ++d) q[d] = bf2f(qp[d]); }
    float acc[32];
#pragma unroll
    for (int e = 0; e < 32; ++e) acc[e] = 0.f;
    const float* rp = rprev + ((size_t)(b * 4 + h) * 128 + n) * 8192 + qt * 32;
    { const bf16_t* qp = P + (size_t)tok * PW + 1536 + h * 64;
      for (int d = 0; d < 64; ++d) { float qd = bf2f(qp[d]);
#pragma unroll
        for (int e = 0; e < 32; ++e) acc[e] += qd * rp[d * 128 + e]; } }
    float sc = __expf(lg * (float)(ii + 1));
#pragma unroll
    for (int e = 0; e < 32; ++e) acc[e] *= sc;
    const bf16_t* Kb = P + (size_t)(tok - ii) * PW + 1792 + h * 64;
    const bf16_t* Vb = P + (size_t)(tok - ii) * PW + 2048 + h * 128 + qt * 32;
    for (int j = 0; j <= ii; ++j) {
        const bf16_t* kr = Kb + (size_t)j * PW; float s = 0.f;
#pragma unroll
        for (int d = 0; d < 64; ++d) s += q[d] * bf2f(kr[d]);
        s *= __expf(lg * (float)(ii - j));
        const bf16_t* vr = Vb + (size_t)j * PW;
#pragma unroll
        for (int e = 0; e < 32; ++e) acc[e] += s * bf2f(vr[e]);
    }
    float sum = 0.f;
#pragma unroll
    for (int e = 0; e < 32; ++e) sum += acc[e];
    sum += __shfl_xor(sum, 1); sum += __shfl_xor(sum, 2);
    float mu = sum * (1.0f / 128.0f), sq = 0.f;
#pragma unroll
    for (int e = 0; e < 32; ++e) { float dlt = acc[e] - mu; sq += dlt * dlt; }
    sq += __shfl_xor(sq, 1); sq += __shfl_xor(sq, 2);
    float rs = rsqrtf(sq * (1.0f / 128.0f) + EPS);
    const bf16_t* gp = P + (size_t)tok * PW + 2560 + h * 128 + qt * 32;
    bf16_t* op = AO + (size_t)tok * D + 512 + h * 128 + qt * 32;
#pragma unroll
    for (int e = 0; e < 32; ++e) op[e] = f2bf((acc[e] - mu) * rs * silu(bf2f(gp[e])));
}

__device__ __forceinline__ void d_router(int vb, const float* __restrict__ h, const float* __restrict__ gain, const float* __restrict__ wg, const float* __restrict__ bg,
                                               const float* __restrict__ wf, const float* __restrict__ bfine, bf16_t* __restrict__ xn, int2* __restrict__ toke, float2* __restrict__ tokg, unsigned* __restrict__ cnt) {
    int row = (vb * blockDim.x + threadIdx.x) >> 6, lane = threadIdx.x & 63;
    if (row >= NTOK) return;
    const float4* xr = (const float4*)(h + (size_t)row * D);
    float4 v[4]; float ss = 0.f;
#pragma unroll
    for (int j = 0; j < 4; ++j) { v[j] = xr[64 * j + lane]; ss += v[j].x * v[j].x + v[j].y * v[j].y + v[j].z * v[j].z + v[j].w * v[j].w; }
    ss = wave_sum(ss);
    float rstd = rsqrtf(ss * (1.0f / D) + EPS);
    float xv[16];
#pragma unroll
    for (int j = 0; j < 4; ++j) {
        float4 g = ((const float4*)gain)[64 * j + lane];
        xv[4 * j] = v[j].x * rstd * g.x; xv[4 * j + 1] = v[j].y * rstd * g.y; xv[4 * j + 2] = v[j].z * rstd * g.z; xv[4 * j + 3] = v[j].w * rstd * g.w;
        ushort4 o; o.x = f2bf(xv[4 * j]); o.y = f2bf(xv[4 * j + 1]); o.z = f2bf(xv[4 * j + 2]); o.w = f2bf(xv[4 * j + 3]);
        ((ushort4*)(xn + (size_t)row * D))[64 * j + lane] = o;
    }
    float gl[4] = {0.f, 0.f, 0.f, 0.f};
#pragma unroll
    for (int j = 0; j < 4; ++j)
#pragma unroll
        for (int c = 0; c < 4; ++c) { int k = (64 * j + lane) * 4 + c; float4 w = ((const float4*)wg)[k];
            gl[0] += xv[4 * j + c] * w.x; gl[1] += xv[4 * j + c] * w.y; gl[2] += xv[4 * j + c] * w.z; gl[3] += xv[4 * j + c] * w.w; }
#pragma unroll
    for (int c = 0; c < 4; ++c) gl[c] = wave_sum(gl[c]) + bg[c];
    int grp = 0; float gm = gl[0];
#pragma unroll
    for (int c = 1; c < 4; ++c) if (gl[c] > gm) { gm = gl[c]; grp = c; }
    float gs = 0.f;
#pragma unroll
    for (int c = 0; c < 4; ++c) gs += __expf(gl[c] - gm);
    float gval = 1.0f / gs;
    float fl[8] = {0.f, 0.f, 0.f, 0.f, 0.f, 0.f, 0.f, 0.f};
#pragma unroll
    for (int j = 0; j < 4; ++j)
#pragma unroll
        for (int c = 0; c < 4; ++c) { int k = (64 * j + lane) * 4 + c; const float4* w = (const float4*)(wf + (size_t)k * 32 + grp * 8);
            float4 w0 = w[0], w1 = w[1]; float x = xv[4 * j + c];
            fl[0] += x * w0.x; fl[1] += x * w0.y; fl[2] += x * w0.z; fl[3] += x * w0.w; fl[4] += x * w1.x; fl[5] += x * w1.y; fl[6] += x * w1.z; fl[7] += x * w1.w; }
#pragma unroll
    for (int c = 0; c < 8; ++c) fl[c] = wave_sum(fl[c]) + bfine[grp * 8 + c];
    int i0 = 0; float v0 = fl[0];
#pragma unroll
    for (int c = 1; c < 8; ++c) if (fl[c] > v0) { v0 = fl[c]; i0 = c; }
    int i1 = -1; float v1 = -INFINITY;
#pragma unroll
    for (int c = 0; c < 8; ++c) if (c != i0 && fl[c] > v1) { v1 = fl[c]; i1 = c; }
    float w0 = 1.0f / (1.0f + __expf(v1 - v0)), w1 = 1.0f - w0;
    if (lane == 0) {
        int e0 = grp * 8 + i0, e1 = grp * 8 + i1;
        toke[row] = make_int2(e0, e1); tokg[row] = make_float2(gval * w0, gval * w1);
        atomicAdd(&cnt[e0], 1u); atomicAdd(&cnt[e1], 1u);
    }
}
__device__ __forceinline__ void d_moe_plan(int vb, const unsigned* cnt, unsigned* pst, unsigned* ntiles, int* texp) {
    if (threadIdx.x != 0 || vb != 0) return;
    unsigned p = 0;
    for (int e = 0; e < NEXP; ++e) { pst[e] = p; unsigned pad = ((cnt[e] + 255u) / 256u) * 256u; for (unsigned t = p / 256; t < (p + pad) / 256; ++t) texp[t] = e; p += pad; }
    pst[NEXP] = p; ntiles[0] = p / 256;
}
__device__ __forceinline__ void d_combine(int vb, float* __restrict__ h, const bf16_t* __restrict__ ys, const int2* __restrict__ pos, const float* __restrict__ gain, bf16_t* __restrict__ xn, int final) {
    int row = (vb * blockDim.x + threadIdx.x) >> 6, lane = threadIdx.x & 63;
    if (row >= NTOK) return;
    int2 p = pos[row];
    float4* xr = (float4*)(h + (size_t)row * D);
    const ushort4* y0 = (const ushort4*)(ys + (size_t)p.x * D); const ushort4* y1 = (const ushort4*)(ys + (size_t)p.y * D);
    float4 v[4]; float ss = 0.f;
#pragma unroll
    for (int j = 0; j < 4; ++j) { v[j] = xr[64 * j + lane]; ushort4 a = y0[64 * j + lane], c = y1[64 * j + lane];
        v[j].x += bf2f(a.x) + bf2f(c.x); v[j].y += bf2f(a.y) + bf2f(c.y); v[j].z += bf2f(a.z) + bf2f(c.z); v[j].w += bf2f(a.w) + bf2f(c.w);
        ss += v[j].x * v[j].x + v[j].y * v[j].y + v[j].z * v[j].z + v[j].w * v[j].w; }
    ss = wave_sum(ss);
    float rstd = rsqrtf(ss * (1.0f / D) + EPS);
#pragma unroll
    for (int j = 0; j < 4; ++j) {
        float4 g = ((const float4*)gain)[64 * j + lane];
        float4 o = make_float4(v[j].x * rstd * g.x, v[j].y * rstd * g.y, v[j].z * rstd * g.z, v[j].w * rstd * g.w);
        if (final) xr[64 * j + lane] = o;
        else { xr[64 * j + lane] = v[j]; ushort4 ob; ob.x = f2bf(o.x); ob.y = f2bf(o.y); ob.z = f2bf(o.z); ob.w = f2bf(o.w); ((ushort4*)(xn + (size_t)row * D))[64 * j + lane] = ob; }
    }
}

__device__ __forceinline__ void d_moe_scatter_gather(int tok, int lane, const int2* toke, const float2* tokg, const unsigned* pst, unsigned* cur, float* rowgate, int2* pos, const bf16_t* __restrict__ xn, bf16_t* __restrict__ xs) {
    int2 e = toke[tok]; float2 g = tokg[tok];
    unsigned d0 = 0, d1 = 0;
    if (lane == 0) { d0 = pst[e.x] + atomicAdd(&cur[e.x], 1u); d1 = pst[e.y] + atomicAdd(&cur[e.y], 1u); rowgate[d0] = g.x; rowgate[d1] = g.y; pos[tok] = make_int2((int)d0, (int)d1); }
    d0 = __shfl(d0, 0); d1 = __shfl(d1, 0);
    const uint4* src = (const uint4*)(xn + (size_t)tok * D);
    uint4 a = src[lane], b = src[lane + 64];
    uint4* o0 = (uint4*)(xs + (size_t)d0 * D); uint4* o1 = (uint4*)(xs + (size_t)d1 * D);
    o0[lane] = a; o0[lane + 64] = b; o1[lane] = a; o1[lane + 64] = b;
}

#define LAS __attribute__((address_space(3)))
__device__ __forceinline__ unsigned pk2(float lo, float hi) { return (unsigned)f2bf(lo) | ((unsigned)f2bf(hi) << 16); }
__device__ __forceinline__ void transpose_item(const float* __restrict__ W, int ldw, int k0, int c0, bf16_t* __restrict__ dst  , int K, LAS float* scr, int lane) {
#pragma unroll 8
    for (int i = 0; i < 32; ++i) { const int kk = 2 * i + (lane >> 5); scr[kk * 33 + (lane & 31)] = W[(size_t)(k0 + kk) * ldw + c0 + (lane & 31)]; }
    asm volatile("s_waitcnt lgkmcnt(0)" ::: "memory");
    const int c = lane & 7;
#pragma unroll
    for (int j = 0; j < 4; ++j) { const int n = (lane >> 3) + 8 * j; const LAS float* s = scr + (8 * c) * 33 + n;
        uint4 o; o.x = pk2(s[0 * 33], s[1 * 33]); o.y = pk2(s[2 * 33], s[3 * 33]); o.z = pk2(s[4 * 33], s[5 * 33]); o.w = pk2(s[6 * 33], s[7 * 33]);
        *(uint4*)(dst + (size_t)n * K + k0 + 8 * c) = o; }
    asm volatile("s_waitcnt lgkmcnt(0)" ::: "memory");
}
__device__ __forceinline__ void tr_inproj(int it, const float* W, bf16_t* WT, int layer, LAS float* scr, int lane) {
    const int kb = it / 96, g = it % 96, pn = g >> 3, q = g & 7, bj = q >> 2, wc = q & 3;
    const bool rotary = layer == 0 ? (pn < 4) : (pn < 8);
    const int c0 = rotary ? 256 * pn + 64 * wc + 32 * bj : 32 * g;
    transpose_item(W, PW, 64 * kb, c0, WT + (size_t)(32 * g) * D, D, scr, lane);
}
__device__ __forceinline__ void tr_outproj(int it, const float* W, bf16_t* WT, LAS float* scr, int lane) {
    const int kb = it / 32, g = it % 32;
    transpose_item(W, D, 64 * kb, 32 * g, WT + (size_t)(32 * g) * D, D, scr, lane);
}
__device__ __forceinline__ void tr_expert(int it, const float* wg, const float* wu, const float* wd, bf16_t* WE, LAS float* scr, int lane) {
    const int e = it / 768, r = it % 768;
    bf16_t* base = WE + (size_t)e * WEXP_E;
    if (r < 512) { const int kb = r / 32, g = r % 32, pn = g >> 3, q = g & 7, bj = q >> 2, wc = q & 3;
        const float* W = (bj ? wu : wg) + (size_t)e * D * HID;
        transpose_item(W, HID, 64 * kb, 128 * pn + 32 * wc, base + (size_t)(32 * g) * D, D, scr, lane);
    } else { const int r2 = r - 512, kb = r2 / 32, g = r2 % 32;
        transpose_item(wd + (size_t)e * HID * D, D, 64 * kb, 32 * g, base + (size_t)D * D + (size_t)(32 * g) * HID, HID, scr, lane); }
}

struct Params {
    const float *x, *mix_norm_even, *w_in_even, *w_out_even, *mix_norm_odd, *w_in_odd, *w_out_odd, *ffn_norm, *w_rg, *b_rg, *w_re, *b_re, *w_eg, *w_eu, *w_ed, *final_norm;
    float* hbuf; unsigned char* ws;
};
#define FOR_VB(n) for (int vb = blockIdx.x; vb < (int)(n); vb += gridDim.x)
constexpr int LDS_BYTES = 147456;

template <class Epi>
__device__ __forceinline__ void run_gemm(PG8_LAS unsigned char* lds, const bf16_t* A, const bf16_t* Bt, int M, int N, int K, const Epi& E) {
    pg8::Gemm g{A, Bt, M, N, K}; pg8::StaticOrder S_; S_.init(M, N, (int)gridDim.x, (int)blockIdx.x);
    pg8::gemm_phase<Epi, pg8::StaticOrder, true, true>(lds, g, S_, E);
}

__device__ __forceinline__ void moe_phases(const Params& p, cg::grid_group& grid, PG8_LAS unsigned char* lds, int layer) {
    unsigned char* ws = p.ws; unsigned* ctl = (unsigned*)(ws + WS_CTL);
    unsigned* cnt = ctl + CW_CNT + 32 * layer; unsigned* cur = ctl + CW_CUR + 32 * layer; unsigned* pst = ctl + CW_PST + 40 * layer;
    unsigned* ntl = ctl + CW_NT + layer; int* texp = (int*)(ctl + CW_TEXP + 320 * layer);
    float* rowgate = (float*)(ctl + CW_ROWGATE + layer * MP_MAX);
    int2* toke = (int2*)(ws + WS_TOKE); float2* tokg = (float2*)(ws + WS_TOKG); int2* pos = (int2*)(ws + WS_POS);
    bf16_t* xn = (bf16_t*)(ws + WS_XN); bf16_t* big = (bf16_t*)(ws + WS_BIG); bf16_t* hs = (bf16_t*)(ws + WS_HS);
    const bf16_t* wexp = (const bf16_t*)(ws + WS_WEXP);
    const int lane = my_lane(), wave = __builtin_amdgcn_readfirstlane(threadIdx.x >> 6);
    FOR_VB(NTOK * 64 / NTH) d_router(vb, p.hbuf, p.ffn_norm + layer * D, p.w_rg + (size_t)layer * D * 4, p.b_rg + layer * 4, p.w_re + (size_t)layer * D * 32, p.b_re + layer * 32, xn, toke, tokg, cnt);
    grid.sync();
    if (blockIdx.x == 0) d_moe_plan(0, cnt, pst, ntl, texp);
    grid.sync();
    for (int tok = blockIdx.x * NWAVES + wave; tok < NTOK; tok += gridDim.x * NWAVES) d_moe_scatter_gather(tok, lane, toke, tokg, pst, cur, rowgate, pos, xn, big);
    grid.sync();
    const int mp = (int)ntl[0] * 256;
    { pg8::Gemm g{big, wexp, mp, 1024, D}; pg8::MoeOrder S_; S_.init(mp, 1024, (int)gridDim.x, (int)blockIdx.x); S_.texp = texp; S_.estride_bytes = WEXP_E * 2;
      pg8::EpiMoe1F E{hs};
      pg8::gemm_phase<pg8::EpiMoe1F, pg8::MoeOrder, true, true>(lds, g, S_, E); }
    grid.sync();
    { pg8::Gemm g{hs, wexp + (size_t)D * D, mp, D, HID}; pg8::MoeOrder S_; S_.init(mp, D, (int)gridDim.x, (int)blockIdx.x); S_.texp = texp; S_.estride_bytes = WEXP_E * 2;
      pg8::EpiMoe2F E{big, rowgate};
      pg8::gemm_phase<pg8::EpiMoe2F, pg8::MoeOrder, true, true>(lds, g, S_, E); }
    grid.sync();
}

__global__ void __launch_bounds__(NTH, 2) mega(Params p) {
    extern __shared__ __attribute__((aligned(16))) unsigned char lds_raw[];
    PG8_LAS unsigned char* lds = (PG8_LAS unsigned char*)lds_raw;
    cg::grid_group grid = cg::this_grid();
    unsigned char* ws = p.ws;
    float2* rot = (float2*)(ws + WS_ROT); float2* ret = (float2*)(ws + WS_RET);
    float* kmean = (float*)(ws + WS_KMEAN);
    int2* pos = (int2*)(ws + WS_POS);
    float* rstate = (float*)(ws + WS_RSTATE); float* rprev = (float*)(ws + WS_RPREV);
    bf16_t* xn = (bf16_t*)(ws + WS_XN); bf16_t* ao = (bf16_t*)(ws + WS_AO); bf16_t* big = (bf16_t*)(ws + WS_BIG);
    bf16_t* win0 = (bf16_t*)(ws + WS_WIN0); bf16_t* wout0 = (bf16_t*)(ws + WS_WOUT0); bf16_t* win1 = (bf16_t*)(ws + WS_WIN1); bf16_t* wout1 = (bf16_t*)(ws + WS_WOUT1);
    bf16_t* wexp = (bf16_t*)(ws + WS_WEXP);
    float* hbuf = p.hbuf;
    const int wave = __builtin_amdgcn_readfirstlane(threadIdx.x >> 6);
    const int gw = blockIdx.x * NWAVES + wave, NGW = gridDim.x * NWAVES;
    const int lane = my_lane();
    LAS float* scr = (LAS float*)(lds + wave * 8448);

    FOR_VB(S * 32 / NTH) d_tables(vb, rot, ret);
    for (int it = gw; it < 1536 + 512 + 1536 + 512 + 24576; it += NGW) {
        int r = it;
        if (r < 1536) { tr_inproj(r, p.w_in_even, win0, 0, scr, lane); continue; } r -= 1536;
        if (r < 512) { tr_outproj(r, p.w_out_even, wout0, scr, lane); continue; } r -= 512;
        if (r < 1536) { tr_inproj(r, p.w_in_odd, win1, 1, scr, lane); continue; } r -= 1536;
        if (r < 512) { tr_outproj(r, p.w_out_odd, wout1, scr, lane); continue; } r -= 512;
        tr_expert(r, p.w_eg, p.w_eu, p.w_ed, wexp, scr, lane);
    }
    FOR_VB(NTOK * 64 / NTH) d_rmsnorm(vb, p.x, p.mix_norm_even, xn);
    grid.sync();
    { pg8::EpiInprojF E{big, rot, ret, 0, 0}; run_gemm(lds, xn, win0, NTOK, PW, D, E); }
    grid.sync();
    FOR_VB(NB * 8 * 64 * 64 / NTH) d_kmean(vb, big, kmean);
    FOR_VB(NB * 4 * 128 * 64 * 128 / NTH) d_ret_state(vb, big, rstate);
    grid.sync();
    FOR_VB(NB * 4 * 8192 / NTH) d_ret_scan(vb, rstate, rprev);
    FOR_VB(NB * 8 * S / NTH) d_moba_naive(vb, big, kmean, ao);
    grid.sync();
    FOR_VB(NTOK * 16 / NTH) d_ret_out(vb, big, rprev, ao);
    grid.sync();
    { pg8::EpiOutprojF E{p.x, hbuf}; run_gemm(lds, ao, wout0, NTOK, D, D, E); }
    grid.sync();
    moe_phases(p, grid, lds, 0);
    FOR_VB(NTOK * 64 / NTH) d_combine(vb, hbuf, big, pos, p.mix_norm_odd, xn, 0);
    { const int lane2 = my_lane(); LAS float* scr2 = (LAS float*)(lds + __builtin_amdgcn_readfirstlane(threadIdx.x >> 6) * 8448);
      for (int it = gw; it < 24576; it += NGW) tr_expert(it, p.w_eg + (size_t)NEXP * D * HID, p.w_eu + (size_t)NEXP * D * HID, p.w_ed + (size_t)NEXP * HID * D, wexp, scr2, lane2); }
    grid.sync();
    { pg8::EpiInprojF E{big, rot, ret, 1, 0}; run_gemm(lds, xn, win1, NTOK, PW, D, E); }
    grid.sync();
    FOR_VB(NB * 16 * S / NTH) d_dilated_naive(vb, big, ao);
    grid.sync();
    { pg8::EpiOutprojF E{hbuf, hbuf}; run_gemm(lds, ao, wout1, NTOK, D, D, E); }
    grid.sync();
    moe_phases(p, grid, lds, 1);
    FOR_VB(NTOK * 64 / NTH) d_combine(vb, hbuf, big, pos, p.final_norm, xn, 1);
}

extern "C" void kernel_launch(void* const* d_in, const int* in_sizes, int n_in, void* d_out, int out_size, void* d_ws, size_t ws_size, hipStream_t stream) {
    if (n_in != 16 || ws_size < WS_END || out_size != NTOK * D) { fprintf(stderr, "kernel_launch: unexpected sizes n_in %d ws %zu out %d\n", n_in, ws_size, out_size); return; }
    static int grid_blocks = 0;
    if (!grid_blocks) {
        int dev = 0, cus = 0, per_cu = 0;
        (void)hipGetDevice(&dev);
        (void)hipDeviceGetAttribute(&cus, hipDeviceAttributeMultiprocessorCount, dev);
        (void)hipFuncSetAttribute((const void*)mega, hipFuncAttributeMaxDynamicSharedMemorySize, LDS_BYTES);
        (void)hipOccupancyMaxActiveBlocksPerMultiprocessor(&per_cu, mega, NTH, LDS_BYTES);
        if (per_cu < 1) per_cu = 1;
        grid_blocks = cus * per_cu;
        fprintf(stderr, "kernel_launch: cus %d per_cu %d grid %d\n", cus, per_cu, grid_blocks);
    }
    Params p{};
    const float** pp = (const float**)&p;
    for (int i = 0; i < 16; ++i) pp[i] = (const float*)d_in[i];
    p.hbuf = (float*)d_out; p.ws = (unsigned char*)d_ws;
    (void)hipMemsetAsync((unsigned char*)d_ws + WS_CTL, 0, CTL_BYTES, stream);
    void* args[] = {&p};
    hipError_t e = hipLaunchCooperativeKernel((void*)mega, dim3(grid_blocks), dim3(NTH), args, LDS_BYTES, stream);
    if (e != hipSuccess) fprintf(stderr, "cooperative launch failed: %s (grid %d)\n", hipGetErrorString(e), grid_blocks);
}
```

```cpp
#include <hip/hip_runtime.h>
#include <hip/hip_cooperative_groups.h>
#include <cstdio>
#include <cstdint>
namespace cg = cooperative_groups;

typedef unsigned short bf16_t;
__device__ __forceinline__ float bf2f(bf16_t v) { return __uint_as_float(((unsigned)v) << 16); }
__device__ __forceinline__ bf16_t f2bf(float f) { unsigned u = __float_as_uint(f); return (bf16_t)((u + 0x7fffu + ((u >> 16) & 1u)) >> 16); }

constexpr int NB = 2, S = 16384, D = 1024, NTOK = NB * S;
constexpr int PW = 3072;
constexpr int NEXP = 32, HID = 512;
constexpr int MP_MAX = 2 * NTOK + NEXP * 256;
constexpr float EPS = 1e-6f;
constexpr int NTH = 512, NWAVES = 8;

constexpr size_t MiB = 1u << 20;
constexpr size_t WS_CTL = 0, CTL_BYTES = 2 * MiB;
constexpr size_t WS_ROT = 2 * MiB, WS_RET = 6 * MiB;
constexpr size_t WS_KMEAN = 10 * MiB;
constexpr size_t WS_TOKE = 12 * MiB, WS_TOKG = 13 * MiB, WS_POS = 14 * MiB;
constexpr size_t WS_WIN0 = 16 * MiB, WS_WOUT0 = 22 * MiB, WS_WIN1 = 24 * MiB, WS_WOUT1 = 30 * MiB;
constexpr size_t WS_WEXP = 32 * MiB;
constexpr size_t WEXP_E = 3 * MiB / 2;
constexpr size_t WS_XN = 128 * MiB, WS_AO = 128 * MiB;
constexpr size_t WS_BIG = 192 * MiB;
constexpr size_t WS_HS = 400 * MiB, WS_RSTATE = 400 * MiB, WS_RPREV = 432 * MiB;
constexpr size_t WS_DPO = 400 * MiB, WS_DPL = 528 * MiB;
constexpr size_t WS_END = 532 * MiB;
constexpr int CW_CNT = 0;
constexpr int CW_CUR = 64;
constexpr int CW_PST = 128;
constexpr int CW_NT = 256;
constexpr int CW_TEXP = 512;
constexpr int CW_ROWGATE = 4096;
static_assert((CW_ROWGATE + 2 * MP_MAX) * 4 <= (int)CTL_BYTES, "ctl");

__device__ __forceinline__ float wave_sum(float v) {
#pragma unroll
    for (int o = 32; o > 0; o >>= 1) v += __shfl_xor(v, o);
    return v;
}
#define LAS __attribute__((address_space(3)))
typedef unsigned u32x4_t __attribute__((ext_vector_type(4)));
__device__ __forceinline__ int my_lane() { int l; asm volatile("v_mbcnt_lo_u32_b32 %0, -1, 0\n\tv_mbcnt_hi_u32_b32 %0, -1, %0" : "=v"(l)); return l; }
__device__ __forceinline__ float silu(float x) { return x / (1.0f + __expf(-x)); }

__device__ __forceinline__ void d_tables(int vb, float2* rot, float2* ret) {
    int i = vb * blockDim.x + threadIdx.x;
    if (i >= S * 32) return;
    int pos = i >> 5, j = i & 31;
    float inv = 1.0f / powf(10000.0f, (float)j * (2.0f / 64.0f));
    float ang = (float)pos * inv;
    rot[i] = make_float2(cosf(ang), sinf(ang));
    float fr = 1.0f / powf(10000.0f, (float)j / 31.0f);
    float a2 = (float)pos * fr;
    ret[i] = make_float2(cosf(a2), sinf(a2));
}

__device__ __forceinline__ void d_rmsnorm(int vb, const float* __restrict__ src, const float* __restrict__ gain, bf16_t* __restrict__ xn) {
    int row = (vb * blockDim.x + threadIdx.x) >> 6, lane = threadIdx.x & 63;
    if (row >= NTOK) return;
    const float4* xr = (const float4*)(src + (size_t)row * D);
    float4 v[4]; float ss = 0.f;
#pragma unroll
    for (int j = 0; j < 4; ++j) { v[j] = xr[64 * j + lane]; ss += v[j].x * v[j].x + v[j].y * v[j].y + v[j].z * v[j].z + v[j].w * v[j].w; }
    ss = wave_sum(ss);
    float rstd = rsqrtf(ss * (1.0f / D) + EPS);
#pragma unroll
    for (int j = 0; j < 4; ++j) {
        float4 g = ((const float4*)gain)[64 * j + lane];
        ushort4 o; o.x = f2bf(v[j].x * rstd * g.x); o.y = f2bf(v[j].y * rstd * g.y); o.z = f2bf(v[j].z * rstd * g.z); o.w = f2bf(v[j].w * rstd * g.w);
        ((ushort4*)(xn + (size_t)row * D))[64 * j + lane] = o;
    }
}


namespace pg8 {
#define PG8_LAS __attribute__((address_space(3)))
typedef unsigned short bf16_t;
typedef short bf16x8 __attribute__((ext_vector_type(8)));
typedef float f32x4 __attribute__((ext_vector_type(4)));
typedef unsigned u32x4 __attribute__((ext_vector_type(4)));
constexpr int BM = 256, BK = 64, HALF = 128, HTB = HALF * BK * 2  , STAGE_BYTES = 8 * HTB, NXCD = 8, WGM = 8;

__host__ __device__ __forceinline__ int lds_byte(int r, int c) { const int st = (r >> 4) * 2 + (c >> 5), rr = r & 15, cc = c & 31, ob = rr * 64 + cc * 2; return st * 1024 + (ob ^ (((ob >> 9) & 1) << 5)); }
__host__ __device__ __forceinline__ void stage_rc(int b, int& R, int& C) { const int st = b / 1024, sb = b % 1024, swz = sb ^ (((sb >> 9) & 1) << 5); R = (st >> 1) * 16 + swz / 64; C = (st & 1) * 32 + (swz % 64) / 2; }
__host__ __device__ __forceinline__ int perm32(int rho) { const int n = rho >> 4, i = rho & 15; return 8 * (i >> 2) + 4 * n + (i & 3); }

struct Unit { int pm, pn; };
struct Gemm { const bf16_t* A; const bf16_t* Bt; int M, N, K; };

struct StaticOrder {
    int nM, nN, nwg, G, c;
    __host__ __device__ void init(int M, int N, int G_, int c_) { nM = M / BM; nN = N / BM; nwg = nM * nN; G = G_; c = c_; }
    __host__ __device__ bool next(int i, Unit& u) const {
        const long L = (long)i * G + c; if (L >= nwg) return false;
        int wgid = (int)L; { const int q = nwg / NXCD, r = nwg % NXCD, xcd = wgid % NXCD, off = wgid / NXCD; wgid = (xcd < r ? xcd * (q + 1) : r * (q + 1) + (xcd - r) * q) + off; }
        const int nig = WGM * nN, gid = wgid / nig, fm = gid * WGM, gsz = (nM - fm) < WGM ? (nM - fm) : WGM;
        u.pm = fm + ((wgid % nig) % gsz); u.pn = (wgid % nig) / gsz; return true;
    }
    __device__ __forceinline__ void a_ready(const Unit&) const {}
    __device__ __forceinline__ void done(const Unit&) const {}
    __device__ __forceinline__ size_t boff(const Unit&) const { return 0; }
};


__device__ __forceinline__ unsigned cvt_pk_bf16(float lo, float hi) { unsigned r; asm volatile("v_cvt_pk_bf16_f32 %0, %1, %2" : "=v"(r) : "v"(lo), "v"(hi)); return r; }
__device__ __forceinline__ u32x4 pack8(const f32x4& a, const f32x4& b) { u32x4 w; w.x = cvt_pk_bf16(a[0], a[1]); w.y = cvt_pk_bf16(a[2], a[3]); w.z = cvt_pk_bf16(b[0], b[1]); w.w = cvt_pk_bf16(b[2], b[3]); return w; }
struct MoeOrder : StaticOrder {
    const int* texp; size_t estride_bytes;
    __device__ __forceinline__ size_t boff(const Unit& u) const { return (size_t)texp[u.pm] * estride_bytes; }
};
struct EpiInprojF {
    static constexpr bool PERM = true, AFTER_DRAIN = false;
    bf16_t* P; const float2* rot; const float2* ret; int mode, pad;
    __device__ __forceinline__ void operator()(const f32x4 (&acc)[2][2][4][2], const Unit& u, int wr, int wc, int fr, int fq) const {
        int kind;
        if (mode == 0) kind = u.pn < 4 ? 1 : (u.pn < 6 ? 0 : (u.pn == 6 ? 2 : (u.pn == 7 ? 3 : 0)));
        else kind = u.pn < 8 ? 1 : 0;
        const int row0 = u.pm * BM + wr * 64 + fr;
#pragma unroll
        for (int ai = 0; ai < 2; ++ai)
#pragma unroll
            for (int m = 0; m < 4; ++m) {
                const int row = row0 + ai * HALF + m * 16, pos = row & (S - 1);
                bf16_t* rp = P + (size_t)row * PW + u.pn * BM;
                if (kind == 1) {
                    const f32x4* t = (const f32x4*)(rot + pos * 32 + 8 * fq);
                    f32x4 o1[2], o2[2];
#pragma unroll
                    for (int n = 0; n < 2; ++n) { const f32x4 ta = t[2 * n], tb = t[2 * n + 1]; const f32x4 x1 = acc[ai][0][m][n], x2 = acc[ai][1][m][n];
                        o1[n][0] = x1[0] * ta[0] - x2[0] * ta[1]; o2[n][0] = x1[0] * ta[1] + x2[0] * ta[0];
                        o1[n][1] = x1[1] * ta[2] - x2[1] * ta[3]; o2[n][1] = x1[1] * ta[3] + x2[1] * ta[2];
                        o1[n][2] = x1[2] * tb[0] - x2[2] * tb[1]; o2[n][2] = x1[2] * tb[1] + x2[2] * tb[0];
                        o1[n][3] = x1[3] * tb[2] - x2[3] * tb[3]; o2[n][3] = x1[3] * tb[3] + x2[3] * tb[2]; }
                    *(u32x4*)(rp + 64 * wc + 8 * fq) = pack8(o1[0], o1[1]);
                    *(u32x4*)(rp + 64 * wc + 32 + 8 * fq) = pack8(o2[0], o2[1]);
                } else if (kind >= 2) {
                    const f32x4* t = (const f32x4*)(ret + pos * 32 + 16 * (wc & 1) + 4 * fq);
                    const f32x4 ta = t[0], tb = t[1]; const float sc = kind == 3 ? 0.125f : 1.0f;
#pragma unroll
                    for (int bj = 0; bj < 2; ++bj) { const f32x4 x0 = acc[ai][bj][m][0], x1 = acc[ai][bj][m][1]; f32x4 o0, o1;
                        o0[0] = (x0[0] * ta[0] - x0[1] * ta[1]) * sc; o0[1] = (x0[0] * ta[1] + x0[1] * ta[0]) * sc;
                        o0[2] = (x0[2] * ta[2] - x0[3] * ta[3]) * sc; o0[3] = (x0[2] * ta[3] + x0[3] * ta[2]) * sc;
                        o1[0] = (x1[0] * tb[0] - x1[1] * tb[1]) * sc; o1[1] = (x1[0] * tb[1] + x1[1] * tb[0]) * sc;
                        o1[2] = (x1[2] * tb[2] - x1[3] * tb[3]) * sc; o1[3] = (x1[2] * tb[3] + x1[3] * tb[2]) * sc;
                        *(u32x4*)(rp + bj * HALF + 32 * wc + 8 * fq) = pack8(o0, o1); }
                } else {
#pragma unroll
                    for (int bj = 0; bj < 2; ++bj) *(u32x4*)(rp + bj * HALF + 32 * wc + 8 * fq) = pack8(acc[ai][bj][m][0], acc[ai][bj][m][1]);
                }
            }
    }
};
struct EpiOutprojF {
    static constexpr bool PERM = false, AFTER_DRAIN = false;
    const float* res; float* hout;
    __device__ __forceinline__ void operator()(const f32x4 (&acc)[2][2][4][2], const Unit& u, int wr, int wc, int fr, int fq) const {
        const int row0 = u.pm * BM + wr * 64 + fr, col0 = u.pn * BM + wc * 32 + 4 * fq;
#pragma unroll
        for (int ai = 0; ai < 2; ++ai)
#pragma unroll
            for (int m = 0; m < 4; ++m) { const size_t off = (size_t)(row0 + ai * HALF + m * 16) * D + col0;
#pragma unroll
                for (int bj = 0; bj < 2; ++bj)
#pragma unroll
                    for (int n = 0; n < 2; ++n) { const f32x4 r = *(const f32x4*)(res + off + bj * HALF + n * 16); *(f32x4*)(hout + off + bj * HALF + n * 16) = r + acc[ai][bj][m][n]; } }
    }
};
struct EpiMoe1F {
    static constexpr bool PERM = true, AFTER_DRAIN = false;
    bf16_t* Hs;
    __device__ __forceinline__ void operator()(const f32x4 (&acc)[2][2][4][2], const Unit& u, int wr, int wc, int fr, int fq) const {
        const int row0 = u.pm * BM + wr * 64 + fr;
#pragma unroll
        for (int ai = 0; ai < 2; ++ai)
#pragma unroll
            for (int m = 0; m < 4; ++m) { f32x4 o[2];
#pragma unroll
                for (int n = 0; n < 2; ++n)
#pragma unroll
                    for (int j = 0; j < 4; ++j) o[n][j] = silu(acc[ai][0][m][n][j]) * acc[ai][1][m][n][j];
                *(u32x4*)(Hs + (size_t)(row0 + ai * HALF + m * 16) * HID + u.pn * HALF + 32 * wc + 8 * fq) = pack8(o[0], o[1]); }
    }
};
struct EpiMoe2F {
    static constexpr bool PERM = true, AFTER_DRAIN = false;
    bf16_t* ys; const float* rowgate;
    __device__ __forceinline__ void operator()(const f32x4 (&acc)[2][2][4][2], const Unit& u, int wr, int wc, int fr, int fq) const {
        const int row0 = u.pm * BM + wr * 64 + fr;
#pragma unroll
        for (int ai = 0; ai < 2; ++ai)
#pragma unroll
            for (int m = 0; m < 4; ++m) { const int row = row0 + ai * HALF + m * 16; const float gt = rowgate[row];
#pragma unroll
                for (int bj = 0; bj < 2; ++bj) *(u32x4*)(ys + (size_t)row * D + u.pn * BM + bj * HALF + 32 * wc + 8 * fq) = pack8(acc[ai][bj][m][0] * gt, acc[ai][bj][m][1] * gt); }
    }
};

template <class Epi, class Sched, bool ALIGN_EPI = false, bool SP2 = false>
__device__ __forceinline__ void gemm_phase(PG8_LAS unsigned char* lds, const Gemm g, const Sched& S, const Epi& E) {
    const int wid = __builtin_amdgcn_readfirstlane(threadIdx.x >> 6), lane = my_lane(), tid = wid * 64 + lane, wr = wid >> 2, wc = wid & 3, fr = lane & 15, fq = lane >> 4;
    const int K = g.K, nt = K / BK;
    unsigned voffA[2], voffB[2];
#pragma unroll
    for (int i = 0; i < 2; ++i) { int R, C; stage_rc(tid * 16 + i * 8192, R, C); const int Rb = Epi::PERM ? ((R & ~31) + perm32(R & 31)) : R;
        voffA[i] = (unsigned)(R * K + C) * 2u; voffB[i] = (unsigned)(Rb * K + C) * 2u; }
    const size_t kstep = (size_t)(BK * 2);
    const size_t hstep = (size_t)HALF * K * 2;
    const size_t tstep = 2 * hstep;
    const unsigned ldsw = (unsigned)wid * 1024u;
    const int aoff = lds_byte(wr * 64 + fr, fq * 8), boff = lds_byte(wc * 32 + fr, fq * 8);
#define PG8_SA(b, h) (((b) * 2 + (h)) * HTB)
#define PG8_SB(b, h) ((4 + (b) * 2 + (h)) * HTB)
#define PG8_STAGE(bufoff, gbase, voff) do { _Pragma("unroll") for (int _i = 0; _i < 2; ++_i) \
        __builtin_amdgcn_global_load_lds((const unsigned*)((const char*)(gbase) + (voff)[_i]), (PG8_LAS unsigned*)(lds + (bufoff) + ldsw + _i * 8192), 16, 0, 0); } while (0)
#define PG8_LDA(dst, b, h) do { _Pragma("unroll") for (int m = 0; m < 4; ++m) _Pragma("unroll") for (int k = 0; k < 2; ++k) dst[m][k] = *(const PG8_LAS bf16x8*)(lds + PG8_SA(b, h) + aoff + m * 2048 + k * 1024); } while (0)
#define PG8_LDB(dst, b, h) do { _Pragma("unroll") for (int n = 0; n < 2; ++n) _Pragma("unroll") for (int k = 0; k < 2; ++k) dst[n][k] = *(const PG8_LAS bf16x8*)(lds + PG8_SB(b, h) + boff + n * 2048 + k * 1024); } while (0)
#define PG8_MMA(ai, bj, At, Bt) do { __builtin_amdgcn_s_setprio(1); _Pragma("unroll") for (int m = 0; m < 4; ++m) _Pragma("unroll") for (int n = 0; n < 2; ++n) _Pragma("unroll") for (int k = 0; k < 2; ++k) \
        acc[ai][bj][m][n] = __builtin_amdgcn_mfma_f32_16x16x32_bf16(Bt[n][k], At[m][k], acc[ai][bj][m][n], 0, 0, 0); __builtin_amdgcn_s_setprio(0); } while (0)
#define PG8_WAIT_V(n) asm volatile("s_waitcnt vmcnt(" #n ")" ::: "memory")
#define PG8_WAIT_L(n) asm volatile("s_waitcnt lgkmcnt(" #n ")" ::: "memory")
#define PG8_BAR __builtin_amdgcn_s_barrier()
#define PG8_SCHED __builtin_amdgcn_sched_barrier(0)
    Unit cur, nxt; int ui = 0;
    if (!S.next(0, cur)) return;
    f32x4 acc[2][2][4][2];
#pragma unroll
    for (int a = 0; a < 2; ++a)
#pragma unroll
        for (int b = 0; b < 2; ++b)
#pragma unroll
            for (int m = 0; m < 4; ++m)
#pragma unroll
                for (int n = 0; n < 2; ++n) acc[a][b][m][n] = (f32x4){0.f, 0.f, 0.f, 0.f};
    bf16x8 At[4][2], B0[2][2], B1[2][2];
    const char* cA = (const char*)g.A + (size_t)cur.pm * tstep; const char* cB = (const char*)g.Bt + (size_t)cur.pn * tstep + S.boff(cur);
    S.a_ready(cur);
    if constexpr (SP2) {
        PG8_STAGE(PG8_SB(0, 0), cB, voffB); PG8_STAGE(PG8_SB(0, 1), cB + hstep, voffB); PG8_STAGE(PG8_SA(0, 0), cA, voffA); PG8_STAGE(PG8_SA(0, 1), cA + hstep, voffA);
        if (wr == 1) PG8_BAR;
        PG8_WAIT_V(2); PG8_BAR;
        PG8_STAGE(PG8_SB(1, 0), cB + kstep, voffB); PG8_STAGE(PG8_SA(1, 0), cA + kstep, voffA); PG8_STAGE(PG8_SB(1, 1), cB + hstep + kstep, voffB);
        PG8_WAIT_V(6); PG8_BAR;
    } else {
        PG8_STAGE(PG8_SB(0, 0), cB, voffB); PG8_STAGE(PG8_SA(0, 0), cA, voffA); PG8_STAGE(PG8_SB(0, 1), cB + hstep, voffB); PG8_STAGE(PG8_SA(0, 1), cA + hstep, voffA);
        if (wr == 1) PG8_BAR;
        PG8_WAIT_V(4); PG8_BAR;
        PG8_STAGE(PG8_SB(1, 0), cB + kstep, voffB); PG8_STAGE(PG8_SA(1, 0), cA + kstep, voffA); PG8_STAGE(PG8_SB(1, 1), cB + hstep + kstep, voffB);
        PG8_WAIT_V(6); PG8_BAR;
    }
    for (;;) {
        const bool has_next = S.next(ui + 1, nxt);
        const char* nA = has_next ? (const char*)g.A + (size_t)nxt.pm * tstep : cA; const char* nB = has_next ? (const char*)g.Bt + (size_t)nxt.pn * tstep + S.boff(nxt) : cB;
        for (int t = 0; t < nt; t += 2) {
            const bool last = (t == nt - 2);
            const char* a1 = cA + (size_t)(t + 1) * kstep;
            const char* a2 = last ? nA : cA + (size_t)(t + 2) * kstep; const char* b2 = last ? nB : cB + (size_t)(t + 2) * kstep;
            const char* a3 = a2 + kstep; const char* b3 = b2 + kstep;
            if (last && has_next) S.a_ready(nxt);
            if constexpr (SP2) {
            PG8_LDB(B0, 0, 0); PG8_LDB(B1, 0, 1); PG8_SCHED; PG8_LDA(At, 0, 0); PG8_STAGE(PG8_SA(1, 1), a1 + hstep, voffA);
            PG8_WAIT_V(8); PG8_WAIT_L(0); PG8_BAR; PG8_MMA(0, 0, At, B0); PG8_MMA(0, 1, At, B1); PG8_BAR; PG8_SCHED;
            PG8_LDA(At, 0, 1); PG8_STAGE(PG8_SB(0, 0), b2, voffB); PG8_STAGE(PG8_SB(0, 1), b2 + hstep, voffB); PG8_STAGE(PG8_SA(0, 0), a2, voffA);
            PG8_WAIT_V(8); PG8_WAIT_L(0); PG8_BAR; PG8_MMA(1, 0, At, B0); PG8_MMA(1, 1, At, B1); PG8_BAR; PG8_SCHED;
            PG8_LDB(B0, 1, 0); PG8_LDB(B1, 1, 1); PG8_SCHED; PG8_LDA(At, 1, 0); PG8_STAGE(PG8_SA(0, 1), a2 + hstep, voffA);
            PG8_WAIT_V(8); PG8_WAIT_L(0); PG8_BAR; PG8_MMA(0, 0, At, B0); PG8_MMA(0, 1, At, B1); PG8_BAR; PG8_SCHED;
            PG8_LDA(At, 1, 1); PG8_STAGE(PG8_SB(1, 0), b3, voffB); PG8_STAGE(PG8_SB(1, 1), b3 + hstep, voffB); PG8_STAGE(PG8_SA(1, 0), a3, voffA);
            PG8_WAIT_V(8); PG8_WAIT_L(0); PG8_BAR; PG8_MMA(1, 0, At, B0); PG8_MMA(1, 1, At, B1); PG8_BAR; PG8_SCHED;
            } else {
            PG8_LDB(B0, 0, 0); PG8_SCHED; PG8_LDA(At, 0, 0); PG8_STAGE(PG8_SA(1, 1), a1 + hstep, voffA);
            PG8_WAIT_L(8); PG8_BAR; PG8_WAIT_L(0); PG8_MMA(0, 0, At, B0); PG8_BAR; PG8_SCHED;
            PG8_LDB(B1, 0, 1); PG8_STAGE(PG8_SB(0, 0), b2, voffB);
            PG8_BAR; PG8_WAIT_L(0); PG8_MMA(0, 1, At, B1); PG8_BAR;
            PG8_LDA(At, 0, 1); PG8_STAGE(PG8_SA(0, 0), a2, voffA);
            PG8_BAR; PG8_WAIT_L(0); PG8_MMA(1, 0, At, B0); PG8_BAR; PG8_SCHED;
            PG8_STAGE(PG8_SB(0, 1), b2 + hstep, voffB);
            PG8_WAIT_V(6); PG8_BAR; PG8_MMA(1, 1, At, B1); PG8_BAR;
            PG8_LDB(B0, 1, 0); PG8_SCHED; PG8_LDA(At, 1, 0); PG8_STAGE(PG8_SA(0, 1), a2 + hstep, voffA);
            PG8_WAIT_L(8); PG8_BAR; PG8_WAIT_L(0); PG8_MMA(0, 0, At, B0); PG8_BAR; PG8_SCHED;
            PG8_LDB(B1, 1, 1); PG8_STAGE(PG8_SB(1, 0), b3, voffB);
            PG8_BAR; PG8_WAIT_L(0); PG8_MMA(0, 1, At, B1); PG8_BAR;
            PG8_LDA(At, 1, 1); PG8_STAGE(PG8_SA(1, 0), a3, voffA);
            PG8_BAR; PG8_WAIT_L(0); PG8_MMA(1, 0, At, B0); PG8_BAR; PG8_SCHED;
            PG8_STAGE(PG8_SB(1, 1), b3 + hstep, voffB);
            PG8_WAIT_V(6); PG8_BAR; PG8_MMA(1, 1, At, B1); PG8_BAR;
            }
        }
        if constexpr (ALIGN_EPI) { if (wr == 0) PG8_BAR; }
        if constexpr (!Epi::AFTER_DRAIN) { E(acc, cur, wr, wc, fr, fq); S.done(cur); }
        if (!has_next) break;
#pragma unroll
        for (int a = 0; a < 2; ++a)
#pragma unroll
            for (int b = 0; b < 2; ++b)
#pragma unroll
                for (int m = 0; m < 4; ++m)
#pragma unroll
                    for (int n = 0; n < 2; ++n) acc[a][b][m][n] = (f32x4){0.f, 0.f, 0.f, 0.f};
        cur = nxt; cA = nA; cB = nB; ++ui;
        if constexpr (ALIGN_EPI) { if (wr == 1) PG8_BAR; }
    }
    PG8_WAIT_V(0);
    if constexpr (!ALIGN_EPI) { if (wr == 0) PG8_BAR; }
    PG8_BAR;
    if constexpr (Epi::AFTER_DRAIN) { E.fused(acc, cur, wr, wc, fr, fq, lds, wid, lane); S.done(cur); }
#undef PG8_SA
#undef PG8_SB
#undef PG8_STAGE
#undef PG8_LDA
#undef PG8_LDB
#undef PG8_MMA
#undef PG8_WAIT_V
#undef PG8_WAIT_L
#undef PG8_BAR
#undef PG8_SCHED
}
}

__device__ __forceinline__ void d_kmean(int vb, const bf16_t* __restrict__ P, float* __restrict__ kmean) {
    int i = vb * blockDim.x + threadIdx.x;
    if (i >= NB * 8 * 64 * 64) return;
    int d = i & 63, n = (i >> 6) & 63, h = (i >> 12) & 7, b = i >> 15;
    float s = 0.f;
    const bf16_t* p = P + ((size_t)(b * S + n * 256)) * PW + 512 + h * 64 + d;
    for (int j = 0; j < 256; ++j) s += bf2f(p[(size_t)j * PW]);
    kmean[i] = s * (1.0f / 256.0f);
}
__device__ __forceinline__ void soft_key(float& m, float& l, float* o, const float* q, const bf16_t* kr, const bf16_t* vr, float scale) {
    float s = 0.f;
#pragma unroll
    for (int c = 0; c < 8; ++c) { uint4 u = ((const uint4*)kr)[c]; const unsigned w[4] = {u.x, u.y, u.z, u.w};
#pragma unroll
        for (int t = 0; t < 4; ++t) { s += q[c * 8 + 2 * t] * __uint_as_float(w[t] << 16) + q[c * 8 + 2 * t + 1] * __uint_as_float(w[t] & 0xffff0000u); } }
    s *= scale;
    float mn = fmaxf(m, s), al = __expf(m - mn), p = __expf(s - mn);
    l = l * al + p; m = mn;
#pragma unroll
    for (int c = 0; c < 8; ++c) { uint4 u = ((const uint4*)vr)[c]; const unsigned w[4] = {u.x, u.y, u.z, u.w};
#pragma unroll
        for (int t = 0; t < 4; ++t) { o[c * 8 + 2 * t] = o[c * 8 + 2 * t] * al + p * __uint_as_float(w[t] << 16); o[c * 8 + 2 * t + 1] = o[c * 8 + 2 * t + 1] * al + p * __uint_as_float(w[t] & 0xffff0000u); } }
}
__device__ __forceinline__ void d_moba_naive(int vb, const bf16_t* __restrict__ P, const float* __restrict__ kmean, bf16_t* __restrict__ AO) {
    int i = vb * blockDim.x + threadIdx.x;
    if (i >= NB * 8 * S) return;
    int pos = i & (S - 1), h = (i >> 14) & 7, b = i >> 17;
    size_t tok = (size_t)b * S + pos;
    float q[64];
    { const bf16_t* qp = P + tok * PW + h * 64;
#pragma unroll
      for (int d = 0; d < 64; ++d) q[d] = bf2f(qp[d]); }
    int qb = pos >> 8;
    float bv[3] = {-INFINITY, -INFINITY, -INFINITY}; int bi[3] = {-1, -1, -1};
    const float* km = kmean + ((size_t)(b * 8 + h) * 64) * 64;
    for (int n = 0; n < qb; ++n) {
        float g = 0.f;
#pragma unroll
        for (int d = 0; d < 64; ++d) g += q[d] * km[n * 64 + d];
        if (g > bv[0]) { bv[2] = bv[1]; bi[2] = bi[1]; bv[1] = bv[0]; bi[1] = bi[0]; bv[0] = g; bi[0] = n; }
        else if (g > bv[1]) { bv[2] = bv[1]; bi[2] = bi[1]; bv[1] = g; bi[1] = n; }
        else if (g > bv[2]) { bv[2] = g; bi[2] = n; }
    }
    float m = -1e30f, l = 0.f, o[64];
#pragma unroll
    for (int d = 0; d < 64; ++d) o[d] = 0.f;
    const bf16_t* Kb = P + ((size_t)b * S) * PW + 512 + h * 64;
    const bf16_t* Vb = P + ((size_t)b * S) * PW + 1024 + h * 64;
    for (int key = qb * 256; key <= pos; ++key) soft_key(m, l, o, q, Kb + (size_t)key * PW, Vb + (size_t)key * PW, 0.125f);
    for (int s3 = 0; s3 < 3; ++s3) {
        if (bi[s3] < 0) continue;
        int k0 = bi[s3] * 256;
        for (int key = k0; key < k0 + 256; ++key) soft_key(m, l, o, q, Kb + (size_t)key * PW, Vb + (size_t)key * PW, 0.125f);
    }
    float il = 1.0f / l;
    bf16_t* op = AO + tok * D + h * 64;
#pragma unroll
    for (int d = 0; d < 64; ++d) op[d] = f2bf(o[d] * il);
}

__device__ __forceinline__ void d_dilated_naive(int vb, const bf16_t* __restrict__ P, bf16_t* __restrict__ AO) {
    int i = vb * blockDim.x + threadIdx.x;
    if (i >= NB * 16 * S) return;
    int pos = i & (S - 1), h = (i >> 14) & 15, b = i >> 18;
    size_t tok = (size_t)b * S + pos;
    float q[64];
    { const bf16_t* qp = P + tok * PW + h * 64;
#pragma unroll
      for (int d = 0; d < 64; ++d) q[d] = bf2f(qp[d]); }
    float m = -1e30f, l = 0.f, o[64];
#pragma unroll
    for (int d = 0; d < 64; ++d) o[d] = 0.f;
    const bf16_t* Kb = P + ((size_t)b * S) * PW + 1024 + h * 64;
    const bf16_t* Vb = P + ((size_t)b * S) * PW + 2048 + h * 64;
    for (int br = 0; br < 3; ++br) {
        int dil = br == 0 ? 1 : (br == 1 ? 4 : 16);
        for (int t = 0; t <= 128; ++t) {
            int key = pos - t * dil; if (key < 0) break;
            soft_key(m, l, o, q, Kb + (size_t)key * PW, Vb + (size_t)key * PW, 0.125f);
        }
    }
    float il = 1.0f / l;
    bf16_t* op = AO + tok * D + h * 64;
#pragma unroll
    for (int d = 0; d < 64; ++d) op[d] = f2bf(o[d] * il);
}

__device__ __forceinline__ float ret_loggamma(int h) { return logf(1.0f - exp2f(-5.0f - (float)h)); }
__device__ __forceinline__ void d_ret_state(int vb, const bf16_t* __restrict__ P, float* __restrict__ state) {
    size_t i = (size_t)vb * blockDim.x + threadIdx.x;
    if (i >= (size_t)NB * 4 * 128 * 64 * 128) return;
    int e = i & 127, d = (i >> 7) & 63, n = (i >> 13) & 127, h = (i >> 20) & 3, b = (int)(i >> 22);
    float lg = ret_loggamma(h);
    const bf16_t* kp = P + ((size_t)(b * S + n * 128)) * PW + 1792 + h * 64 + d;
    const bf16_t* vp = P + ((size_t)(b * S + n * 128)) * PW + 2048 + h * 128 + e;
    float s = 0.f;
    for (int j = 0; j < 128; ++j) s += bf2f(kp[(size_t)j * PW]) * __expf(lg * (float)(127 - j)) * bf2f(vp[(size_t)j * PW]);
    state[i] = s;
}
__device__ __forceinline__ void d_ret_scan(int vb, const float* __restrict__ state, float* __restrict__ rprev) {
    int i = vb * blockDim.x + threadIdx.x;
    if (i >= NB * 4 * 8192) return;
    int de = i & 8191, bh = i >> 13, h = bh & 3;
    float gc = __expf(ret_loggamma(h) * 128.0f), r = 0.f;
    for (int n = 0; n < 128; ++n) { size_t o = ((size_t)bh * 128 + n) * 8192 + de; rprev[o] = r; r = gc * r + state[o]; }
}
__device__ __forceinline__ void d_ret_out(int vb, const bf16_t* __restrict__ P, const float* __restrict__ rprev, bf16_t* __restrict__ AO) {
    int t = vb * blockDim.x + threadIdx.x;
    if (t >= NTOK * 16) return;
    int qt = t & 3, h = (t >> 2) & 3, tok = t >> 4, b = tok >> 14, pos = tok & (S - 1), ii = pos & 127, n = pos >> 7;
    float lg = ret_loggamma(h);
    float q[64];
    { const bf16_t* qp = P + (size_t)tok * PW + 1536 + h * 64;
#pragma unroll
      for (int d = 0; d < 64; ++d) q[d] = bf2f(qp[d]); }
    float acc[32];
#pragma unroll
    for (int e = 0; e < 32; ++e) acc[e] = 0.f;
    const float* rp = rprev + ((size_t)(b * 4 + h) * 128 + n) * 8192 + qt * 32;
    { const bf16_t* qp = P + (size_t)tok * PW + 1536 + h * 64;
      for (int d = 0; d < 64; ++d) { float qd = bf2f(qp[d]);
#pragma unroll
        for (int e = 0; e < 32; ++e) acc[e] += qd * rp[d * 128 + e]; } }
    float sc = __expf(lg * (float)(ii + 1));
#pragma unroll
    for (int e = 0; e < 32; ++e) acc[e] *= sc;
    const bf16_t* Kb = P + (size_t)(tok - ii) * PW + 1792 + h * 64;
    const bf16_t* Vb = P + (size_t)(tok - ii) * PW + 2048 + h * 128 + qt * 32;
    for (int j = 0; j <= ii; ++j) {
        const bf16_t* kr = Kb + (size_t)j * PW; float s = 0.f;
#pragma unroll
        for (int d = 0; d < 64; ++d) s += q[d] * bf2f(kr[d]);
        s *= __expf(lg * (float)(ii - j));
        const bf16_t* vr = Vb + (size_t)j * PW;
#pragma unroll
        for (int e = 0; e < 32; ++e) acc[e] += s * bf2f(vr[e]);
    }
    float sum = 0.f;
#pragma unroll
    for (int e = 0; e < 32; ++e) sum += acc[e];
    sum += __shfl_xor(sum, 1); sum += __shfl_xor(sum, 2);
    float mu = sum * (1.0f / 128.0f), sq = 0.f;
#pragma unroll
    for (int e = 0; e < 32; ++e) { float dlt = acc[e] - mu; sq += dlt * dlt; }
    sq += __shfl_xor(sq, 1); sq += __shfl_xor(sq, 2);
    float rs = rsqrtf(sq * (1.0f / 128.0f) + EPS);
    const bf16_t* gp = P + (size_t)tok * PW + 2560 + h * 128 + qt * 32;
    bf16_t* op = AO + (size_t)tok * D + 512 + h * 128 + qt * 32;
#pragma unroll
    for (int e = 0; e < 32; ++e) op[e] = f2bf((acc[e] - mu) * rs * silu(bf2f(gp[e])));
}

__device__ __forceinline__ void d_router(int vb, const float* __restrict__ h, const float* __restrict__ gain, const float* __restrict__ wg, const float* __restrict__ bg,
                                               const float* __restrict__ wf, const float* __restrict__ bfine, bf16_t* __restrict__ xn, int2* __restrict__ toke, float2* __restrict__ tokg, unsigned* __restrict__ cnt) {
    int row = (vb * blockDim.x + threadIdx.x) >> 6, lane = threadIdx.x & 63;
    if (row >= NTOK) return;
    const float4* xr = (const float4*)(h + (size_t)row * D);
    float4 v[4]; float ss = 0.f;
#pragma unroll
    for (int j = 0; j < 4; ++j) { v[j] = xr[64 * j + lane]; ss += v[j].x * v[j].x + v[j].y * v[j].y + v[j].z * v[j].z + v[j].w * v[j].w; }
    ss = wave_sum(ss);
    float rstd = rsqrtf(ss * (1.0f / D) + EPS);
    float xv[16];
#pragma unroll
    for (int j = 0; j < 4; ++j) {
        float4 g = ((const float4*)gain)[64 * j + lane];
        xv[4 * j] = v[j].x * rstd * g.x; xv[4 * j + 1] = v[j].y * rstd * g.y; xv[4 * j + 2] = v[j].z * rstd * g.z; xv[4 * j + 3] = v[j].w * rstd * g.w;
        ushort4 o; o.x = f2bf(xv[4 * j]); o.y = f2bf(xv[4 * j + 1]); o.z = f2bf(xv[4 * j + 2]); o.w = f2bf(xv[4 * j + 3]);
        ((ushort4*)(xn + (size_t)row * D))[64 * j + lane] = o;
    }
    float gl[4] = {0.f, 0.f, 0.f, 0.f};
#pragma unroll
    for (int j = 0; j < 4; ++j)
#pragma unroll
        for (int c = 0; c < 4; ++c) { int k = (64 * j + lane) * 4 + c; float4 w = ((const float4*)wg)[k];
            gl[0] += xv[4 * j + c] * w.x; gl[1] += xv[4 * j + c] * w.y; gl[2] += xv[4 * j + c] * w.z; gl[3] += xv[4 * j + c] * w.w; }
#pragma unroll
    for (int c = 0; c < 4; ++c) gl[c] = wave_sum(gl[c]) + bg[c];
    int grp = 0; float gm = gl[0];
#pragma unroll
    for (int c = 1; c < 4; ++c) if (gl[c] > gm) { gm = gl[c]; grp = c; }
    float gs = 0.f;
#pragma unroll
    for (int c = 0; c < 4; ++c) gs += __expf(gl[c] - gm);
    float gval = 1.0f / gs;
    float fl[8] = {0.f, 0.f, 0.f, 0.f, 0.f, 0.f, 0.f, 0.f};
#pragma unroll
    for (int j = 0; j < 4; ++j)
#pragma unroll
        for (int c = 0; c < 4; ++c) { int k = (64 * j + lane) * 4 + c; const float4* w = (const float4*)(wf + (size_t)k * 32 + grp * 8);
            float4 w0 = w[0], w1 = w[1]; float x = xv[4 * j + c];
            fl[0] += x * w0.x; fl[1] += x * w0.y; fl[2] += x * w0.z; fl[3] += x * w0.w; fl[4] += x * w1.x; fl[5] += x * w1.y; fl[6] += x * w1.z; fl[7] += x * w1.w; }
#pragma unroll
    for (int c = 0; c < 8; ++c) fl[c] = wave_sum(fl[c]) + bfine[grp * 8 + c];
    int i0 = 0; float v0 = fl[0];
#pragma unroll
    for (int c = 1; c < 8; ++c) if (fl[c] > v0) { v0 = fl[c]; i0 = c; }
    int i1 = -1; float v1 = -INFINITY;
#pragma unroll
    for (int c = 0; c < 8; ++c) if (c != i0 && fl[c] > v1) { v1 = fl[c]; i1 = c; }
    float w0 = 1.0f / (1.0f + __expf(v1 - v0)), w1 = 1.0f - w0;
    if (lane == 0) {
        int e0 = grp * 8 + i0, e1 = grp * 8 + i1;
        toke[row] = make_int2(e0, e1); tokg[row] = make_float2(gval * w0, gval * w1);
        atomicAdd(&cnt[e0], 1u); atomicAdd(&cnt[e1], 1u);
    }
}
__device__ __forceinline__ void d_moe_plan(int vb, const unsigned* cnt, unsigned* pst, unsigned* ntiles, int* texp) {
    if (threadIdx.x != 0 || vb != 0) return;
    unsigned p = 0;
    for (int e = 0; e < NEXP; ++e) { pst[e] = p; unsigned pad = ((cnt[e] + 255u) / 256u) * 256u; for (unsigned t = p / 256; t < (p + pad) / 256; ++t) texp[t] = e; p += pad; }
    pst[NEXP] = p; ntiles[0] = p / 256;
}
__device__ __forceinline__ void d_combine(int vb, float* __restrict__ h, const bf16_t* __restrict__ ys, const int2* __restrict__ pos, const float* __restrict__ gain, bf16_t* __restrict__ xn, int final) {
    int row = (vb * blockDim.x + threadIdx.x) >> 6, lane = threadIdx.x & 63;
    if (row >= NTOK) return;
    int2 p = pos[row];
    float4* xr = (float4*)(h + (size_t)row * D);
    const ushort4* y0 = (const ushort4*)(ys + (size_t)p.x * D); const ushort4* y1 = (const ushort4*)(ys + (size_t)p.y * D);
    float4 v[4]; float ss = 0.f;
#pragma unroll
    for (int j = 0; j < 4; ++j) { v[j] = xr[64 * j + lane]; ushort4 a = y0[64 * j + lane], c = y1[64 * j + lane];
        v[j].x += bf2f(a.x) + bf2f(c.x); v[j].y += bf2f(a.y) + bf2f(c.y); v[j].z += bf2f(a.z) + bf2f(c.z); v[j].w += bf2f(a.w) + bf2f(c.w);
        ss += v[j].x * v[j].x + v[j].y * v[j].y + v[j].z * v[j].z + v[j].w * v[j].w; }
    ss = wave_sum(ss);
    float rstd = rsqrtf(ss * (1.0f / D) + EPS);
#pragma unroll
    for (int j = 0; j < 4; ++j) {
        float4 g = ((const float4*)gain)[64 * j + lane];
        float4 o = make_float4(v[j].x * rstd * g.x, v[j].y * rstd * g.y, v[j].z * rstd * g.z, v[j].w * rstd * g.w);
        if (final) xr[64 * j + lane] = o;
        else { xr[64 * j + lane] = v[j]; ushort4 ob; ob.x = f2bf(o.x); ob.y = f2bf(o.y); ob.z = f2bf(o.z); ob.w = f2bf(o.w); ((ushort4*)(xn + (size_t)row * D))[64 * j + lane] = ob; }
    }
}


typedef float f32x16 __attribute__((ext_vector_type(16)));
typedef short bf16x8 __attribute__((ext_vector_type(8)));
typedef short s16x4 __attribute__((ext_vector_type(4)));
typedef float f32x2_t __attribute__((ext_vector_type(2)));
typedef __bf16 bf16x2_t __attribute__((ext_vector_type(2)));
__device__ __forceinline__ unsigned cvtpk(float lo, float hi) { f32x2_t v = {lo, hi}; bf16x2_t b = __builtin_convertvector(v, bf16x2_t); return __builtin_bit_cast(unsigned, b); }
__device__ __forceinline__ s16x4 lds_tr16(LAS const char* p) { return __builtin_bit_cast(s16x4, __builtin_amdgcn_ds_read_tr16_b64_v4i16((LAS s16x4*)p)); }
constexpr int VPITCH = 144;
constexpr int ENG_LDS_PER_WAVE = 32 * VPITCH;
constexpr float SM_SCALE = 0.125f * 1.4426950408889634f;
constexpr float NEG_BIG = -1e30f;
struct AttnAcc { f32x16 o0, o1; float m, l; };
__device__ __forceinline__ void acc_init(AttnAcc& a) {
#pragma unroll
    for (int r = 0; r < 16; ++r) { a.o0[r] = 0.f; a.o1[r] = 0.f; }
    a.m = NEG_BIG; a.l = 0.f;
}
__device__ __forceinline__ void attn_tile(AttnAcc& a, const bf16x8 (&qf)[4], const bf16x8 (&kf)[4], LAS const char* vl, int lane, int lo, int hi) {
    const int hh = lane >> 5;
    f32x16 s;
#pragma unroll
    for (int r = 0; r < 16; ++r) s[r] = 0.f;
#pragma unroll
    for (int d0 = 0; d0 < 4; ++d0) s = __builtin_amdgcn_mfma_f32_32x32x16_bf16(kf[d0], qf[d0], s, 0, 0, 0);
    float mx = NEG_BIG;
#pragma unroll
    for (int r = 0; r < 16; ++r) { const int kr = (r & 3) + 8 * (r >> 2) + 4 * hh; s[r] = (kr >= lo && kr <= hi) ? s[r] * SM_SCALE : NEG_BIG; mx = fmaxf(mx, s[r]); }
    mx = fmaxf(mx, __shfl_xor(mx, 32));
    const float mn = fmaxf(a.m, mx), al = __builtin_amdgcn_exp2f(a.m - mn);
    a.m = mn;
    float ps = 0.f;
#pragma unroll
    for (int r = 0; r < 16; ++r) { s[r] = __builtin_amdgcn_exp2f(s[r] - mn); ps += s[r]; }
    a.l = a.l * al + ps;
#pragma unroll
    for (int r = 0; r < 16; ++r) { a.o0[r] *= al; a.o1[r] *= al; }
    bf16x8 pb[2];
#pragma unroll
    for (int ks = 0; ks < 2; ++ks) { u32x4_t w; w.x = cvtpk(s[8 * ks], s[8 * ks + 1]); w.y = cvtpk(s[8 * ks + 2], s[8 * ks + 3]); w.z = cvtpk(s[8 * ks + 4], s[8 * ks + 5]); w.w = cvtpk(s[8 * ks + 6], s[8 * ks + 7]); pb[ks] = __builtin_bit_cast(bf16x8, w); }
    const int li = lane & 15;
    LAS const char* vb = vl + (4 * hh + (li >> 2)) * VPITCH + (16 * ((lane >> 4) & 1) + 4 * (li & 3)) * 2;
#pragma unroll
    for (int ks = 0; ks < 2; ++ks) {
        { const s16x4 lo4 = lds_tr16(vb + (16 * ks) * VPITCH), hi4 = lds_tr16(vb + (16 * ks + 8) * VPITCH);
          const bf16x8 vf = {lo4[0], lo4[1], lo4[2], lo4[3], hi4[0], hi4[1], hi4[2], hi4[3]};
          a.o0 = __builtin_amdgcn_mfma_f32_32x32x16_bf16(vf, pb[ks], a.o0, 0, 0, 0); }
        { const s16x4 lo4 = lds_tr16(vb + (16 * ks) * VPITCH + 64), hi4 = lds_tr16(vb + (16 * ks + 8) * VPITCH + 64);
          const bf16x8 vf = {lo4[0], lo4[1], lo4[2], lo4[3], hi4[0], hi4[1], hi4[2], hi4[3]};
          a.o1 = __builtin_amdgcn_mfma_f32_32x32x16_bf16(vf, pb[ks], a.o1, 0, 0, 0); }
    }
}
template <class KP, class VP, class LH>
__device__ __forceinline__ void attn_run(AttnAcc& a, const bf16x8 (&qf)[4], int t0, int t1, const KP& kp, const VP& vp, const LH& lh, LAS char* vl, int lane) {
    if (t0 >= t1) return;
    bf16x8 kn[4]; u32x4_t vn[4];
    { const bf16_t* k = kp(t0); const bf16_t* v = vp(t0);
#pragma unroll
      for (int i = 0; i < 4; ++i) { kn[i] = *(const bf16x8*)(k + 16 * i); vn[i] = *(const u32x4_t*)(v + 8 * i); } }
    LAS char* vw = vl + (lane >> 1) * VPITCH + (lane & 1) * 64;
    for (int t = t0; t < t1; ++t) {
        bf16x8 kf[4];
#pragma unroll
        for (int i = 0; i < 4; ++i) { kf[i] = kn[i]; *(LAS u32x4_t*)(vw + 16 * i) = vn[i]; }
        if (t + 1 < t1) { const bf16_t* k = kp(t + 1); const bf16_t* v = vp(t + 1);
#pragma unroll
            for (int i = 0; i < 4; ++i) { kn[i] = *(const bf16x8*)(k + 16 * i); vn[i] = *(const u32x4_t*)(v + 8 * i); } }
        int lo, hi; lh(t, lo, hi);
        attn_tile(a, qf, kf, vl, lane, lo, hi);
    }
}
__device__ __forceinline__ void attn_finish(const AttnAcc& a, float& inv_l, float& lse) {
    const float l = a.l + __shfl_xor(a.l, 32);
    inv_l = 1.0f / l; lse = (a.m + __log2f(l)) * 0.6931471805599453f;
}
__device__ __forceinline__ void store_o(bf16_t* op, const f32x16& o0, const f32x16& o1, float sc, int hh) {
#pragma unroll
    for (int rr = 0; rr < 4; ++rr) {
        uint2 w0, w1; w0.x = cvtpk(o0[4 * rr] * sc, o0[4 * rr + 1] * sc); w0.y = cvtpk(o0[4 * rr + 2] * sc, o0[4 * rr + 3] * sc);
        w1.x = cvtpk(o1[4 * rr] * sc, o1[4 * rr + 1] * sc); w1.y = cvtpk(o1[4 * rr + 2] * sc, o1[4 * rr + 3] * sc);
        *(uint2*)(op + 8 * rr + 4 * hh) = w0; *(uint2*)(op + 32 + 8 * rr + 4 * hh) = w1; }
}
__device__ __forceinline__ void add_partial(f32x16& o0, f32x16& o1, const bf16_t* pp, float w, int hh) {
#pragma unroll
    for (int rr = 0; rr < 4; ++rr) {
        const uint2 w0 = *(const uint2*)(pp + 8 * rr + 4 * hh), w1 = *(const uint2*)(pp + 32 + 8 * rr + 4 * hh);
        o0[4 * rr] += w * __uint_as_float(w0.x << 16); o0[4 * rr + 1] += w * __uint_as_float(w0.x & 0xffff0000u); o0[4 * rr + 2] += w * __uint_as_float(w0.y << 16); o0[4 * rr + 3] += w * __uint_as_float(w0.y & 0xffff0000u);
        o1[4 * rr] += w * __uint_as_float(w1.x << 16); o1[4 * rr + 1] += w * __uint_as_float(w1.x & 0xffff0000u); o1[4 * rr + 2] += w * __uint_as_float(w1.y << 16); o1[4 * rr + 3] += w * __uint_as_float(w1.y & 0xffff0000u); }
}


constexpr size_t HB_MPO = 0, HB_MPL = 96 * MiB, HB_MLIST = 100 * MiB;
constexpr int CW_LCNT = 2048;
constexpr int LIST_PER_BH = 64 * 16384 - 128 * 64 * 65;
__device__ __forceinline__ int list_off(int bh, int n) { return bh * LIST_PER_BH + n * 16384 - 128 * n * (n + 1); }
__device__ __forceinline__ void d_moba_route(int vb, const bf16_t* __restrict__ P, const float* __restrict__ kmean, unsigned* __restrict__ lcnt, unsigned short* __restrict__ lists, float* __restrict__ mpl) {
    const int i = vb * NTH + threadIdx.x;
    const int pos = i & (S - 1), h = (i >> 14) & 7, b = i >> 17, bh = b * 8 + h;
    const size_t tok = (size_t)b * S + pos;
    float q[64];
    { const bf16_t* qp = P + tok * PW + h * 64;
#pragma unroll
      for (int c = 0; c < 8; ++c) { const uint4 u = ((const uint4*)qp)[c]; const unsigned w[4] = {u.x, u.y, u.z, u.w};
#pragma unroll
          for (int t = 0; t < 4; ++t) { q[c * 8 + 2 * t] = __uint_as_float(w[t] << 16); q[c * 8 + 2 * t + 1] = __uint_as_float(w[t] & 0xffff0000u); } } }
    const int qb = pos >> 8;
    float bv[3] = {-INFINITY, -INFINITY, -INFINITY}; int bi[3] = {-1, -1, -1};
    const float* km = kmean + (size_t)bh * 64 * 64;
    for (int n = 0; n < qb; ++n) {
        float g = 0.f;
#pragma unroll
        for (int d = 0; d < 64; ++d) g += q[d] * km[n * 64 + d];
        if (g > bv[0]) { bv[2] = bv[1]; bi[2] = bi[1]; bv[1] = bv[0]; bi[1] = bi[0]; bv[0] = g; bi[0] = n; }
        else if (g > bv[1]) { bv[2] = bv[1]; bi[2] = bi[1]; bv[1] = g; bi[1] = n; }
        else if (g > bv[2]) { bv[2] = g; bi[2] = n; }
    }
#pragma unroll
    for (int k = 0; k < 3; ++k) {
        if (bi[k] >= 0) { const unsigned slot = atomicAdd(&lcnt[bh * 64 + bi[k]], 1u); lists[list_off(bh, bi[k]) + slot] = (unsigned short)(pos | (k << 14)); }
        else mpl[(tok * 8 + h) * 3 + k] = NEG_BIG;
    }
}
__device__ __forceinline__ void dilated_run(AttnAcc& a, const bf16_t* __restrict__ P, int b, int h, int dil, int r, int j, LAS char* vl, int lane) {
    const int c = lane & 31, hh = lane >> 5;
    const size_t rowb = (size_t)b * S;
    const bf16_t* qrow = P + (rowb + r + (size_t)dil * (32 * j + c)) * PW + h * 64 + 8 * hh;
    bf16x8 qf[4];
#pragma unroll
    for (int i = 0; i < 4; ++i) qf[i] = *(const bf16x8*)(qrow + 16 * i);
    acc_init(a);
    const bf16_t* Kb = P + rowb * PW + 1024 + h * 64 + 8 * hh;
    const bf16_t* Vb = P + rowb * PW + 2048 + h * 64 + (lane & 1) * 32;
    const int t0 = j >= 4 ? 0 : 4 - j;
    auto kp = [&](int tt) { return Kb + (size_t)(r + dil * (32 * (j - 4 + tt) + c)) * PW; };
    auto vp = [&](int tt) { return Vb + (size_t)(r + dil * (32 * (j - 4 + tt) + (lane >> 1))) * PW; };
    auto lh = [&](int tt, int& lo, int& hi) { lo = tt == 0 ? c : 0; hi = tt == 4 ? c : 31; };
    attn_run(a, qf, t0, 5, kp, vp, lh, vl, lane);
}
__device__ __forceinline__ void d_moe_scatter_gather(int tok, int lane, const int2* toke, const float2* tokg, const unsigned* pst, unsigned* cur, float* rowgate, int2* pos, const bf16_t* __restrict__ xn, bf16_t* __restrict__ xs) {
    int2 e = toke[tok]; float2 g = tokg[tok];
    unsigned d0 = 0, d1 = 0;
    if (lane == 0) { d0 = pst[e.x] + atomicAdd(&cur[e.x], 1u); d1 = pst[e.y] + atomicAdd(&cur[e.y], 1u); rowgate[d0] = g.x; rowgate[d1] = g.y; pos[tok] = make_int2((int)d0, (int)d1); }
    d0 = __shfl(d0, 0); d1 = __shfl(d1, 0);
    const uint4* src = (const uint4*)(xn + (size_t)tok * D);
    uint4 a = src[lane], b = src[lane + 64];
    uint4* o0 = (uint4*)(xs + (size_t)d0 * D); uint4* o1 = (uint4*)(xs + (size_t)d1 * D);
    o0[lane] = a; o0[lane + 64] = b; o1[lane] = a; o1[lane + 64] = b;
}

__device__ __forceinline__ unsigned pk2(float lo, float hi) { return (unsigned)f2bf(lo) | ((unsigned)f2bf(hi) << 16); }
__device__ __forceinline__ void transpose_item(const float* __restrict__ W, int ldw, int k0, int c0, bf16_t* __restrict__ dst  , int K, LAS float* scr, int lane) {
#pragma unroll 8
    for (int i = 0; i < 32; ++i) { const int kk = 2 * i + (lane >> 5); scr[kk * 33 + (lane & 31)] = W[(size_t)(k0 + kk) * ldw + c0 + (lane & 31)]; }
    asm volatile("s_waitcnt lgkmcnt(0)" ::: "memory");
    const int c = lane & 7;
#pragma unroll
    for (int j = 0; j < 4; ++j) { const int n = (lane >> 3) + 8 * j; const LAS float* s = scr + (8 * c) * 33 + n;
        uint4 o; o.x = pk2(s[0 * 33], s[1 * 33]); o.y = pk2(s[2 * 33], s[3 * 33]); o.z = pk2(s[4 * 33], s[5 * 33]); o.w = pk2(s[6 * 33], s[7 * 33]);
        *(uint4*)(dst + (size_t)n * K + k0 + 8 * c) = o; }
    asm volatile("s_waitcnt lgkmcnt(0)" ::: "memory");
}
__device__ __forceinline__ void tr_inproj(int it, const float* W, bf16_t* WT, int layer, LAS float* scr, int lane) {
    const int kb = it / 96, g = it % 96, pn = g >> 3, q = g & 7, bj = q >> 2, wc = q & 3;
    const bool rotary = layer == 0 ? (pn < 4) : (pn < 8);
    const int c0 = rotary ? 256 * pn + 64 * wc + 32 * bj : 32 * g;
    transpose_item(W, PW, 64 * kb, c0, WT + (size_t)(32 * g) * D, D, scr, lane);
}
__device__ __forceinline__ void tr_outproj(int it, const float* W, bf16_t* WT, LAS float* scr, int lane) {
    const int kb = it / 32, g = it % 32;
    transpose_item(W, D, 64 * kb, 32 * g, WT + (size_t)(32 * g) * D, D, scr, lane);
}
__device__ __forceinline__ void tr_expert(int it, const float* wg, const float* wu, const float* wd, bf16_t* WE, LAS float* scr, int lane) {
    const int e = it / 768, r = it % 768;
    bf16_t* base = WE + (size_t)e * WEXP_E;
    if (r < 512) { const int kb = r / 32, g = r % 32, pn = g >> 3, q = g & 7, bj = q >> 2, wc = q & 3;
        const float* W = (bj ? wu : wg) + (size_t)e * D * HID;
        transpose_item(W, HID, 64 * kb, 128 * pn + 32 * wc, base + (size_t)(32 * g) * D, D, scr, lane);
    } else { const int r2 = r - 512, kb = r2 / 32, g = r2 % 32;
        transpose_item(wd + (size_t)e * HID * D, D, 64 * kb, 32 * g, base + (size_t)D * D + (size_t)(32 * g) * HID, HID, scr, lane); }
}

struct Params {
    const float *x, *mix_norm_even, *w_in_even, *w_out_even, *mix_norm_odd, *w_in_odd, *w_out_odd, *ffn_norm, *w_rg, *b_rg, *w_re, *b_re, *w_eg, *w_eu, *w_ed, *final_norm;
    float* hbuf; unsigned char* ws;
};
#define FOR_VB(n) for (int vb = blockIdx.x; vb < (int)(n); vb += gridDim.x)
constexpr int LDS_BYTES = 147456;

template <class Epi>
__device__ __forceinline__ void run_gemm(PG8_LAS unsigned char* lds, const bf16_t* A, const bf16_t* Bt, int M, int N, int K, const Epi& E) {
    pg8::Gemm g{A, Bt, M, N, K}; pg8::StaticOrder S_; S_.init(M, N, (int)gridDim.x, (int)blockIdx.x);
    pg8::gemm_phase<Epi, pg8::StaticOrder, true, true>(lds, g, S_, E);
}

__device__ __forceinline__ void moe_phases(const Params& p, cg::grid_group& grid, PG8_LAS unsigned char* lds, int layer) {
    unsigned char* ws = p.ws; unsigned* ctl = (unsigned*)(ws + WS_CTL);
    unsigned* cnt = ctl + CW_CNT + 32 * layer; unsigned* cur = ctl + CW_CUR + 32 * layer; unsigned* pst = ctl + CW_PST + 40 * layer;
    unsigned* ntl = ctl + CW_NT + layer; int* texp = (int*)(ctl + CW_TEXP + 320 * layer);
    float* rowgate = (float*)(ctl + CW_ROWGATE + layer * MP_MAX);
    int2* toke = (int2*)(ws + WS_TOKE); float2* tokg = (float2*)(ws + WS_TOKG); int2* pos = (int2*)(ws + WS_POS);
    bf16_t* xn = (bf16_t*)(ws + WS_XN); bf16_t* big = (bf16_t*)(ws + WS_BIG); bf16_t* hs = (bf16_t*)(ws + WS_HS);
    const bf16_t* wexp = (const bf16_t*)(ws + WS_WEXP);
    const int lane = my_lane(), wave = __builtin_amdgcn_readfirstlane(threadIdx.x >> 6);
    FOR_VB(NTOK * 64 / NTH) d_router(vb, p.hbuf, p.ffn_norm + layer * D, p.w_rg + (size_t)layer * D * 4, p.b_rg + layer * 4, p.w_re + (size_t)layer * D * 32, p.b_re + layer * 32, xn, toke, tokg, cnt);
    grid.sync();
    if (blockIdx.x == 0) d_moe_plan(0, cnt, pst, ntl, texp);
    grid.sync();
    for (int tok = blockIdx.x * NWAVES + wave; tok < NTOK; tok += gridDim.x * NWAVES) d_moe_scatter_gather(tok, lane, toke, tokg, pst, cur, rowgate, pos, xn, big);
    grid.sync();
    const int mp = (int)ntl[0] * 256;
    { pg8::Gemm g{big, wexp, mp, 1024, D}; pg8::MoeOrder S_; S_.init(mp, 1024, (int)gridDim.x, (int)blockIdx.x); S_.texp = texp; S_.estride_bytes = WEXP_E * 2;
      pg8::EpiMoe1F E{hs};
      pg8::gemm_phase<pg8::EpiMoe1F, pg8::MoeOrder, true, true>(lds, g, S_, E); }
    grid.sync();
    { pg8::Gemm g{hs, wexp + (size_t)D * D, mp, D, HID}; pg8::MoeOrder S_; S_.init(mp, D, (int)gridDim.x, (int)blockIdx.x); S_.texp = texp; S_.estride_bytes = WEXP_E * 2;
      pg8::EpiMoe2F E{big, rowgate};
      pg8::gemm_phase<pg8::EpiMoe2F, pg8::MoeOrder, true, true>(lds, g, S_, E); }
    grid.sync();
}

__global__ void __launch_bounds__(NTH, 2) mega(Params p) {
    extern __shared__ __attribute__((aligned(16))) unsigned char lds_raw[];
    PG8_LAS unsigned char* lds = (PG8_LAS unsigned char*)lds_raw;
    cg::grid_group grid = cg::this_grid();
    unsigned char* ws = p.ws;
    float2* rot = (float2*)(ws + WS_ROT); float2* ret = (float2*)(ws + WS_RET);
    float* kmean = (float*)(ws + WS_KMEAN);
    int2* pos = (int2*)(ws + WS_POS);
    float* rstate = (float*)(ws + WS_RSTATE); float* rprev = (float*)(ws + WS_RPREV);
    bf16_t* xn = (bf16_t*)(ws + WS_XN); bf16_t* ao = (bf16_t*)(ws + WS_AO); bf16_t* big = (bf16_t*)(ws + WS_BIG);
    bf16_t* win0 = (bf16_t*)(ws + WS_WIN0); bf16_t* wout0 = (bf16_t*)(ws + WS_WOUT0); bf16_t* win1 = (bf16_t*)(ws + WS_WIN1); bf16_t* wout1 = (bf16_t*)(ws + WS_WOUT1);
    bf16_t* wexp = (bf16_t*)(ws + WS_WEXP);
    float* hbuf = p.hbuf;
    const int wave = __builtin_amdgcn_readfirstlane(threadIdx.x >> 6);
    const int gw = blockIdx.x * NWAVES + wave, NGW = gridDim.x * NWAVES;
    const int lane = my_lane();
    LAS float* scr = (LAS float*)(lds + wave * 8448);

    FOR_VB(S * 32 / NTH) d_tables(vb, rot, ret);
    for (int it = gw; it < 1536 + 512 + 1536 + 512 + 24576; it += NGW) {
        int r = it;
        if (r < 1536) { tr_inproj(r, p.w_in_even, win0, 0, scr, lane); continue; } r -= 1536;
        if (r < 512) { tr_outproj(r, p.w_out_even, wout0, scr, lane); continue; } r -= 512;
        if (r < 1536) { tr_inproj(r, p.w_in_odd, win1, 1, scr, lane); continue; } r -= 1536;
        if (r < 512) { tr_outproj(r, p.w_out_odd, wout1, scr, lane); continue; } r -= 512;
        tr_expert(r, p.w_eg, p.w_eu, p.w_ed, wexp, scr, lane);
    }
    FOR_VB(NTOK * 64 / NTH) d_rmsnorm(vb, p.x, p.mix_norm_even, xn);
    grid.sync();
    { pg8::EpiInprojF E{big, rot, ret, 0, 0}; run_gemm(lds, xn, win0, NTOK, PW, D, E); }
    grid.sync();
    FOR_VB(NB * 8 * 64 * 64 / NTH) d_kmean(vb, big, kmean);
    FOR_VB(NB * 4 * 128 * 64 * 128 / NTH) d_ret_state(vb, big, rstate);
    grid.sync();
    unsigned* lcnt = (unsigned*)(ws + WS_CTL) + CW_LCNT;
    bf16_t* mpo = (bf16_t*)((unsigned char*)hbuf + HB_MPO); float* mpl = (float*)((unsigned char*)hbuf + HB_MPL); unsigned short* mlist = (unsigned short*)((unsigned char*)hbuf + HB_MLIST);
    FOR_VB(NB * 4 * 8192 / NTH) d_ret_scan(vb, rstate, rprev);
    FOR_VB(NB * 8 * S / NTH) d_moba_route(vb, big, kmean, lcnt, mlist, mpl);
    grid.sync();
    FOR_VB(NTOK * 16 / NTH) d_ret_out(vb, big, rprev, ao);
    {
      LAS int* pre = (LAS int*)(lds + 40960);
      { const int t = threadIdx.x; const int c0 = ((int)lcnt[2 * t] + 31) >> 5, c1 = ((int)lcnt[2 * t + 1] + 31) >> 5;
        LAS int* sc = (LAS int*)(lds + 49152);
        sc[t] = c0 + c1; __syncthreads();
        for (int o = 1; o < NTH; o <<= 1) { const int v = t >= o ? sc[t - o] : 0; __syncthreads(); sc[t] += v; __syncthreads(); }
        const int ex = sc[t] - (c0 + c1); pre[2 * t] = ex; pre[2 * t + 1] = ex + c0; if (t == NTH - 1) pre[1024] = sc[t];
        __syncthreads(); }
      const int lane2 = my_lane(), c = lane2 & 31, hh = lane2 >> 5; LAS char* vl = (LAS char*)(lds + wave * ENG_LDS_PER_WAVE);
      const int total = pre[1024];
      for (int ch = gw; ch < total; ch += NGW) {
          int l = 0;
#pragma unroll
          for (int st = 512; st > 0; st >>= 1) if (pre[l + st] <= ch) l += st;
          const int bh = l >> 6, n = l & 63, b = bh >> 3, h = bh & 7, idx = (ch - pre[l]) * 32 + c, cntl = (int)lcnt[l];
          const bool valid = idx < cntl;
          const unsigned ent = mlist[list_off(bh, n) + (valid ? idx : 0)];
          const int pos = ent & 16383, k = ent >> 14;
          const size_t rowb = (size_t)b * S, tok = rowb + pos;
          const bf16_t* qrow = big + tok * PW + h * 64 + 8 * hh;
          bf16x8 qf[4];
#pragma unroll
          for (int i = 0; i < 4; ++i) qf[i] = *(const bf16x8*)(qrow + 16 * i);
          AttnAcc a; acc_init(a);
          const bf16_t* Kb = big + (rowb + n * 256) * PW + 512 + h * 64 + 8 * hh;
          const bf16_t* Vb = big + (rowb + n * 256) * PW + 1024 + h * 64 + (lane2 & 1) * 32;
          auto kp = [&](int tt) { return Kb + (size_t)(32 * tt + c) * PW; };
          auto vp = [&](int tt) { return Vb + (size_t)(32 * tt + (lane2 >> 1)) * PW; };
          auto lh = [&](int, int& lo, int& hi) { lo = 0; hi = 31; };
          attn_run(a, qf, 0, 8, kp, vp, lh, vl, lane2);
          float inv, lse; attn_finish(a, inv, lse);
          if (valid) { const size_t pi = (tok * 8 + h) * 3 + k; store_o(mpo + pi * 64, a.o0, a.o1, inv, hh); if (hh == 0) mpl[pi] = lse; }
      } }
    grid.sync();
    {
      const int lane2 = my_lane(), c = lane2 & 31, hh = lane2 >> 5; LAS char* vl = (LAS char*)(lds + wave * ENG_LDS_PER_WAVE);
      for (int it = gw; it < NB * 8 * 512; it += NGW) {
          const int bh = it >> 9, qb = (it >> 3) & 63, j8 = ((bh >> 2) & 1) ? 7 - (it & 7) : (it & 7), b = bh >> 3, h = bh & 7;
          const size_t rowb = (size_t)b * S, tok = rowb + qb * 256 + j8 * 32 + c;
          const bf16_t* qrow = big + tok * PW + h * 64 + 8 * hh;
          bf16x8 qf[4];
#pragma unroll
          for (int i = 0; i < 4; ++i) qf[i] = *(const bf16x8*)(qrow + 16 * i);
          AttnAcc a; acc_init(a);
          const bf16_t* Kb = big + (rowb + qb * 256) * PW + 512 + h * 64 + 8 * hh;
          const bf16_t* Vb = big + (rowb + qb * 256) * PW + 1024 + h * 64 + (lane2 & 1) * 32;
          auto kp = [&](int tt) { return Kb + (size_t)(32 * tt + c) * PW; };
          auto vp = [&](int tt) { return Vb + (size_t)(32 * tt + (lane2 >> 1)) * PW; };
          auto lh = [&](int tt, int& lo, int& hi) { lo = 0; hi = tt == j8 ? c : 31; };
          attn_run(a, qf, 0, j8 + 1, kp, vp, lh, vl, lane2);
          float inv, lse0; attn_finish(a, inv, lse0);
          const size_t pi = (tok * 8 + h) * 3;
          const float l1 = mpl[pi], l2 = mpl[pi + 1], l3 = mpl[pi + 2], mxl = fmaxf(fmaxf(lse0, l1), fmaxf(l2, l3));
          const float w0 = __expf(lse0 - mxl), w1 = __expf(l1 - mxl), w2 = __expf(l2 - mxl), w3 = __expf(l3 - mxl), iw = 1.0f / (w0 + w1 + w2 + w3);
          const float s0 = w0 * inv;
#pragma unroll
          for (int q = 0; q < 16; ++q) { a.o0[q] *= s0; a.o1[q] *= s0; }
          if (w1 > 0.f) add_partial(a.o0, a.o1, mpo + pi * 64, w1, hh);
          if (w2 > 0.f) add_partial(a.o0, a.o1, mpo + (pi + 1) * 64, w2, hh);
          if (w3 > 0.f) add_partial(a.o0, a.o1, mpo + (pi + 2) * 64, w3, hh);
          store_o(ao + tok * D + h * 64, a.o0, a.o1, iw, hh);
      } }
    grid.sync();
    { pg8::EpiOutprojF E{p.x, hbuf}; run_gemm(lds, ao, wout0, NTOK, D, D, E); }
    grid.sync();
    moe_phases(p, grid, lds, 0);
    FOR_VB(NTOK * 64 / NTH) d_combine(vb, hbuf, big, pos, p.mix_norm_odd, xn, 0);
    { const int lane2 = my_lane(); LAS float* scr2 = (LAS float*)(lds + __builtin_amdgcn_readfirstlane(threadIdx.x >> 6) * 8448);
      for (int it = gw; it < 24576; it += NGW) tr_expert(it, p.w_eg + (size_t)NEXP * D * HID, p.w_eu + (size_t)NEXP * D * HID, p.w_ed + (size_t)NEXP * HID * D, wexp, scr2, lane2); }
    grid.sync();
    { pg8::EpiInprojF E{big, rot, ret, 1, 0}; run_gemm(lds, xn, win1, NTOK, PW, D, E); }
    grid.sync();
    {
      const int lane2 = my_lane(); LAS char* vl = (LAS char*)(lds + wave * ENG_LDS_PER_WAVE);
      bf16_t* dpo = (bf16_t*)(ws + WS_DPO); float* dpl = (float*)(ws + WS_DPL);
      for (int it = gw; it < NB * 16 * 2 * 512; it += NGW) {
          const int rj = it & 511, br = (it >> 9) & 1, h = (it >> 10) & 15, b = it >> 14, dil = br ? 4 : 1, per = 512 / dil, r = rj / per, j = rj % per;
          AttnAcc a; dilated_run(a, big, b, h, dil, r, j, vl, lane2);
          float inv, lse; attn_finish(a, inv, lse);
          const size_t tok = (size_t)b * S + r + (size_t)dil * (32 * j + (lane2 & 31)), pi = (tok * 16 + h) * 2 + br;
          store_o(dpo + pi * 64, a.o0, a.o1, inv, lane2 >> 5);
          if (lane2 < 32) dpl[pi] = lse;
      } }
    grid.sync();
    {
      const int lane2 = my_lane(); LAS char* vl = (LAS char*)(lds + wave * ENG_LDS_PER_WAVE);
      const bf16_t* dpo = (const bf16_t*)(ws + WS_DPO); const float* dpl = (const float*)(ws + WS_DPL);
      for (int it = gw; it < NB * 16 * 512; it += NGW) {
          const int rj = it & 511, h = (it >> 9) & 15, b = it >> 13, r = rj >> 5, j = rj & 31;
          AttnAcc a; dilated_run(a, big, b, h, 16, r, j, vl, lane2);
          float inv, lse3; attn_finish(a, inv, lse3);
          const size_t tok = (size_t)b * S + r + (size_t)16 * (32 * j + (lane2 & 31)), pi = (tok * 16 + h) * 2;
          const float lse1 = dpl[pi], lse2 = dpl[pi + 1], mxl = fmaxf(fmaxf(lse1, lse2), lse3);
          const float w1 = __expf(lse1 - mxl), w2 = __expf(lse2 - mxl), w3 = __expf(lse3 - mxl), iw = 1.0f / (w1 + w2 + w3);
          const float s3 = w3 * inv;
#pragma unroll
          for (int q = 0; q < 16; ++q) { a.o0[q] *= s3; a.o1[q] *= s3; }
          add_partial(a.o0, a.o1, dpo + pi * 64, w1, lane2 >> 5);
          add_partial(a.o0, a.o1, dpo + (pi + 1) * 64, w2, lane2 >> 5);
          store_o(ao + tok * D + h * 64, a.o0, a.o1, iw, lane2 >> 5);
      } }
    grid.sync();
    { pg8::EpiOutprojF E{hbuf, hbuf}; run_gemm(lds, ao, wout1, NTOK, D, D, E); }
    grid.sync();
    moe_phases(p, grid, lds, 1);
    FOR_VB(NTOK * 64 / NTH) d_combine(vb, hbuf, big, pos, p.final_norm, xn, 1);
}

extern "C" void kernel_launch(void* const* d_in, const int* in_sizes, int n_in, void* d_out, int out_size, void* d_ws, size_t ws_size, hipStream_t stream) {
    if (n_in != 16 || ws_size < WS_END || out_size != NTOK * D) { fprintf(stderr, "kernel_launch: unexpected sizes n_in %d ws %zu out %d\n", n_in, ws_size, out_size); return; }
    static int grid_blocks = 0;
    if (!grid_blocks) {
        int dev = 0, cus = 0, per_cu = 0;
        (void)hipGetDevice(&dev);
        (void)hipDeviceGetAttribute(&cus, hipDeviceAttributeMultiprocessorCount, dev);
        (void)hipFuncSetAttribute((const void*)mega, hipFuncAttributeMaxDynamicSharedMemorySize, LDS_BYTES);
        (void)hipOccupancyMaxActiveBlocksPerMultiprocessor(&per_cu, mega, NTH, LDS_BYTES);
        if (per_cu < 1) per_cu = 1;
        grid_blocks = cus * per_cu;
        fprintf(stderr, "kernel_launch: cus %d per_cu %d grid %d\n", cus, per_cu, grid_blocks);
    }
    Params p{};
    const float** pp = (const float**)&p;
    for (int i = 0; i < 16; ++i) pp[i] = (const float*)d_in[i];
    p.hbuf = (float*)d_out; p.ws = (unsigned char*)d_ws;
    (void)hipMemsetAsync((unsigned char*)d_ws + WS_CTL, 0, CTL_BYTES, stream);
    void* args[] = {&p};
    hipError_t e = hipLaunchCooperativeKernel((void*)mega, dim3(grid_blocks), dim3(NTH), args, LDS_BYTES, stream);
    if (e != hipSuccess) fprintf(stderr, "cooperative launch failed: %s (grid %d)\n", hipGetErrorString(e), grid_blocks);
}
```

```cpp
#include <hip/hip_runtime.h>
#include <hip/hip_cooperative_groups.h>
#include <cstdio>
#include <cstdint>
namespace cg = cooperative_groups;

typedef unsigned short bf16_t;
__device__ __forceinline__ float bf2f(bf16_t v) { return __uint_as_float(((unsigned)v) << 16); }
__device__ __forceinline__ bf16_t f2bf(float f) { unsigned u = __float_as_uint(f); return (bf16_t)((u + 0x7fffu + ((u >> 16) & 1u)) >> 16); }

constexpr int NB = 2, S = 16384, D = 1024, NTOK = NB * S;
constexpr int PW = 3072;
constexpr int NEXP = 32, HID = 512;
constexpr int MP_MAX = 2 * NTOK + NEXP * 256;
constexpr float EPS = 1e-6f;
constexpr int NTH = 512, NWAVES = 8;

constexpr size_t MiB = 1u << 20;
constexpr size_t WS_CTL = 0, CTL_BYTES = 2 * MiB;
constexpr size_t WS_ROT = 2 * MiB, WS_RET = 6 * MiB;
constexpr size_t WS_KMEAN = 10 * MiB;
constexpr size_t WS_TOKE = 12 * MiB, WS_TOKG = 13 * MiB, WS_POS = 14 * MiB, WS_TOKRS = 15 * MiB;
constexpr size_t WS_WR = 11 * MiB, WS_WR2 = 11 * MiB + 256 * 1024;
constexpr size_t WS_TOKRANK = 15 * MiB + 512 * 1024, WS_TILECNT = 11 * MiB + 512 * 1024;
constexpr size_t WS_WIN0 = 16 * MiB, WS_WOUT0 = 22 * MiB, WS_WIN1 = 24 * MiB, WS_WOUT1 = 30 * MiB;
constexpr size_t WS_WEXP = 32 * MiB;
constexpr size_t WEXP_E = 3 * MiB / 2;
constexpr size_t WS_XN = 128 * MiB, WS_AO = 128 * MiB;
constexpr size_t WS_BIG = 192 * MiB;
constexpr size_t WS_HS = 400 * MiB, WS_RSTATE = 400 * MiB, WS_RPREV = 432 * MiB;
constexpr size_t WS_DPO = 400 * MiB, WS_DPL = 528 * MiB;
constexpr size_t WS_END = 532 * MiB;
constexpr int CW_CNT = 0;
constexpr int CW_CUR = 64;
constexpr int CW_PST = 128;
constexpr int CW_NT = 256;
constexpr int CW_TEXP = 512;
constexpr int CW_ROWGATE = 4096;
constexpr int CW_ROWSCALE = 4096 + 2 * MP_MAX;
constexpr int CW_BAR = ((CW_ROWSCALE + 2 * MP_MAX + 63) / 64) * 64;
constexpr int CW_ROWTOK = CW_BAR + 3584;
static_assert((CW_ROWTOK + 2 * MP_MAX) * 4 <= (int)CTL_BYTES, "ctl");

constexpr size_t L0_AQ = 0, L0_AK = (size_t)NTOK * 512, L0_AV = (size_t)NTOK * 1024, L0_RQ = (size_t)NTOK * 1536, L0_RK = (size_t)NTOK * 1792, L0_RV = (size_t)NTOK * 2048, L0_RG = (size_t)NTOK * 2560;
constexpr size_t L1_Q = 0, L1_K = (size_t)NTOK * 1024, L1_V = (size_t)NTOK * 2048;
__device__ __forceinline__ size_t hm(int b, int H, int h, int s, int W) { return ((size_t)(b * H + h) * S + s) * W; }
__device__ __forceinline__ size_t akf_off(int s, int d) { return ((size_t)((s >> 5) * 4 + (d >> 4)) * 64 + (((d >> 3) & 1) * 32 + (s & 31))) * 8 + (d & 7); }
__device__ __forceinline__ size_t avf_off(int s, int d) { return ((size_t)((s >> 5) * 4 + ((d >> 3) & 3)) * 64 + (2 * (s & 31) + (d >> 5))) * 8 + (d & 7); }
__device__ __forceinline__ size_t pcol_off(int layer, int col, int b, int s) {
    if (layer == 0) {
        if (col < 1536) { const int reg = col >> 9, w = col & 511, hd = w >> 6, d = w & 63;
            if (reg == 1) return L0_AK + hm(b, 8, hd, 0, 64) + akf_off(s, d);
            if (reg == 2) return L0_AV + hm(b, 8, hd, 0, 64) + avf_off(s, d);
            return hm(b, 8, hd, s, 64) + d; }
        if (col < 2048) { const int reg = (col - 1536) >> 8, w = (col - 1536) & 255;
            if (reg == 1) return L0_RK + hm(b, 4, w >> 6, 0, 64) + akf_off(s, w & 63);
            return L0_RQ + hm(b, 4, w >> 6, s, 64) + (w & 63); }
        const int reg = (col - 2048) >> 9, w = (col - 2048) & 511; return L0_RV + (size_t)reg * NTOK * 512 + hm(b, 4, w >> 7, s, 128) + (w & 127);
    }
    const int reg = col >> 10, w = col & 1023; return (size_t)reg * NTOK * 1024 + hm(b, 16, w >> 6, s, 64) + (w & 63);
}
__device__ __forceinline__ float wave_sum(float v) {
#pragma unroll
    for (int o = 32; o > 0; o >>= 1) v += __shfl_xor(v, o);
    return v;
}
#define LAS __attribute__((address_space(3)))
typedef unsigned u32x4_t __attribute__((ext_vector_type(4)));
typedef float f32x4_t __attribute__((ext_vector_type(4)));
__device__ __forceinline__ int my_lane() { int l; asm volatile("v_mbcnt_lo_u32_b32 %0, -1, 0\n\tv_mbcnt_hi_u32_b32 %0, -1, %0" : "=v"(l)); return l; }
__device__ __forceinline__ float silu(float x) { return x / (1.0f + __expf(-x)); }

__device__ __forceinline__ void d_tables(int vb, float2* rot, float2* ret) {
    int i = vb * blockDim.x + threadIdx.x;
    if (i >= S * 32) return;
    int pos = i >> 5, j = i & 31;
    float inv = 1.0f / powf(10000.0f, (float)j * (2.0f / 64.0f));
    float ang = (float)pos * inv;
    rot[i] = make_float2(cosf(ang), sinf(ang));
    float fr = 1.0f / powf(10000.0f, (float)j / 31.0f);
    float a2 = (float)pos * fr;
    ret[i] = make_float2(cosf(a2), sinf(a2));
}

__device__ __forceinline__ void d_rmsnorm(int vb, const float* __restrict__ src, const float* __restrict__ gain, bf16_t* __restrict__ xn) {
    int row = (vb * blockDim.x + threadIdx.x) >> 6, lane = threadIdx.x & 63;
    if (row >= NTOK) return;
    const float4* xr = (const float4*)(src + (size_t)row * D);
    float4 v[4]; float ss = 0.f;
#pragma unroll
    for (int j = 0; j < 4; ++j) { v[j] = xr[64 * j + lane]; ss += v[j].x * v[j].x + v[j].y * v[j].y + v[j].z * v[j].z + v[j].w * v[j].w; }
    ss = wave_sum(ss);
    float rstd = rsqrtf(ss * (1.0f / D) + EPS);
#pragma unroll
    for (int j = 0; j < 4; ++j) {
        float4 g = ((const float4*)gain)[64 * j + lane];
        ushort4 o; o.x = f2bf(v[j].x * rstd * g.x); o.y = f2bf(v[j].y * rstd * g.y); o.z = f2bf(v[j].z * rstd * g.z); o.w = f2bf(v[j].w * rstd * g.w);
        ((ushort4*)(xn + (size_t)row * D))[64 * j + lane] = o;
    }
}


namespace pg8 {
#define PG8_LAS __attribute__((address_space(3)))
typedef unsigned short bf16_t;
typedef short bf16x8 __attribute__((ext_vector_type(8)));
typedef float f32x4 __attribute__((ext_vector_type(4)));
typedef unsigned u32x4 __attribute__((ext_vector_type(4)));
constexpr int BM = 256, BK = 64, HALF = 128, HTB = HALF * BK * 2  , STAGE_BYTES = 8 * HTB, NXCD = 8, WGM = 8;

__host__ __device__ __forceinline__ int lds_byte(int r, int c) { const int st = (r >> 4) * 2 + (c >> 5), rr = r & 15, cc = c & 31, ob = rr * 64 + cc * 2; return st * 1024 + (ob ^ (((ob >> 9) & 1) << 5)); }
__host__ __device__ __forceinline__ void stage_rc(int b, int& R, int& C) { const int st = b / 1024, sb = b % 1024, swz = sb ^ (((sb >> 9) & 1) << 5); R = (st >> 1) * 16 + swz / 64; C = (st & 1) * 32 + (swz % 64) / 2; }
__host__ __device__ __forceinline__ int perm32(int rho) { const int n = rho >> 4, i = rho & 15; return 8 * (i >> 2) + 4 * n + (i & 3); }

struct Unit { int pm, pn; };
struct Gemm { const bf16_t* A; const bf16_t* Bt; int M, N, K; const int* rowidx = nullptr; };

struct StaticOrder {
    int nM, nN, nwg, G, c;
    __host__ __device__ void init(int M, int N, int G_, int c_) { nM = M / BM; nN = N / BM; nwg = nM * nN; G = G_; c = c_; }
    __host__ __device__ bool next(int i, Unit& u) const {
        const long L = (long)i * G + c; if (L >= nwg) return false;
        int wgid = (int)L; { const int q = nwg / NXCD, r = nwg % NXCD, xcd = wgid % NXCD, off = wgid / NXCD; wgid = (xcd < r ? xcd * (q + 1) : r * (q + 1) + (xcd - r) * q) + off; }
        const int nig = WGM * nN, gid = wgid / nig, fm = gid * WGM, gsz = (nM - fm) < WGM ? (nM - fm) : WGM;
        u.pm = fm + ((wgid % nig) % gsz); u.pn = (wgid % nig) / gsz; return true;
    }
    __device__ __forceinline__ void a_ready(const Unit&) const {}
    __device__ __forceinline__ void done(const Unit&) const {}
    __device__ __forceinline__ size_t boff(const Unit&) const { return 0; }
};


__device__ __forceinline__ unsigned cvt_pk_bf16(float lo, float hi) { unsigned r; asm volatile("v_cvt_pk_bf16_f32 %0, %1, %2" : "=v"(r) : "v"(lo), "v"(hi)); return r; }
__device__ __forceinline__ u32x4 pack8(const f32x4& a, const f32x4& b) { u32x4 w; w.x = cvt_pk_bf16(a[0], a[1]); w.y = cvt_pk_bf16(a[2], a[3]); w.z = cvt_pk_bf16(b[0], b[1]); w.w = cvt_pk_bf16(b[2], b[3]); return w; }
struct MoeOrder : StaticOrder {
    const int* texp; size_t estride_bytes;
    __device__ __forceinline__ size_t boff(const Unit& u) const { return (size_t)texp[u.pm] * estride_bytes; }
};
struct EpiInprojF {
    static constexpr bool PERM = true, AFTER_DRAIN = false;
    bf16_t* P; const float2* rot; const float2* ret; int mode, pad;
    __device__ __forceinline__ void operator()(const f32x4 (&acc)[2][2][4][2], const Unit& u, int wr, int wc, int fr, int fq) const {
        int kind;
        if (mode == 0) kind = u.pn < 4 ? 1 : (u.pn < 6 ? 0 : (u.pn == 6 ? 2 : (u.pn == 7 ? 3 : 0)));
        else kind = u.pn < 8 ? 1 : 0;
        const int row0 = u.pm * BM + wr * 64 + fr;
#pragma unroll
        for (int ai = 0; ai < 2; ++ai)
#pragma unroll
            for (int m = 0; m < 4; ++m) {
                const int row = row0 + ai * HALF + m * 16, pos = row & (S - 1), bb = row >> 14;
                if (kind == 1) {
                    const f32x4* t = (const f32x4*)(rot + pos * 32 + 8 * fq);
                    f32x4 o1[2], o2[2];
#pragma unroll
                    for (int n = 0; n < 2; ++n) { const f32x4 ta = t[2 * n], tb = t[2 * n + 1]; const f32x4 x1 = acc[ai][0][m][n], x2 = acc[ai][1][m][n];
                        o1[n][0] = x1[0] * ta[0] - x2[0] * ta[1]; o2[n][0] = x1[0] * ta[1] + x2[0] * ta[0];
                        o1[n][1] = x1[1] * ta[2] - x2[1] * ta[3]; o2[n][1] = x1[1] * ta[3] + x2[1] * ta[2];
                        o1[n][2] = x1[2] * tb[0] - x2[2] * tb[1]; o2[n][2] = x1[2] * tb[1] + x2[2] * tb[0];
                        o1[n][3] = x1[3] * tb[2] - x2[3] * tb[3]; o2[n][3] = x1[3] * tb[3] + x2[3] * tb[2]; }
                    *(u32x4*)(P + pcol_off(mode, u.pn * BM + 64 * wc + 8 * fq, bb, pos)) = pack8(o1[0], o1[1]);
                    *(u32x4*)(P + pcol_off(mode, u.pn * BM + 64 * wc + 32 + 8 * fq, bb, pos)) = pack8(o2[0], o2[1]);
                } else if (kind >= 2) {
                    const f32x4* t = (const f32x4*)(ret + pos * 32 + 16 * (wc & 1) + 4 * fq);
                    const f32x4 ta = t[0], tb = t[1]; const float sc = kind == 3 ? 0.125f : 1.0f;
#pragma unroll
                    for (int bj = 0; bj < 2; ++bj) { const f32x4 x0 = acc[ai][bj][m][0], x1 = acc[ai][bj][m][1]; f32x4 o0, o1;
                        o0[0] = (x0[0] * ta[0] - x0[1] * ta[1]) * sc; o0[1] = (x0[0] * ta[1] + x0[1] * ta[0]) * sc;
                        o0[2] = (x0[2] * ta[2] - x0[3] * ta[3]) * sc; o0[3] = (x0[2] * ta[3] + x0[3] * ta[2]) * sc;
                        o1[0] = (x1[0] * tb[0] - x1[1] * tb[1]) * sc; o1[1] = (x1[0] * tb[1] + x1[1] * tb[0]) * sc;
                        o1[2] = (x1[2] * tb[2] - x1[3] * tb[3]) * sc; o1[3] = (x1[2] * tb[3] + x1[3] * tb[2]) * sc;
                        *(u32x4*)(P + pcol_off(mode, u.pn * BM + bj * HALF + 32 * wc + 8 * fq, bb, pos)) = pack8(o0, o1); }
                } else {
#pragma unroll
                    for (int bj = 0; bj < 2; ++bj) *(u32x4*)(P + pcol_off(mode, u.pn * BM + bj * HALF + 32 * wc + 8 * fq, bb, pos)) = pack8(acc[ai][bj][m][0], acc[ai][bj][m][1]);
                }
            }
    }
};
struct EpiOutprojF {
    static constexpr bool PERM = false, AFTER_DRAIN = false;
    const float* res; float* hout;
    __device__ __forceinline__ void operator()(const f32x4 (&acc)[2][2][4][2], const Unit& u, int wr, int wc, int fr, int fq) const {
        const int row0 = u.pm * BM + wr * 64 + fr, col0 = u.pn * BM + wc * 32 + 4 * fq;
#pragma unroll
        for (int ai = 0; ai < 2; ++ai)
#pragma unroll
            for (int m = 0; m < 4; ++m) { const size_t off = (size_t)(row0 + ai * HALF + m * 16) * D + col0;
#pragma unroll
                for (int bj = 0; bj < 2; ++bj)
#pragma unroll
                    for (int n = 0; n < 2; ++n) { const f32x4 r = *(const f32x4*)(res + off + bj * HALF + n * 16); *(f32x4*)(hout + off + bj * HALF + n * 16) = r + acc[ai][bj][m][n]; } }
    }
};
struct EpiMoe1F {
    static constexpr bool PERM = true, AFTER_DRAIN = false;
    bf16_t* Hs; const float* rowscale;
    __device__ __forceinline__ void operator()(const f32x4 (&acc)[2][2][4][2], const Unit& u, int wr, int wc, int fr, int fq) const {
        const int row0 = u.pm * BM + wr * 64 + fr;
#pragma unroll
        for (int ai = 0; ai < 2; ++ai)
#pragma unroll
            for (int m = 0; m < 4; ++m) { f32x4 o[2]; const float rs = rowscale[row0 + ai * HALF + m * 16];
#pragma unroll
                for (int n = 0; n < 2; ++n)
#pragma unroll
                    for (int j = 0; j < 4; ++j) o[n][j] = silu(acc[ai][0][m][n][j] * rs) * (acc[ai][1][m][n][j] * rs);
                *(u32x4*)(Hs + (size_t)(row0 + ai * HALF + m * 16) * HID + u.pn * HALF + 32 * wc + 8 * fq) = pack8(o[0], o[1]); }
    }
};
struct EpiMoe2F {
    static constexpr bool PERM = true, AFTER_DRAIN = false;
    bf16_t* ys; const float* rowgate;
    __device__ __forceinline__ void operator()(const f32x4 (&acc)[2][2][4][2], const Unit& u, int wr, int wc, int fr, int fq) const {
        const int row0 = u.pm * BM + wr * 64 + fr;
#pragma unroll
        for (int ai = 0; ai < 2; ++ai)
#pragma unroll
            for (int m = 0; m < 4; ++m) { const int row = row0 + ai * HALF + m * 16; const float gt = rowgate[row];
#pragma unroll
                for (int bj = 0; bj < 2; ++bj) *(u32x4*)(ys + (size_t)row * D + u.pn * BM + bj * HALF + 32 * wc + 8 * fq) = pack8(acc[ai][bj][m][0] * gt, acc[ai][bj][m][1] * gt); }
    }
};

template <class Epi, class Sched, bool ALIGN_EPI = false, bool SP2 = false, bool GATHER = false>
__device__ __forceinline__ void gemm_phase(PG8_LAS unsigned char* lds, const Gemm g, const Sched& S, const Epi& E) {
    const int wid = __builtin_amdgcn_readfirstlane(threadIdx.x >> 6), lane = my_lane(), tid = wid * 64 + lane, wr = wid >> 2, wc = wid & 3, fr = lane & 15, fq = lane >> 4;
    const int K = g.K, nt = K / BK;
    unsigned voffA[2], voffB[2];
    static_assert(!GATHER || SP2, "the gathered A operand is wired into the SP2 loop only");
#pragma unroll
    for (int i = 0; i < 2; ++i) { int R, C; stage_rc(tid * 16 + i * 8192, R, C); const int Rb = Epi::PERM ? ((R & ~31) + perm32(R & 31)) : R;
        voffA[i] = (unsigned)(R * K + C) * 2u; voffB[i] = (unsigned)(Rb * K + C) * 2u; }
    const size_t kstep = (size_t)(BK * 2);
    const size_t hstep = (size_t)HALF * K * 2;
    const size_t tstep = 2 * hstep;
    const unsigned ldsw = (unsigned)wid * 1024u;
    const int aoff = lds_byte(wr * 64 + fr, fq * 8), boff = lds_byte(wc * 32 + fr, fq * 8);
#define PG8_SA(b, h) (((b) * 2 + (h)) * HTB)
#define PG8_SB(b, h) ((4 + (b) * 2 + (h)) * HTB)
#define PG8_STAGE(bufoff, gbase, voff) do { _Pragma("unroll") for (int _i = 0; _i < 2; ++_i) \
        __builtin_amdgcn_global_load_lds((const unsigned*)((const char*)(gbase) + (voff)[_i]), (PG8_LAS unsigned*)(lds + (bufoff) + ldsw + _i * 8192), 16, 0, 0); } while (0)
#define PG8_STAGE_G(bufoff, kbytes, vo) do { _Pragma("unroll") for (int _i = 0; _i < 2; ++_i) \
        __builtin_amdgcn_global_load_lds((const unsigned*)((const char*)g.A + (kbytes) + (vo)[_i]), (PG8_LAS unsigned*)(lds + (bufoff) + ldsw + _i * 8192), 16, 0, 0); } while (0)
#define PG8_LDA(dst, b, h) do { _Pragma("unroll") for (int m = 0; m < 4; ++m) _Pragma("unroll") for (int k = 0; k < 2; ++k) dst[m][k] = *(const PG8_LAS bf16x8*)(lds + PG8_SA(b, h) + aoff + m * 2048 + k * 1024); } while (0)
#define PG8_LDB(dst, b, h) do { _Pragma("unroll") for (int n = 0; n < 2; ++n) _Pragma("unroll") for (int k = 0; k < 2; ++k) dst[n][k] = *(const PG8_LAS bf16x8*)(lds + PG8_SB(b, h) + boff + n * 2048 + k * 1024); } while (0)
#define PG8_MMA(ai, bj, At, Bt) do { __builtin_amdgcn_s_setprio(1); _Pragma("unroll") for (int m = 0; m < 4; ++m) _Pragma("unroll") for (int n = 0; n < 2; ++n) _Pragma("unroll") for (int k = 0; k < 2; ++k) \
        acc[ai][bj][m][n] = __builtin_amdgcn_mfma_f32_16x16x32_bf16(Bt[n][k], At[m][k], acc[ai][bj][m][n], 0, 0, 0); __builtin_amdgcn_s_setprio(0); } while (0)
#define PG8_WAIT_V(n) asm volatile("s_waitcnt vmcnt(" #n ")" ::: "memory")
#define PG8_WAIT_L(n) asm volatile("s_waitcnt lgkmcnt(" #n ")" ::: "memory")
#define PG8_BAR __builtin_amdgcn_s_barrier()
#define PG8_SCHED __builtin_amdgcn_sched_barrier(0)
    Unit cur, nxt; int ui = 0;
    if (!S.next(0, cur)) return;
    unsigned voC0[2], voC1[2];
#define PG8_GOFF(dst0, dst1, pm_) do { _Pragma("unroll") for (int _i = 0; _i < 2; ++_i) { int R_, C_; stage_rc((wid * 64 + my_lane()) * 16 + _i * 8192, R_, C_);   \
        dst0[_i] = (unsigned)g.rowidx[(pm_) * BM + R_] * (unsigned)(K * 2) + (unsigned)C_ * 2u; dst1[_i] = (unsigned)g.rowidx[(pm_) * BM + HALF + R_] * (unsigned)(K * 2) + (unsigned)C_ * 2u; } } while (0)
    if constexpr (GATHER) { PG8_GOFF(voC0, voC1, cur.pm); }
    f32x4 acc[2][2][4][2];
#pragma unroll
    for (int a = 0; a < 2; ++a)
#pragma unroll
        for (int b = 0; b < 2; ++b)
#pragma unroll
            for (int m = 0; m < 4; ++m)
#pragma unroll
                for (int n = 0; n < 2; ++n) acc[a][b][m][n] = (f32x4){0.f, 0.f, 0.f, 0.f};
    bf16x8 At[4][2], B0[2][2], B1[2][2];
    const char* cA = (const char*)g.A + (size_t)cur.pm * tstep; const char* cB = (const char*)g.Bt + (size_t)cur.pn * tstep + S.boff(cur);
    S.a_ready(cur);
    if constexpr (SP2) {
        PG8_STAGE(PG8_SB(0, 0), cB, voffB); PG8_STAGE(PG8_SB(0, 1), cB + hstep, voffB);
        if constexpr (GATHER) { PG8_STAGE_G(PG8_SA(0, 0), 0, voC0); PG8_STAGE_G(PG8_SA(0, 1), 0, voC1); } else { PG8_STAGE(PG8_SA(0, 0), cA, voffA); PG8_STAGE(PG8_SA(0, 1), cA + hstep, voffA); }
        if (wr == 1) PG8_BAR;
        PG8_WAIT_V(2); PG8_BAR;
        PG8_STAGE(PG8_SB(1, 0), cB + kstep, voffB); if constexpr (GATHER) { PG8_STAGE_G(PG8_SA(1, 0), kstep, voC0); } else { PG8_STAGE(PG8_SA(1, 0), cA + kstep, voffA); } PG8_STAGE(PG8_SB(1, 1), cB + hstep + kstep, voffB);
        PG8_WAIT_V(6); PG8_BAR;
    } else {
        PG8_STAGE(PG8_SB(0, 0), cB, voffB); PG8_STAGE(PG8_SA(0, 0), cA, voffA); PG8_STAGE(PG8_SB(0, 1), cB + hstep, voffB); PG8_STAGE(PG8_SA(0, 1), cA + hstep, voffA);
        if (wr == 1) PG8_BAR;
        PG8_WAIT_V(4); PG8_BAR;
        PG8_STAGE(PG8_SB(1, 0), cB + kstep, voffB); PG8_STAGE(PG8_SA(1, 0), cA + kstep, voffA); PG8_STAGE(PG8_SB(1, 1), cB + hstep + kstep, voffB);
        PG8_WAIT_V(6); PG8_BAR;
    }
    for (;;) {
        const bool has_next = S.next(ui + 1, nxt);
        const char* nA = has_next ? (const char*)g.A + (size_t)nxt.pm * tstep : cA; const char* nB = has_next ? (const char*)g.Bt + (size_t)nxt.pn * tstep + S.boff(nxt) : cB;
        for (int t = 0; t < nt; t += 2) {
            const bool last = (t == nt - 2);
            const char* a1 = cA + (size_t)(t + 1) * kstep;
            const char* a2 = last ? nA : cA + (size_t)(t + 2) * kstep; const char* b2 = last ? nB : cB + (size_t)(t + 2) * kstep;
            const char* a3 = a2 + kstep; const char* b3 = b2 + kstep;
            if (last && has_next) S.a_ready(nxt);
            if constexpr (SP2) {
            const size_t k2b = last ? (size_t)0 : (size_t)(t + 2) * kstep;
            PG8_LDB(B0, 0, 0); PG8_LDB(B1, 0, 1); PG8_SCHED; PG8_LDA(At, 0, 0); if constexpr (GATHER) { PG8_STAGE_G(PG8_SA(1, 1), (size_t)(t + 1) * kstep, voC1); if (last && has_next) { PG8_GOFF(voC0, voC1, nxt.pm); }   } else { PG8_STAGE(PG8_SA(1, 1), a1 + hstep, voffA); }
            PG8_WAIT_V(8); PG8_WAIT_L(0); PG8_BAR; PG8_MMA(0, 0, At, B0); PG8_MMA(0, 1, At, B1); PG8_BAR; PG8_SCHED;
            PG8_LDA(At, 0, 1); PG8_STAGE(PG8_SB(0, 0), b2, voffB); PG8_STAGE(PG8_SB(0, 1), b2 + hstep, voffB); if constexpr (GATHER) { PG8_STAGE_G(PG8_SA(0, 0), k2b, voC0); } else { PG8_STAGE(PG8_SA(0, 0), a2, voffA); }
            PG8_WAIT_V(8); PG8_WAIT_L(0); PG8_BAR; PG8_MMA(1, 0, At, B0); PG8_MMA(1, 1, At, B1); PG8_BAR; PG8_SCHED;
            PG8_LDB(B0, 1, 0); PG8_LDB(B1, 1, 1); PG8_SCHED; PG8_LDA(At, 1, 0); if constexpr (GATHER) { PG8_STAGE_G(PG8_SA(0, 1), k2b, voC1); } else { PG8_STAGE(PG8_SA(0, 1), a2 + hstep, voffA); }
            PG8_WAIT_V(8); PG8_WAIT_L(0); PG8_BAR; PG8_MMA(0, 0, At, B0); PG8_MMA(0, 1, At, B1); PG8_BAR; PG8_SCHED;
            PG8_LDA(At, 1, 1); PG8_STAGE(PG8_SB(1, 0), b3, voffB); PG8_STAGE(PG8_SB(1, 1), b3 + hstep, voffB); if constexpr (GATHER) { PG8_STAGE_G(PG8_SA(1, 0), k2b + kstep, voC0); } else { PG8_STAGE(PG8_SA(1, 0), a3, voffA); }
            PG8_WAIT_V(8); PG8_WAIT_L(0); PG8_BAR; PG8_MMA(1, 0, At, B0); PG8_MMA(1, 1, At, B1); PG8_BAR; PG8_SCHED;
            } else {
            PG8_LDB(B0, 0, 0); PG8_SCHED; PG8_LDA(At, 0, 0); PG8_STAGE(PG8_SA(1, 1), a1 + hstep, voffA);
            PG8_WAIT_L(8); PG8_BAR; PG8_WAIT_L(0); PG8_MMA(0, 0, At, B0); PG8_BAR; PG8_SCHED;
            PG8_LDB(B1, 0, 1); PG8_STAGE(PG8_SB(0, 0), b2, voffB);
            PG8_BAR; PG8_WAIT_L(0); PG8_MMA(0, 1, At, B1); PG8_BAR;
            PG8_LDA(At, 0, 1); PG8_STAGE(PG8_SA(0, 0), a2, voffA);
            PG8_BAR; PG8_WAIT_L(0); PG8_MMA(1, 0, At, B0); PG8_BAR; PG8_SCHED;
            PG8_STAGE(PG8_SB(0, 1), b2 + hstep, voffB);
            PG8_WAIT_V(6); PG8_BAR; PG8_MMA(1, 1, At, B1); PG8_BAR;
            PG8_LDB(B0, 1, 0); PG8_SCHED; PG8_LDA(At, 1, 0); PG8_STAGE(PG8_SA(0, 1), a2 + hstep, voffA);
            PG8_WAIT_L(8); PG8_BAR; PG8_WAIT_L(0); PG8_MMA(0, 0, At, B0); PG8_BAR; PG8_SCHED;
            PG8_LDB(B1, 1, 1); PG8_STAGE(PG8_SB(1, 0), b3, voffB);
            PG8_BAR; PG8_WAIT_L(0); PG8_MMA(0, 1, At, B1); PG8_BAR;
            PG8_LDA(At, 1, 1); PG8_STAGE(PG8_SA(1, 0), a3, voffA);
            PG8_BAR; PG8_WAIT_L(0); PG8_MMA(1, 0, At, B0); PG8_BAR; PG8_SCHED;
            PG8_STAGE(PG8_SB(1, 1), b3 + hstep, voffB);
            PG8_WAIT_V(6); PG8_BAR; PG8_MMA(1, 1, At, B1); PG8_BAR;
            }
        }
        if constexpr (ALIGN_EPI) { if (wr == 0) PG8_BAR; }
        if constexpr (!Epi::AFTER_DRAIN) { E(acc, cur, wr, wc, fr, fq); S.done(cur); }
        if (!has_next) break;
#pragma unroll
        for (int a = 0; a < 2; ++a)
#pragma unroll
            for (int b = 0; b < 2; ++b)
#pragma unroll
                for (int m = 0; m < 4; ++m)
#pragma unroll
                    for (int n = 0; n < 2; ++n) acc[a][b][m][n] = (f32x4){0.f, 0.f, 0.f, 0.f};
        cur = nxt; cA = nA; cB = nB; ++ui;
        if constexpr (ALIGN_EPI) { if (wr == 1) PG8_BAR; }
    }
    PG8_WAIT_V(0);
    if constexpr (!ALIGN_EPI) { if (wr == 0) PG8_BAR; }
    PG8_BAR;
    if constexpr (Epi::AFTER_DRAIN) { E.fused(acc, cur, wr, wc, fr, fq, lds, wid, lane); S.done(cur); }
#undef PG8_SA
#undef PG8_SB
#undef PG8_STAGE
#undef PG8_STAGE_G
#undef PG8_GOFF
#undef PG8_LDA
#undef PG8_LDB
#undef PG8_MMA
#undef PG8_WAIT_V
#undef PG8_WAIT_L
#undef PG8_BAR
#undef PG8_SCHED
}
}

__device__ __forceinline__ void d_kmean(int vb, const bf16_t* __restrict__ P, float* __restrict__ kmean) {
    int i = vb * blockDim.x + threadIdx.x;
    if (i >= NB * 8 * 64 * 64) return;
    int d = i & 63, n = (i >> 6) & 63, h = (i >> 12) & 7, b = i >> 15;
    float s = 0.f;
    const bf16_t* p = P + L0_AK + hm(b, 8, h, 0, 64) + akf_off(n * 256, d);
    for (int j = 0; j < 256; ++j) s += bf2f(p[(size_t)(j >> 5) * 2048 + (j & 31) * 8]);
    kmean[i] = s * (1.0f / 256.0f);
}
__device__ __forceinline__ void d_combine(int vb, float* __restrict__ h, const bf16_t* __restrict__ ys, const int2* __restrict__ pos, const float* __restrict__ gain, bf16_t* __restrict__ xn, int final) {
    int row = (vb * blockDim.x + threadIdx.x) >> 6, lane = threadIdx.x & 63;
    if (row >= NTOK) return;
    int2 p = pos[row];
    float4* xr = (float4*)(h + (size_t)row * D);
    const ushort4* y0 = (const ushort4*)(ys + (size_t)p.x * D); const ushort4* y1 = (const ushort4*)(ys + (size_t)p.y * D);
    float4 v[4]; float ss = 0.f;
#pragma unroll
    for (int j = 0; j < 4; ++j) { v[j] = xr[64 * j + lane]; ushort4 a = y0[64 * j + lane], c = y1[64 * j + lane];
        v[j].x += bf2f(a.x) + bf2f(c.x); v[j].y += bf2f(a.y) + bf2f(c.y); v[j].z += bf2f(a.z) + bf2f(c.z); v[j].w += bf2f(a.w) + bf2f(c.w);
        ss += v[j].x * v[j].x + v[j].y * v[j].y + v[j].z * v[j].z + v[j].w * v[j].w; }
    ss = wave_sum(ss);
    float rstd = rsqrtf(ss * (1.0f / D) + EPS);
#pragma unroll
    for (int j = 0; j < 4; ++j) {
        float4 g = ((const float4*)gain)[64 * j + lane];
        float4 o = make_float4(v[j].x * rstd * g.x, v[j].y * rstd * g.y, v[j].z * rstd * g.z, v[j].w * rstd * g.w);
        if (final) xr[64 * j + lane] = o;
        else { xr[64 * j + lane] = v[j]; ushort4 ob; ob.x = f2bf(o.x); ob.y = f2bf(o.y); ob.z = f2bf(o.z); ob.w = f2bf(o.w); ((ushort4*)(xn + (size_t)row * D))[64 * j + lane] = ob; }
    }
}


typedef float f32x16 __attribute__((ext_vector_type(16)));
typedef short bf16x8 __attribute__((ext_vector_type(8)));
typedef short s16x4 __attribute__((ext_vector_type(4)));
typedef float f32x2_t __attribute__((ext_vector_type(2)));
typedef __bf16 bf16x2_t __attribute__((ext_vector_type(2)));
__device__ __forceinline__ unsigned cvtpk(float lo, float hi) { f32x2_t v = {lo, hi}; bf16x2_t b = __builtin_convertvector(v, bf16x2_t); return __builtin_bit_cast(unsigned, b); }
__device__ __forceinline__ s16x4 lds_tr16(LAS const char* p) { return __builtin_bit_cast(s16x4, __builtin_amdgcn_ds_read_tr16_b64_v4i16((LAS s16x4*)p)); }
constexpr int VPITCH = 144;
constexpr int ENG_LDS_PER_WAVE = 64 * VPITCH;
constexpr float SM_SCALE = 0.125f * 1.4426950408889634f;
constexpr float NEG_BIG = -1e30f;
struct AttnAcc { f32x16 o0, o1; float m, l; };
__device__ __forceinline__ void acc_init(AttnAcc& a) {
#pragma unroll
    for (int r = 0; r < 16; ++r) { a.o0[r] = 0.f; a.o1[r] = 0.f; }
    a.m = NEG_BIG; a.l = 0.f;
}
__device__ __forceinline__ void attn_tile(AttnAcc& a, const bf16x8 (&qf)[4], const bf16x8 (&kf)[4], LAS const char* vl, int lane, int lo, int hi) {
    const int hh = lane >> 5;
    f32x16 s;
#pragma unroll
    for (int r = 0; r < 16; ++r) s[r] = 0.f;
#pragma unroll
    for (int d0 = 0; d0 < 4; ++d0) s = __builtin_amdgcn_mfma_f32_32x32x16_bf16(kf[d0], qf[d0], s, 0, 0, 0);
    float mx = NEG_BIG;
#pragma unroll
    for (int r = 0; r < 16; ++r) { const int kr = (r & 3) + 8 * (r >> 2) + 4 * hh; s[r] = (kr >= lo && kr <= hi) ? s[r] * SM_SCALE : NEG_BIG; mx = fmaxf(mx, s[r]); }
    mx = fmaxf(mx, __shfl_xor(mx, 32));
    const float mn = fmaxf(a.m, mx), al = __builtin_amdgcn_exp2f(a.m - mn);
    a.m = mn;
    float ps = 0.f;
#pragma unroll
    for (int r = 0; r < 16; ++r) { s[r] = __builtin_amdgcn_exp2f(s[r] - mn); ps += s[r]; }
    a.l = a.l * al + ps;
#pragma unroll
    for (int r = 0; r < 16; ++r) { a.o0[r] *= al; a.o1[r] *= al; }
    bf16x8 pb[2];
#pragma unroll
    for (int ks = 0; ks < 2; ++ks) { u32x4_t w; w.x = cvtpk(s[8 * ks], s[8 * ks + 1]); w.y = cvtpk(s[8 * ks + 2], s[8 * ks + 3]); w.z = cvtpk(s[8 * ks + 4], s[8 * ks + 5]); w.w = cvtpk(s[8 * ks + 6], s[8 * ks + 7]); pb[ks] = __builtin_bit_cast(bf16x8, w); }
    const int li = lane & 15;
    LAS const char* vb = vl + (4 * hh + (li >> 2)) * VPITCH + (16 * ((lane >> 4) & 1) + 4 * (li & 3)) * 2;
#pragma unroll
    for (int ks = 0; ks < 2; ++ks) {
        { const s16x4 lo4 = lds_tr16(vb + (16 * ks) * VPITCH), hi4 = lds_tr16(vb + (16 * ks + 8) * VPITCH);
          const bf16x8 vf = {lo4[0], lo4[1], lo4[2], lo4[3], hi4[0], hi4[1], hi4[2], hi4[3]};
          a.o0 = __builtin_amdgcn_mfma_f32_32x32x16_bf16(vf, pb[ks], a.o0, 0, 0, 0); }
        { const s16x4 lo4 = lds_tr16(vb + (16 * ks) * VPITCH + 64), hi4 = lds_tr16(vb + (16 * ks + 8) * VPITCH + 64);
          const bf16x8 vf = {lo4[0], lo4[1], lo4[2], lo4[3], hi4[0], hi4[1], hi4[2], hi4[3]};
          a.o1 = __builtin_amdgcn_mfma_f32_32x32x16_bf16(vf, pb[ks], a.o1, 0, 0, 0); }
    }
}
template <class KP, class VP, class LH>
__device__ __forceinline__ void attn_run(AttnAcc& a, const bf16x8 (&qf)[4], int t0, int t1, const KP& kp, const VP& vp, const LH& lh, LAS char* vl, int lane) {
    if (t0 >= t1) return;
    bf16x8 kn[4]; u32x4_t vn[4];
    { const bf16_t* k = kp(t0); const bf16_t* v = vp(t0);
#pragma unroll
      for (int i = 0; i < 4; ++i) { kn[i] = *(const bf16x8*)(k + 16 * i); vn[i] = *(const u32x4_t*)(v + 8 * i); } }
    LAS char* vw = vl + (lane >> 1) * VPITCH + (lane & 1) * 64;
    for (int t = t0; t < t1; ++t) {
        bf16x8 kf[4];
#pragma unroll
        for (int i = 0; i < 4; ++i) { kf[i] = kn[i]; *(LAS u32x4_t*)(vw + 16 * i) = vn[i]; }
        if (t + 1 < t1) { const bf16_t* k = kp(t + 1); const bf16_t* v = vp(t + 1);
#pragma unroll
            for (int i = 0; i < 4; ++i) { kn[i] = *(const bf16x8*)(k + 16 * i); vn[i] = *(const u32x4_t*)(v + 8 * i); } }
        int lo, hi; lh(t, lo, hi);
        attn_tile(a, qf, kf, vl, lane, lo, hi);
    }
}

constexpr float SENT = -3.0e38f;
__device__ __forceinline__ float half_max(float v) { auto rr = __builtin_amdgcn_permlane32_swap(__float_as_uint(v), __float_as_uint(v), false, false); return fmaxf(__uint_as_float(rr[0]), __uint_as_float(rr[1])); }
__device__ __forceinline__ float half_sum(float v) { auto rr = __builtin_amdgcn_permlane32_swap(__float_as_uint(v), __float_as_uint(v), false, false); return __uint_as_float(rr[0]) + __uint_as_float(rr[1]); }
__device__ __forceinline__ void acc_init64(AttnAcc& a) {
#pragma unroll
    for (int r = 0; r < 16; ++r) { a.o0[r] = 0.f; a.o1[r] = 0.f; }
    a.m = SENT; a.l = 0.f;
}
__device__ __forceinline__ void attn_qk64(f32x16& s0, f32x16& s1, const bf16x8 (&qf)[4], const bf16x8 (&kf)[8]) {
#pragma unroll
    for (int r = 0; r < 16; ++r) { s0[r] = 0.f; s1[r] = 0.f; }
#pragma unroll
    for (int d0 = 0; d0 < 4; ++d0) { s0 = __builtin_amdgcn_mfma_f32_32x32x16_bf16(kf[d0], qf[d0], s0, 0, 0, 0); s1 = __builtin_amdgcn_mfma_f32_32x32x16_bf16(kf[4 + d0], qf[d0], s1, 0, 0, 0); }
}
__device__ __forceinline__ float max3f(float a, float b, float c) { float r; asm("v_max3_f32 %0, %1, %2, %3" : "=v"(r) : "v"(a), "v"(b), "v"(c)); return r; }
__device__ __forceinline__ void mask_sub(f32x16& s, int mode, int dq  ) {
    if (mode == 1) {
#pragma unroll
        for (int r = 0; r < 16; ++r) if (((r & 3) + 8 * (r >> 2)) < dq) s[r] = SENT;
    } else if (mode == 2) {
#pragma unroll
        for (int r = 0; r < 16; ++r) if (((r & 3) + 8 * (r >> 2)) > dq) s[r] = SENT;
    } else if (mode == 3) {
#pragma unroll
        for (int r = 0; r < 16; ++r) s[r] = SENT;
    }
}
__device__ __forceinline__ void attn_sv64(AttnAcc& a, f32x16& s0, f32x16& s1, LAS const char* vl, int lane, int m0, int m1) {
    const int hh = lane >> 5;
    if (m0 | m1) { const int dq = (lane & 31) - 4 * hh; mask_sub(s0, m0, dq); mask_sub(s1, m1, dq); }
    float mx;
    {
      const float a0 = max3f(s0[0], s0[1], s0[2]), a1 = max3f(s0[3], s0[4], s0[5]), a2 = max3f(s0[6], s0[7], s0[8]), a3 = max3f(s0[9], s0[10], s0[11]), a4 = max3f(s0[12], s0[13], s0[14]);
      const float b0 = max3f(s1[0], s1[1], s1[2]), b1 = max3f(s1[3], s1[4], s1[5]), b2 = max3f(s1[6], s1[7], s1[8]), b3 = max3f(s1[9], s1[10], s1[11]), b4 = max3f(s1[12], s1[13], s1[14]);
      const float c0 = max3f(a0, a1, a2), c1 = max3f(a3, a4, s0[15]), c2 = max3f(b0, b1, b2), c3 = max3f(b3, b4, s1[15]);
      mx = max3f(max3f(c0, c1, c2), c3, SENT); }
    mx = half_max(mx) * SM_SCALE;
    if (!__all(mx <= a.m + 8.0f)) {
        const float mn = fmaxf(a.m, mx), al = __builtin_amdgcn_exp2f(a.m - mn);
        a.m = mn; a.l *= al;
#pragma unroll
        for (int r = 0; r < 16; ++r) { a.o0[r] *= al; a.o1[r] *= al; }
    }
    const float nm = -a.m;
    float ps = 0.f;
#pragma unroll
    for (int r = 0; r < 16; ++r) {
        float p0 = __builtin_amdgcn_exp2f(__builtin_fmaf(s0[r], SM_SCALE, nm)), p1 = __builtin_amdgcn_exp2f(__builtin_fmaf(s1[r], SM_SCALE, nm));
        s0[r] = p0; s1[r] = p1; ps += p0 + p1;
    }
    a.l += ps;
    bf16x8 pb[4];
#pragma unroll
    for (int ks = 0; ks < 2; ++ks) {
        u32x4_t w; w.x = cvtpk(s0[8 * ks], s0[8 * ks + 1]); w.y = cvtpk(s0[8 * ks + 2], s0[8 * ks + 3]); w.z = cvtpk(s0[8 * ks + 4], s0[8 * ks + 5]); w.w = cvtpk(s0[8 * ks + 6], s0[8 * ks + 7]); pb[ks] = __builtin_bit_cast(bf16x8, w);
        u32x4_t v; v.x = cvtpk(s1[8 * ks], s1[8 * ks + 1]); v.y = cvtpk(s1[8 * ks + 2], s1[8 * ks + 3]); v.z = cvtpk(s1[8 * ks + 4], s1[8 * ks + 5]); v.w = cvtpk(s1[8 * ks + 6], s1[8 * ks + 7]); pb[2 + ks] = __builtin_bit_cast(bf16x8, v); }
    const int li = lane & 15;
    LAS const char* vb = vl + (4 * hh + (li >> 2)) * VPITCH + (16 * ((lane >> 4) & 1) + 4 * (li & 3)) * 2;
#pragma unroll
    for (int kh = 0; kh < 2; ++kh) {
        s16x4 t0[4], t1[4];
#pragma unroll
        for (int kk = 0; kk < 2; ++kk) { const int ks = 2 * kh + kk; t0[2 * kk] = lds_tr16(vb + (16 * ks) * VPITCH); t0[2 * kk + 1] = lds_tr16(vb + (16 * ks + 8) * VPITCH); t1[2 * kk] = lds_tr16(vb + (16 * ks) * VPITCH + 64); t1[2 * kk + 1] = lds_tr16(vb + (16 * ks + 8) * VPITCH + 64); }
#pragma unroll
        for (int kk = 0; kk < 2; ++kk) { const int ks = 2 * kh + kk;
            const bf16x8 vf0 = {t0[2 * kk][0], t0[2 * kk][1], t0[2 * kk][2], t0[2 * kk][3], t0[2 * kk + 1][0], t0[2 * kk + 1][1], t0[2 * kk + 1][2], t0[2 * kk + 1][3]};
            const bf16x8 vf1 = {t1[2 * kk][0], t1[2 * kk][1], t1[2 * kk][2], t1[2 * kk][3], t1[2 * kk + 1][0], t1[2 * kk + 1][1], t1[2 * kk + 1][2], t1[2 * kk + 1][3]};
            a.o0 = __builtin_amdgcn_mfma_f32_32x32x16_bf16(vf0, pb[ks], a.o0, 0, 0, 0);
            a.o1 = __builtin_amdgcn_mfma_f32_32x32x16_bf16(vf1, pb[ks], a.o1, 0, 0, 0); }
    }
}
constexpr int KT_BYTES = 64 * 128;
__device__ __forceinline__ void stage_load(u32x4_t (&kn)[8], u32x4_t (&vn)[8], const bf16_t* k0, const bf16_t* k1, const bf16_t* v0, const bf16_t* v1, int rstride, int lane) {
    const size_t o = (size_t)(lane >> 3) * rstride + (lane & 7) * 8, st8 = (size_t)8 * rstride;
#pragma unroll
    for (int i = 0; i < 4; ++i) { kn[i] = *(const u32x4_t*)(k0 + o + i * st8); kn[4 + i] = *(const u32x4_t*)(k1 + o + i * st8); vn[i] = *(const u32x4_t*)(v0 + o + i * st8); vn[4 + i] = *(const u32x4_t*)(v1 + o + i * st8); }
}
__device__ __forceinline__ void stage_write(LAS char* kl, LAS char* vl, const u32x4_t (&kn)[8], const u32x4_t (&vn)[8], int lane) {
    const int r0 = lane >> 3, ch = lane & 7;
#pragma unroll
    for (int i = 0; i < 8; ++i) { const int row = 32 * (i >> 2) + r0 + 8 * (i & 3);
        *(LAS u32x4_t*)(kl + row * 128 + ((ch ^ ((row >> 1) & 7)) * 16)) = kn[i];
        *(LAS u32x4_t*)(vl + row * VPITCH + ch * 16) = vn[i]; }
}
__device__ __forceinline__ void kfrag_read(bf16x8 (&kf)[8], LAS const char* kl, int lane) {
    const int c = lane & 31, hh = lane >> 5, sw = (c >> 1) & 7;
#pragma unroll
    for (int sub = 0; sub < 2; ++sub)
#pragma unroll
        for (int d0 = 0; d0 < 4; ++d0) kf[4 * sub + d0] = __builtin_bit_cast(bf16x8, *(LAS const u32x4_t*)(kl + (32 * sub + c) * 128 + (((2 * d0 + hh) ^ sw) * 16)));
}
template <int KSTR = 16, int VSTR = 8, class KP, class VP, class MK>
__device__ __forceinline__ void attn_run64(AttnAcc& a, const bf16x8 (&qf)[4], int st0, int st1, const KP& kp, const VP& vp, const MK& mk, LAS char* vl, int lane) {
    if (st0 >= st1) return;
    bf16x8 kn[8]; u32x4_t vn[8];
#pragma unroll
    for (int sub = 0; sub < 2; ++sub) { const bf16_t* k = kp(st0, sub); const bf16_t* v = vp(st0, sub);
#pragma unroll
        for (int i = 0; i < 4; ++i) { kn[4 * sub + i] = *(const bf16x8*)(k + KSTR * i); vn[4 * sub + i] = *(const u32x4_t*)(v + VSTR * i); } }
    LAS char* vw = vl + (lane >> 1) * VPITCH + (lane & 1) * 64;
#pragma unroll 1
    for (int st = st0; st < st1; ++st) {
#pragma unroll
        for (int i = 0; i < 8; ++i) *(LAS u32x4_t*)(vw + (i >> 2) * 32 * VPITCH + 16 * (i & 3)) = vn[i];
        if (st + 1 < st1) {
#pragma unroll
            for (int sub = 0; sub < 2; ++sub) { const bf16_t* v = vp(st + 1, sub);
#pragma unroll
                for (int i = 0; i < 4; ++i) vn[4 * sub + i] = *(const u32x4_t*)(v + VSTR * i); } }
        f32x16 s0, s1;
        attn_qk64(s0, s1, qf, kn);
        asm volatile("" : "+v"(s0), "+v"(s1));
        if (st + 1 < st1) {
#pragma unroll
            for (int sub = 0; sub < 2; ++sub) { const bf16_t* k = kp(st + 1, sub);
#pragma unroll
                for (int i = 0; i < 4; ++i) kn[4 * sub + i] = *(const bf16x8*)(k + KSTR * i); } }
        int m0, m1; mk(st, m0, m1);
        attn_sv64(a, s0, s1, vl, lane, m0, m1);
    }
}
__device__ __forceinline__ void attn_finish64(const AttnAcc& a, float& inv_l, float& lse) {
    const float l = half_sum(a.l);
    inv_l = 1.0f / l; lse = (a.m + __log2f(l)) * 0.6931471805599453f;
}
__device__ __forceinline__ void attn_finish(const AttnAcc& a, float& inv_l, float& lse) {
    const float l = a.l + __shfl_xor(a.l, 32);
    inv_l = 1.0f / l; lse = (a.m + __log2f(l)) * 0.6931471805599453f;
}
__device__ __forceinline__ void store_o(bf16_t* op, const f32x16& o0, const f32x16& o1, float sc, int hh) {
#pragma unroll
    for (int rr = 0; rr < 4; ++rr) {
        uint2 w0, w1; w0.x = cvtpk(o0[4 * rr] * sc, o0[4 * rr + 1] * sc); w0.y = cvtpk(o0[4 * rr + 2] * sc, o0[4 * rr + 3] * sc);
        w1.x = cvtpk(o1[4 * rr] * sc, o1[4 * rr + 1] * sc); w1.y = cvtpk(o1[4 * rr + 2] * sc, o1[4 * rr + 3] * sc);
        *(uint2*)(op + 8 * rr + 4 * hh) = w0; *(uint2*)(op + 32 + 8 * rr + 4 * hh) = w1; }
}

__device__ __forceinline__ void store_o_frag(bf16_t* op, const f32x16& o0, const f32x16& o1, float sc, int hh) {
    u32x4_t* q = (u32x4_t*)(op + 32 * hh);
#pragma unroll
    for (int g = 0; g < 2; ++g) { u32x4_t w0, w1;
        w0.x = cvtpk(o0[8 * g] * sc, o0[8 * g + 1] * sc); w0.y = cvtpk(o0[8 * g + 2] * sc, o0[8 * g + 3] * sc); w0.z = cvtpk(o0[8 * g + 4] * sc, o0[8 * g + 5] * sc); w0.w = cvtpk(o0[8 * g + 6] * sc, o0[8 * g + 7] * sc);
        w1.x = cvtpk(o1[8 * g] * sc, o1[8 * g + 1] * sc); w1.y = cvtpk(o1[8 * g + 2] * sc, o1[8 * g + 3] * sc); w1.z = cvtpk(o1[8 * g + 4] * sc, o1[8 * g + 5] * sc); w1.w = cvtpk(o1[8 * g + 6] * sc, o1[8 * g + 7] * sc);
        q[g] = w0; q[2 + g] = w1; }
}
__device__ __forceinline__ void fma_frag(f32x16& o0, f32x16& o1, const u32x4_t (&v)[4], float w) {
#pragma unroll
    for (int g = 0; g < 2; ++g)
#pragma unroll
        for (int i = 0; i < 4; ++i) { const unsigned a = v[g][i], b = v[2 + g][i];
            o0[8 * g + 2 * i] += w * __uint_as_float(a << 16); o0[8 * g + 2 * i + 1] += w * __uint_as_float(a & 0xffff0000u);
            o1[8 * g + 2 * i] += w * __uint_as_float(b << 16); o1[8 * g + 2 * i + 1] += w * __uint_as_float(b & 0xffff0000u); }
}
__device__ __forceinline__ void load_frag(u32x4_t (&v)[4], const bf16_t* pp, int hh) {
    const u32x4_t* q = (const u32x4_t*)(pp + 32 * hh);
#pragma unroll
    for (int g = 0; g < 4; ++g) v[g] = q[g];
}
__device__ __forceinline__ void add_partial(f32x16& o0, f32x16& o1, const bf16_t* pp, float w, int hh) {
#pragma unroll
    for (int rr = 0; rr < 4; ++rr) {
        const uint2 w0 = *(const uint2*)(pp + 8 * rr + 4 * hh), w1 = *(const uint2*)(pp + 32 + 8 * rr + 4 * hh);
        o0[4 * rr] += w * __uint_as_float(w0.x << 16); o0[4 * rr + 1] += w * __uint_as_float(w0.x & 0xffff0000u); o0[4 * rr + 2] += w * __uint_as_float(w0.y << 16); o0[4 * rr + 3] += w * __uint_as_float(w0.y & 0xffff0000u);
        o1[4 * rr] += w * __uint_as_float(w1.x << 16); o1[4 * rr + 1] += w * __uint_as_float(w1.x & 0xffff0000u); o1[4 * rr + 2] += w * __uint_as_float(w1.y << 16); o1[4 * rr + 3] += w * __uint_as_float(w1.y & 0xffff0000u); }
}


constexpr size_t HB_MPO = 0, HB_MPL = 96 * MiB, HB_MLIST = 100 * MiB;
constexpr int CW_LCNT = 2048;
constexpr int LIST_PER_BH = 64 * 16384 - 128 * 64 * 65;
__device__ __forceinline__ int list_off(int bh, int n) { return bh * LIST_PER_BH + n * 16384 - 128 * n * (n + 1); }
__device__ __forceinline__ void d_moba_route(int vb, const bf16_t* __restrict__ P, const float* __restrict__ kmean, unsigned* __restrict__ lcnt, unsigned short* __restrict__ lists, float* __restrict__ mpl, LAS unsigned* lc  ) {
    const int i = vb * NTH + threadIdx.x;
    const int pos = i & (S - 1), h = (i >> 14) & 7, b = i >> 17, bh = b * 8 + h;
    const size_t tok = (size_t)b * S + pos;
    if (threadIdx.x < 64) lc[threadIdx.x] = 0u;
    LAS float* kml = (LAS float*)(lc + 256);
    { const u32x4_t* src = (const u32x4_t*)(kmean + (size_t)bh * 64 * 64) + threadIdx.x * 2; LAS u32x4_t* dst = (LAS u32x4_t*)kml + threadIdx.x * 2; dst[0] = src[0]; dst[1] = src[1]; }
    __syncthreads();
    float q[64];
    { const bf16_t* qp = P + L0_AQ + hm(b, 8, h, pos, 64);
#pragma unroll
      for (int c = 0; c < 8; ++c) { const uint4 u = ((const uint4*)qp)[c]; const unsigned w[4] = {u.x, u.y, u.z, u.w};
#pragma unroll
          for (int t = 0; t < 4; ++t) { q[c * 8 + 2 * t] = __uint_as_float(w[t] << 16); q[c * 8 + 2 * t + 1] = __uint_as_float(w[t] & 0xffff0000u); } } }
    const int qb = pos >> 8;
    float bv[3] = {-INFINITY, -INFINITY, -INFINITY}; int bi[3] = {-1, -1, -1};
    for (int n = 0; n < qb; ++n) {
        float g = 0.f;
#pragma unroll
        for (int d4 = 0; d4 < 16; ++d4) { const f32x4_t kv = ((LAS const f32x4_t*)kml)[n * 16 + d4]; g += q[4 * d4] * kv[0] + q[4 * d4 + 1] * kv[1] + q[4 * d4 + 2] * kv[2] + q[4 * d4 + 3] * kv[3]; }
        if (g > bv[0]) { bv[2] = bv[1]; bi[2] = bi[1]; bv[1] = bv[0]; bi[1] = bi[0]; bv[0] = g; bi[0] = n; }
        else if (g > bv[1]) { bv[2] = bv[1]; bi[2] = bi[1]; bv[1] = g; bi[1] = n; }
        else if (g > bv[2]) { bv[2] = g; bi[2] = n; }
    }
    unsigned lr[3];
#pragma unroll
    for (int k = 0; k < 3; ++k) lr[k] = bi[k] >= 0 ? __hip_atomic_fetch_add(&lc[bi[k]], 1u, __ATOMIC_RELAXED, __HIP_MEMORY_SCOPE_WORKGROUP) : 0u;
    __syncthreads();
    if (threadIdx.x < 64) { const unsigned n = lc[threadIdx.x]; lc[64 + threadIdx.x] = n ? atomicAdd(&lcnt[bh * 64 + threadIdx.x], n) : 0u; }
    __syncthreads();
#pragma unroll
    for (int k = 0; k < 3; ++k) {
        if (bi[k] >= 0) lists[list_off(bh, bi[k]) + lc[64 + bi[k]] + lr[k]] = (unsigned short)(pos | (k << 14));
        else mpl[(tok * 8 + h) * 3 + k] = NEG_BIG;
    }
    __syncthreads();
}
constexpr int KP_R = 144, VP_R = 272;
__device__ __forceinline__ float ret_log2gamma(int h) { return __log2f(1.0f - exp2f(-5.0f - (float)h)); }
__device__ __forceinline__ void ret_state_item(int item, const bf16_t* __restrict__ P, float* __restrict__ stateT, LAS char* lds, int wave, int lane) {
    const int n = item & 127, h = (item >> 7) & 3, b = item >> 9;
    const float l2g = ret_log2gamma(h);
    const int t = wave * 64 + lane, row = t >> 2, part = t & 3;
    LAS char* Ks = lds; LAS char* Vs = lds + 128 * KP_R;
    const bf16_t* rkb = P + L0_RK + hm(b, 4, h, 0, 64); const bf16_t* rvp = P + L0_RV + hm(b, 4, h, n * 128 + row, 128);
    { const float sc = __builtin_amdgcn_exp2f(l2g * (float)(127 - row));
#pragma unroll
      for (int i = 0; i < 2; ++i) { const uint4 u = *(const uint4*)(rkb + akf_off(n * 128 + row, part * 16 + 8 * i)); const unsigned w[4] = {u.x, u.y, u.z, u.w}; u32x4_t o;
#pragma unroll
          for (int q = 0; q < 4; ++q) o[q] = cvtpk(__uint_as_float(w[q] << 16) * sc, __uint_as_float(w[q] & 0xffff0000u) * sc);
          *(LAS u32x4_t*)(Ks + row * KP_R + part * 32 + i * 16) = o; }
      const u32x4_t* vp = (const u32x4_t*)(rvp + part * 32);
#pragma unroll
      for (int i = 0; i < 4; ++i) *(LAS u32x4_t*)(Vs + row * VP_R + part * 64 + i * 16) = vp[i]; }
    __syncthreads();
    const int et = wave >> 1, dt = wave & 1, li = lane & 15, hh = lane >> 5, c = lane & 31;
    const int rsel = 4 * hh + (li >> 2), csel = 16 * ((lane >> 4) & 1) + 4 * (li & 3);
    LAS const char* va = Vs + rsel * VP_R + (32 * et + csel) * 2;
    LAS const char* ka = Ks + rsel * KP_R + (32 * dt + csel) * 2;
    f32x16 acc;
#pragma unroll
    for (int r = 0; r < 16; ++r) acc[r] = 0.f;
#pragma unroll
    for (int ks = 0; ks < 8; ++ks) {
        const s16x4 v0 = lds_tr16(va + (16 * ks) * VP_R), v1 = lds_tr16(va + (16 * ks + 8) * VP_R);
        const s16x4 k0 = lds_tr16(ka + (16 * ks) * KP_R), k1 = lds_tr16(ka + (16 * ks + 8) * KP_R);
        const bf16x8 af = {v0[0], v0[1], v0[2], v0[3], v1[0], v1[1], v1[2], v1[3]}, bfr = {k0[0], k0[1], k0[2], k0[3], k1[0], k1[1], k1[2], k1[3]};
        acc = __builtin_amdgcn_mfma_f32_32x32x16_bf16(af, bfr, acc, 0, 0, 0);
    }
    float* op = stateT + (size_t)item * 8192 + 32 * dt + c;
#pragma unroll
    for (int r = 0; r < 16; ++r) op[(32 * et + (r & 3) + 8 * (r >> 2) + 4 * hh) * 64] = acc[r];
    __syncthreads();
}
__device__ __forceinline__ void ret_scan_thread(int i, const float* __restrict__ stateT, bf16_t* __restrict__ rprevT) {
    const int ed = i & 8191, bh = i >> 13, h = bh & 3;
    const float gc = __builtin_amdgcn_exp2f(ret_log2gamma(h) * 128.0f); float r = 0.f;
    const int e_ = ed >> 6, d_ = ed & 63;
    const float* sp = stateT + (size_t)bh * 128 * 8192 + ed; bf16_t* op = rprevT + (size_t)bh * 128 * 8192 + akf_off(e_, d_);
    for (int n0 = 0; n0 < 128; n0 += 8) { float v[8];
#pragma unroll
        for (int q = 0; q < 8; ++q) v[q] = sp[(size_t)(n0 + q) * 8192];
#pragma unroll
        for (int q = 0; q < 8; ++q) { op[(size_t)(n0 + q) * 8192] = f2bf(r); r = gc * r + v[q]; } }
}
__device__ __forceinline__ void ret_out_item(int item, const bf16_t* __restrict__ P, const bf16_t* __restrict__ rprevT, bf16_t* __restrict__ AO, LAS char* vl, int lane) {
    const int n = (item >> 2) & 127, h = (item >> 9) & 3, b = item >> 11, j = b ? 3 - (item & 3) : (item & 3);
    const int c = lane & 31, hh = lane >> 5, li = lane & 15;
    const float l2g = ret_log2gamma(h);
    const size_t tok0 = (size_t)b * S + n * 128, tok = tok0 + 32 * j + c;
    const int posr = n * 128 + 32 * j + c;
    const bf16_t* qrow = P + L0_RQ + hm(b, 4, h, posr, 64) + 8 * hh;
    bf16x8 qf[4];
#pragma unroll
    for (int i = 0; i < 4; ++i) qf[i] = *(const bf16x8*)(qrow + 16 * i);
    f32x16 acc[4];
#pragma unroll
    for (int et = 0; et < 4; ++et)
#pragma unroll
        for (int r = 0; r < 16; ++r) acc[et][r] = 0.f;
    { const bf16_t* rp = rprevT + ((size_t)((b * 4 + h) * 128 + n)) * 8192 + lane * 8;
#pragma unroll
      for (int et = 0; et < 4; ++et)
#pragma unroll
          for (int ks = 0; ks < 4; ++ks) { const bf16x8 af = *(const bf16x8*)(rp + (et * 4 + ks) * 512); acc[et] = __builtin_amdgcn_mfma_f32_32x32x16_bf16(af, qf[ks], acc[et], 0, 0, 0); } }
    const int iq = 32 * j + c;
    { const float sc = __builtin_amdgcn_exp2f(l2g * (float)(iq + 1));
#pragma unroll
      for (int et = 0; et < 4; ++et)
#pragma unroll
          for (int r = 0; r < 16; ++r) acc[et][r] *= sc; }
    const bf16_t* Kb = P + L0_RK + hm(b, 4, h, n * 128, 64) + lane * 8;
    const bf16_t* Vb = P + L0_RV + hm(b, 4, h, n * 128, 128) + (lane & 1) * 64;
    LAS char* vw = vl + (lane >> 1) * VP_R + (lane & 1) * 128;
    LAS const char* vb = vl + (4 * hh + (li >> 2)) * VP_R + (16 * ((lane >> 4) & 1) + 4 * (li & 3)) * 2;
    for (int tt = 0; tt <= j; ++tt) {
        bf16x8 kf[4]; u32x4_t vn[8];
        { const bf16_t* k = Kb + (size_t)tt * 2048; const bf16_t* v = Vb + (size_t)(32 * tt + (lane >> 1)) * 128;
#pragma unroll
          for (int i = 0; i < 4; ++i) kf[i] = *(const bf16x8*)(k + 512 * i);
#pragma unroll
          for (int i = 0; i < 8; ++i) vn[i] = *(const u32x4_t*)(v + 8 * i); }
#pragma unroll
        for (int i = 0; i < 8; ++i) *(LAS u32x4_t*)(vw + 16 * i) = vn[i];
        f32x16 s;
#pragma unroll
        for (int r = 0; r < 16; ++r) s[r] = 0.f;
#pragma unroll
        for (int d0 = 0; d0 < 4; ++d0) s = __builtin_amdgcn_mfma_f32_32x32x16_bf16(kf[d0], qf[d0], s, 0, 0, 0);
#pragma unroll
        for (int r = 0; r < 16; ++r) { const int dlt = iq - (32 * tt + (r & 3) + 8 * (r >> 2) + 4 * hh); s[r] = dlt >= 0 ? s[r] * __builtin_amdgcn_exp2f(l2g * (float)dlt) : 0.f; }
        bf16x8 pb[2];
#pragma unroll
        for (int ks = 0; ks < 2; ++ks) { u32x4_t w; w.x = cvtpk(s[8 * ks], s[8 * ks + 1]); w.y = cvtpk(s[8 * ks + 2], s[8 * ks + 3]); w.z = cvtpk(s[8 * ks + 4], s[8 * ks + 5]); w.w = cvtpk(s[8 * ks + 6], s[8 * ks + 7]); pb[ks] = __builtin_bit_cast(bf16x8, w); }
#pragma unroll
        for (int ks = 0; ks < 2; ++ks)
#pragma unroll
            for (int et = 0; et < 4; ++et) { const s16x4 lo4 = lds_tr16(vb + (16 * ks) * VP_R + et * 64), hi4 = lds_tr16(vb + (16 * ks + 8) * VP_R + et * 64);
                const bf16x8 vf = {lo4[0], lo4[1], lo4[2], lo4[3], hi4[0], hi4[1], hi4[2], hi4[3]};
                acc[et] = __builtin_amdgcn_mfma_f32_32x32x16_bf16(vf, pb[ks], acc[et], 0, 0, 0); }
    }
    float sum = 0.f;
#pragma unroll
    for (int et = 0; et < 4; ++et)
#pragma unroll
        for (int r = 0; r < 16; ++r) sum += acc[et][r];
    sum += __shfl_xor(sum, 32);
    const float mu = sum * (1.0f / 128.0f); float sq = 0.f;
#pragma unroll
    for (int et = 0; et < 4; ++et)
#pragma unroll
        for (int r = 0; r < 16; ++r) { const float dl = acc[et][r] - mu; sq += dl * dl; }
    sq += __shfl_xor(sq, 32);
    const float rs = rsqrtf(sq * (1.0f / 128.0f) + EPS);
    const bf16_t* gp = P + L0_RG + hm(b, 4, h, posr, 128) + 4 * hh;
    bf16_t* op = AO + tok * D + 512 + h * 128 + 4 * hh;
#pragma unroll
    for (int et = 0; et < 4; ++et)
#pragma unroll
        for (int rr = 0; rr < 4; ++rr) { const uint2 g = *(const uint2*)(gp + 32 * et + 8 * rr);
            const float g0 = __uint_as_float(g.x << 16), g1 = __uint_as_float(g.x & 0xffff0000u), g2 = __uint_as_float(g.y << 16), g3 = __uint_as_float(g.y & 0xffff0000u);
            uint2 w; w.x = cvtpk((acc[et][4 * rr] - mu) * rs * silu(g0), (acc[et][4 * rr + 1] - mu) * rs * silu(g1)); w.y = cvtpk((acc[et][4 * rr + 2] - mu) * rs * silu(g2), (acc[et][4 * rr + 3] - mu) * rs * silu(g3));
            *(uint2*)(op + 32 * et + 8 * rr) = w; }
}
constexpr int CB_BYTES = KT_BYTES + 64 * VPITCH;
template <bool PHASEB>
__device__ __forceinline__ void dilated_coop(const bf16_t* __restrict__ P, bf16_t* __restrict__ dpo, float* __restrict__ dpl, bf16_t* __restrict__ AO, LAS char* lds, int wave, int lane) {
    constexpr int SEG = PHASEB ? 16 : 32;
    const int c = lane & 31, hh = lane >> 5, t = wave * 64 + lane, key = t >> 3, chunk = t & 7;
    const int nseg = PHASEB ? NB * 16 * 16 : NB * 16 * 16;
    for (int sg = blockIdx.x; sg < nseg; sg += gridDim.x) {
        int b, h, dil, r, s0, br;
        if (!PHASEB) { const int q = sg & 7; br = (sg >> 3) & 1; h = (sg >> 4) & 15; b = sg >> 8; dil = br ? 4 : 1; if (br) { r = q >> 1; s0 = (q & 1) * 32; } else { r = 0; s0 = q * 32; } }
        else { br = 2; r = sg & 15; h = (sg >> 4) & 15; b = sg >> 8; dil = 16; s0 = 0; }
        const int nst = (S / dil) / 64;
        const int sbeg = s0 >= 2 ? s0 - 2 : 0, send = s0 + SEG;
        const bf16_t* Kb = P + L1_K + hm(b, 16, h, r, 64) + chunk * 8; const bf16_t* Vb = P + L1_V + hm(b, 16, h, r, 64) + chunk * 8;
        const size_t rs = (size_t)dil * 64;
        int j = 2 * s0 + wave; const int jend = 2 * s0 + 2 * SEG;
        bf16x8 qf[4];
        { const bf16_t* q = P + L1_Q + hm(b, 16, h, r + dil * (32 * j + c), 64) + 8 * hh;
#pragma unroll
          for (int i = 0; i < 4; ++i) qf[i] = *(const bf16x8*)(q + 16 * i); }
        AttnAcc a; acc_init64(a);
        float pl1 = 0.f, pl2 = 0.f; u32x4_t po1[4], po2[4];
        LAS char* kw = lds + key * 128 + ((chunk ^ ((key >> 1) & 7)) * 16); LAS char* vw = lds + KT_BYTES + key * VPITCH + chunk * 16;
        u32x4_t k1, v1, k2, v2;
        { const u32x4_t k0 = *(const u32x4_t*)(Kb + (size_t)(64 * sbeg + key) * rs), v0 = *(const u32x4_t*)(Vb + (size_t)(64 * sbeg + key) * rs);
          const int s1 = sbeg + 1 < nst ? sbeg + 1 : sbeg;
          k1 = *(const u32x4_t*)(Kb + (size_t)(64 * s1 + key) * rs); v1 = *(const u32x4_t*)(Vb + (size_t)(64 * s1 + key) * rs);
          *(LAS u32x4_t*)(kw + (sbeg & 1) * CB_BYTES) = k0; *(LAS u32x4_t*)(vw + (sbeg & 1) * CB_BYTES) = v0; }
        __syncthreads();
#pragma unroll 1
        for (int s = sbeg; s < send; ++s) {
            { const int s2 = s + 2 < nst ? s + 2 : nst - 1;
              k2 = *(const u32x4_t*)(Kb + (size_t)(64 * s2 + key) * rs); v2 = *(const u32x4_t*)(Vb + (size_t)(64 * s2 + key) * rs); }
            const int fs = j >= 4 ? (j - 4) >> 1 : 0, ls = j >> 1;
            if (j < jend && s >= fs && s <= ls) {
                LAS char* kl = lds + (s & 1) * CB_BYTES;
                if (PHASEB && s == fs) { const size_t tok = (size_t)b * S + r + (size_t)dil * (32 * j + c), pi = (tok * 16 + h) * 2; pl1 = dpl[pi]; pl2 = dpl[pi + 1];
                    load_frag(po1, dpo + pi * 64, hh); load_frag(po2, dpo + (pi + 1) * 64, hh); }
                bf16x8 kf[8]; kfrag_read(kf, kl, lane);
                f32x16 s0v, s1v;
                attn_qk64(s0v, s1v, qf, kf);
                const int tta = 2 * s - (j - 4), ttb = tta + 1;
                const int m0 = (tta < 0 || tta > 4) ? 3 : (tta == 0 ? 1 : (tta == 4 ? 2 : 0)), m1 = (ttb < 0 || ttb > 4) ? 3 : (ttb == 0 ? 1 : (ttb == 4 ? 2 : 0));
                attn_sv64(a, s0v, s1v, kl + KT_BYTES, lane, m0, m1);
                if (s == ls) {
                    float inv, lse; attn_finish64(a, inv, lse);
                    const size_t tok = (size_t)b * S + r + (size_t)dil * (32 * j + c);
                    if (!PHASEB) { const size_t pi = (tok * 16 + h) * 2 + br; store_o_frag(dpo + pi * 64, a.o0, a.o1, inv, hh); if (hh == 0) dpl[pi] = lse; }
                    else { const float mxl = fmaxf(fmaxf(pl1, pl2), lse);
                        const float w1 = __expf(pl1 - mxl), w2 = __expf(pl2 - mxl), w3 = __expf(lse - mxl), iw = 1.0f / (w1 + w2 + w3), s3 = w3 * inv;
#pragma unroll
                        for (int q = 0; q < 16; ++q) { a.o0[q] *= s3; a.o1[q] *= s3; }
                        fma_frag(a.o0, a.o1, po1, w1); fma_frag(a.o0, a.o1, po2, w2);
                        store_o(AO + tok * D + h * 64, a.o0, a.o1, iw, hh); }
                    j += 8; acc_init64(a);
                    if (j < jend) { const bf16_t* q = P + L1_Q + hm(b, 16, h, r + dil * (32 * j + c), 64) + 8 * hh;
#pragma unroll
                        for (int i = 0; i < 4; ++i) qf[i] = *(const bf16x8*)(q + 16 * i); }
                }
            }
            if (s + 1 < send) { const int bn = ((s + 1) & 1) * CB_BYTES; *(LAS u32x4_t*)(kw + bn) = k1; *(LAS u32x4_t*)(vw + bn) = v1; }
            asm volatile("s_waitcnt lgkmcnt(0)" ::: "memory"); __builtin_amdgcn_s_barrier(); asm volatile("" ::: "memory");
            k1 = k2; v1 = v2;
        }
    }
}
__device__ __forceinline__ void router_tile(int tile, int khalf, const float* __restrict__ h, const float4* __restrict__ WR, const float4* __restrict__ WR2, const float* __restrict__ bg, const float* __restrict__ bfine,
                                            int2* __restrict__ toke, float2* __restrict__ tokg, float* __restrict__ tokrs, unsigned* __restrict__ tokrank, unsigned* __restrict__ tilecnt, LAS float* xch, int lane,
                                            const float* __restrict__ gain, bf16_t* __restrict__ xn) {
    const int c = lane & 31, hh = lane >> 5, tok = tile * 32 + c;
    const float4* hp = (const float4*)(h + (size_t)tok * D) + hh + 128 * khalf;
    const float4* gp = (const float4*)gain + hh + 128 * khalf; uint2* xo = (uint2*)(xn + (size_t)tok * D) + hh + 128 * khalf;
    const float4* w1p = WR + (64 * khalf) * 64 + lane; const float4* w2p = WR2 + (64 * khalf) * 64 + lane;
    f32x16 acc, acc2;
#pragma unroll
    for (int r = 0; r < 16; ++r) { acc[r] = 0.f; acc2[r] = 0.f; }
    float ss = 0.f;
#pragma unroll 8
    for (int g = 0; g < 64; ++g) {
        const float4 x = hp[2 * g], w = w1p[g * 64], w2 = w2p[g * 64];
        acc = __builtin_amdgcn_mfma_f32_32x32x2f32(w.x, x.x, acc, 0, 0, 0);   acc2 = __builtin_amdgcn_mfma_f32_32x32x2f32(w2.x, x.x, acc2, 0, 0, 0);
        acc = __builtin_amdgcn_mfma_f32_32x32x2f32(w.y, x.y, acc, 0, 0, 0);   acc2 = __builtin_amdgcn_mfma_f32_32x32x2f32(w2.y, x.y, acc2, 0, 0, 0);
        acc = __builtin_amdgcn_mfma_f32_32x32x2f32(w.z, x.z, acc, 0, 0, 0);   acc2 = __builtin_amdgcn_mfma_f32_32x32x2f32(w2.z, x.z, acc2, 0, 0, 0);
        acc = __builtin_amdgcn_mfma_f32_32x32x2f32(w.w, x.w, acc, 0, 0, 0);   acc2 = __builtin_amdgcn_mfma_f32_32x32x2f32(w2.w, x.w, acc2, 0, 0, 0);
        ss += x.x * x.x + x.y * x.y + x.z * x.z + x.w * x.w;
        { const float4 gn = gp[2 * g]; uint2 o; o.x = cvtpk(x.x * gn.x, x.y * gn.y); o.y = cvtpk(x.z * gn.z, x.w * gn.w); xo[2 * g] = o; }
    }
    if (khalf == 1) {
#pragma unroll
        for (int r = 0; r < 16; ++r) xch[r * 64 + lane] = acc[r];
#pragma unroll
        for (int r = 0; r < 4; ++r) xch[(16 + r) * 64 + lane] = acc2[r];
        xch[20 * 64 + lane] = ss;
    }
    __syncthreads();
    if (khalf == 1) return;
#pragma unroll
    for (int r = 0; r < 16; ++r) acc[r] += xch[r * 64 + lane];
#pragma unroll
    for (int r = 0; r < 4; ++r) acc2[r] += xch[(16 + r) * 64 + lane];
    ss += xch[20 * 64 + lane];
    ss += __shfl_xor(ss, 32);
    const float rstd = rsqrtf(ss * (1.0f / D) + EPS);
    float gl[4] = {acc2[0] * rstd + bg[0], acc2[1] * rstd + bg[1], acc2[2] * rstd + bg[2], acc2[3] * rstd + bg[3]};
    int grp = 0; float gm = gl[0];
#pragma unroll
    for (int q = 1; q < 4; ++q) if (gl[q] > gm) { gm = gl[q]; grp = q; }
    float gs = 0.f;
#pragma unroll
    for (int q = 0; q < 4; ++q) gs += __expf(gl[q] - gm);
    const float gval = 1.0f / gs;
    { const int og = __shfl_xor(grp, 32); if (hh) grp = og; }
    float mine[4], oth[4];
#pragma unroll
    for (int q = 0; q < 4; ++q) { mine[q] = grp == 0 ? acc[q] : (grp == 1 ? acc[4 + q] : (grp == 2 ? acc[8 + q] : acc[12 + q])); oth[q] = __shfl_xor(mine[q], 32); }
    float fl[8];
#pragma unroll
    for (int q = 0; q < 4; ++q) { fl[q] = hh == 0 ? mine[q] : oth[q]; fl[4 + q] = hh == 0 ? oth[q] : mine[q]; }
#pragma unroll
    for (int q = 0; q < 8; ++q) fl[q] = fl[q] * rstd + bfine[grp * 8 + q];
    int i0 = 0; float v0 = fl[0];
#pragma unroll
    for (int q = 1; q < 8; ++q) if (fl[q] > v0) { v0 = fl[q]; i0 = q; }
    int i1 = -1; float v1 = -INFINITY;
#pragma unroll
    for (int q = 0; q < 8; ++q) if (q != i0 && fl[q] > v1) { v1 = fl[q]; i1 = q; }
    const float w0 = 1.0f / (1.0f + __expf(v1 - v0)), w1 = 1.0f - w0;
    const int e0 = hh == 0 ? grp * 8 + i0 : -1, e1 = hh == 0 ? grp * 8 + i1 : -1;
    const unsigned long long lt = (1ull << lane) - 1ull;
    unsigned r0 = 0, r1 = 0, mycnt = 0;
    for (int e = 0; e < NEXP; ++e) {
        const unsigned long long b0 = __ballot(e0 == e), b1 = __ballot(e1 == e);
        const unsigned n0 = __popcll(b0);
        if (e0 == e) r0 = __popcll(b0 & lt);
        if (e1 == e) r1 = n0 + __popcll(b1 & lt);
        if (lane == e) mycnt = n0 + __popcll(b1);
    }
    if (hh == 0) {
        toke[tok] = make_int2(e0, e1); tokg[tok] = make_float2(gval * w0, gval * w1); tokrs[tok] = rstd; tokrank[tok] = r0 | (r1 << 16);
        tilecnt[tile * 32 + lane] = mycnt;
    }
}
__device__ __forceinline__ void moe_plan_block(const unsigned* __restrict__ tilecnt, LAS int* sm, unsigned* pst_g, unsigned* ntl_g, int* texp_g) {
    const int t = threadIdx.x, e = t & 31, ch = t >> 5;
    LAS int* cs = sm; LAS int* cp = sm + 512; LAS int* pst = sm + 1024; LAS int* tb = sm + 1064;
    { int sacc = 0;
#pragma unroll 8
      for (int i = 0; i < 64; ++i) sacc += (int)tilecnt[(ch * 64 + i) * 32 + e];
      cs[ch * 32 + e] = sacc; }
    __syncthreads();
    if (t < 32) { int run = 0; for (int q = 0; q < 16; ++q) { cp[q * 32 + t] = run; run += cs[q * 32 + t]; } cs[t] = run;   }
    __syncthreads();
    if (t == 0) { int pacc = 0; for (int q = 0; q < NEXP; ++q) { pst[q] = pacc; const int pad = ((cs[q] + 255) >> 8) << 8;
            if (blockIdx.x == 0) { pst_g[q] = pacc; for (int tt = pacc >> 8; tt < (pacc + pad) >> 8; ++tt) texp_g[tt] = q; }
            pacc += pad; }
        pst[NEXP] = pacc; if (blockIdx.x == 0) { pst_g[NEXP] = pacc; ntl_g[0] = pacc >> 8; } }
    __syncthreads();
    if (t < 128) { const int q = t >> 5, tile = blockIdx.x * 4 + q; int base = pst[e] + cp[(tile >> 6) * 32 + e];
        for (int i = (tile >> 6) * 64; i < tile; ++i) base += (int)tilecnt[i * 32 + e];
        tb[q * 32 + e] = base; }
    __syncthreads();
}
__device__ __forceinline__ void moe_scatter_idx(int tok, const int2* toke, const float2* tokg, const float* tokrs, const unsigned* tokrank, LAS const int* tbq, int* rowtok, float* rowgate, float* rowscale, int2* pos) {
    const int2 e = toke[tok]; const unsigned rk = tokrank[tok];
    const int d0 = tbq[e.x] + (int)(rk & 0xffffu), d1 = tbq[e.y] + (int)(rk >> 16);
    const float2 g = tokg[tok]; const float rs = tokrs[tok];
    rowtok[d0] = tok; rowtok[d1] = tok; rowgate[d0] = g.x; rowgate[d1] = g.y; rowscale[d0] = rs; rowscale[d1] = rs; pos[tok] = make_int2(d0, d1);
}
__device__ __forceinline__ void d_moe_scatter_gather(int tok, int lane, const int2* toke, const float2* tokg, const unsigned* pst, unsigned* cur, float* rowgate, int2* pos, const bf16_t* __restrict__ xn, bf16_t* __restrict__ xs) {
    int2 e = toke[tok]; float2 g = tokg[tok];
    unsigned d0 = 0, d1 = 0;
    if (lane == 0) { d0 = pst[e.x] + atomicAdd(&cur[e.x], 1u); d1 = pst[e.y] + atomicAdd(&cur[e.y], 1u); rowgate[d0] = g.x; rowgate[d1] = g.y; pos[tok] = make_int2((int)d0, (int)d1); }
    d0 = __shfl(d0, 0); d1 = __shfl(d1, 0);
    const uint4* src = (const uint4*)(xn + (size_t)tok * D);
    uint4 a = src[lane], b = src[lane + 64];
    uint4* o0 = (uint4*)(xs + (size_t)d0 * D); uint4* o1 = (uint4*)(xs + (size_t)d1 * D);
    o0[lane] = a; o0[lane + 64] = b; o1[lane] = a; o1[lane + 64] = b;
}

__device__ __forceinline__ unsigned pk2(float lo, float hi) { return (unsigned)f2bf(lo) | ((unsigned)f2bf(hi) << 16); }
__device__ __forceinline__ void transpose_item(const float* __restrict__ W, int ldw, int k0, int c0, bf16_t* __restrict__ dst  , int K, LAS float* scr, int lane) {
#pragma unroll 8
    for (int i = 0; i < 32; ++i) { const int kk = 2 * i + (lane >> 5); scr[kk * 33 + (lane & 31)] = W[(size_t)(k0 + kk) * ldw + c0 + (lane & 31)]; }
    asm volatile("s_waitcnt lgkmcnt(0)" ::: "memory");
    const int c = lane & 7;
#pragma unroll
    for (int j = 0; j < 4; ++j) { const int n = (lane >> 3) + 8 * j; const LAS float* s = scr + (8 * c) * 33 + n;
        uint4 o; o.x = pk2(s[0 * 33], s[1 * 33]); o.y = pk2(s[2 * 33], s[3 * 33]); o.z = pk2(s[4 * 33], s[5 * 33]); o.w = pk2(s[6 * 33], s[7 * 33]);
        *(uint4*)(dst + (size_t)n * K + k0 + 8 * c) = o; }
    asm volatile("s_waitcnt lgkmcnt(0)" ::: "memory");
}
__device__ __forceinline__ void tr_inproj(int it, const float* W, bf16_t* WT, int layer, LAS float* scr, int lane) {
    const int kb = it / 96, g = it % 96, pn = g >> 3, q = g & 7, bj = q >> 2, wc = q & 3;
    const bool rotary = layer == 0 ? (pn < 4) : (pn < 8);
    const int c0 = rotary ? 256 * pn + 64 * wc + 32 * bj : 32 * g;
    transpose_item(W, PW, 64 * kb, c0, WT + (size_t)(32 * g) * D, D, scr, lane);
}
__device__ __forceinline__ void tr_outproj(int it, const float* W, bf16_t* WT, LAS float* scr, int lane) {
    const int kb = it / 32, g = it % 32;
    transpose_item(W, D, 64 * kb, 32 * g, WT + (size_t)(32 * g) * D, D, scr, lane);
}
__device__ __forceinline__ void tr_expert(int it, const float* wg, const float* wu, const float* wd, bf16_t* WE, LAS float* scr, int lane) {
    const int e = it / 768, r = it % 768;
    bf16_t* base = WE + (size_t)e * WEXP_E;
    if (r < 512) { const int kb = r / 32, g = r % 32, pn = g >> 3, q = g & 7, bj = q >> 2, wc = q & 3;
        const float* W = (bj ? wu : wg) + (size_t)e * D * HID;
        transpose_item(W, HID, 64 * kb, 128 * pn + 32 * wc, base + (size_t)(32 * g) * D, D, scr, lane);
    } else { const int r2 = r - 512, kb = r2 / 32, g = r2 % 32;
        transpose_item(wd + (size_t)e * HID * D, D, 64 * kb, 32 * g, base + (size_t)D * D + (size_t)(32 * g) * HID, HID, scr, lane); }
}

struct Params {
    const float *x, *mix_norm_even, *w_in_even, *w_out_even, *mix_norm_odd, *w_in_odd, *w_out_odd, *ffn_norm, *w_rg, *b_rg, *w_re, *b_re, *w_eg, *w_eu, *w_ed, *final_norm;
    float* hbuf; unsigned char* ws;
};
#define FOR_VB(n) for (int vb = blockIdx.x; vb < (int)(n); vb += gridDim.x)
constexpr int LDS_BYTES = 147456;

template <class Epi>
__device__ __forceinline__ void run_gemm(PG8_LAS unsigned char* lds, const bf16_t* A, const bf16_t* Bt, int M, int N, int K, const Epi& E) {
    pg8::Gemm g{A, Bt, M, N, K}; pg8::StaticOrder S_; S_.init(M, N, (int)gridDim.x, (int)blockIdx.x);
    pg8::gemm_phase<Epi, pg8::StaticOrder, true, true>(lds, g, S_, E);
}

#define XB_TMO      128
#define XB_XCNT(j)  (256  + 64 * (j))
#define XB_XSUB(j)  (1280 + 64 * (j))
#define XB_XGEN(j)  (2304 + 64 * (j))
#define XB_TOP      3328
#define XB_TOPGEN   3392
#define XCD_BAR_WORDS 3456
#define XB_SPIN_CAP (1u << 18)

__device__ __forceinline__ unsigned xb_ld(unsigned* p)              { return __hip_atomic_load(p, __ATOMIC_RELAXED, __HIP_MEMORY_SCOPE_AGENT); }
__device__ __forceinline__ unsigned xb_add(unsigned* p, unsigned v) { return __hip_atomic_fetch_add(p, v, __ATOMIC_RELAXED, __HIP_MEMORY_SCOPE_AGENT); }
__device__ __forceinline__ unsigned xb_xcc_id() { return (unsigned)__builtin_amdgcn_s_getreg((3 << 11) | 20) & 0xFu; }
#define XB_SPIN(cond, bar) do { unsigned _sp = 0; while (cond) { __builtin_amdgcn_s_sleep(1); \
    if ((++_sp & 255u) == 0u) { if (xb_ld(&(bar)[XB_TMO])) break; if (_sp > XB_SPIN_CAP) { atomicAdd(&(bar)[XB_TMO], 1u); break; } } } } while (0)

struct XcdBarrier {
    unsigned* bar; unsigned x;
    volatile LAS unsigned* st;
};

__device__ __forceinline__ XcdBarrier xcd_barrier_post(unsigned* bar, volatile LAS unsigned* st) {
    XcdBarrier b; b.bar = bar; b.x = xb_xcc_id(); b.st = st;
    if (threadIdx.x == 0) (void)xb_add(&bar[XB_XCNT(b.x)], 1u);
    return b;
}
__device__ __forceinline__ void xcd_barrier_complete(unsigned* bar, unsigned x, unsigned& nloc, unsigned& nx) {
    const unsigned G = gridDim.x * gridDim.y * gridDim.z;
    unsigned sum, cnt, mine, sp = 0u;
    for (;;) {
        sum = 0u; cnt = 0u; mine = 0u;
#pragma unroll
        for (unsigned j = 0; j < 16; ++j) { const unsigned c = xb_ld(&bar[XB_XCNT(j)]); sum += c; cnt += (c > 0u) ? 1u : 0u; mine = (j == x) ? c : mine; }
        if (sum == G) break;
        __builtin_amdgcn_s_sleep(1);
        if ((++sp & 255u) == 0u) { if (xb_ld(&bar[XB_TMO])) break; if (sp > XB_SPIN_CAP) { atomicAdd(&bar[XB_TMO], 1u); break; } }
    }
    nloc = mine > 0u ? mine : 1u; nx = cnt > 0u ? cnt : 1u;
}

__device__ __forceinline__ void xcd_barrier(const XcdBarrier& b) {
    asm volatile("s_waitcnt vmcnt(0)" ::: "memory");
    __syncthreads();
    if (threadIdx.x == 0) {
        unsigned* bar = b.bar;
        __builtin_amdgcn_s_waitcnt(0);
        unsigned nloc = b.st[0], nx = b.st[1];
        if (nloc == 0u) { xcd_barrier_complete(bar, b.x, nloc, nx); b.st[0] = nloc; b.st[1] = nx; }
        const unsigned old = xb_add(&bar[XB_XSUB(b.x)], 1u);
        const unsigned gen = old / nloc;
        if (old + 1u == (gen + 1u) * nloc) {
            __builtin_amdgcn_fence(__ATOMIC_RELEASE, "agent");
            asm volatile("s_waitcnt vmcnt(0)" ::: "memory");
            const unsigned og = xb_add(&bar[XB_TOP], 1u);
            const unsigned tg = og / nx;
            if (og + 1u == (tg + 1u) * nx) xb_add(&bar[XB_TOPGEN], 1u);
            else XB_SPIN(xb_ld(&bar[XB_TOPGEN]) == tg, bar);
            __builtin_amdgcn_fence(__ATOMIC_ACQUIRE, "agent");
            xb_add(&bar[XB_XGEN(b.x)], 1u);
            asm volatile("s_waitcnt vmcnt(0)" ::: "memory");
        } else {
            XB_SPIN(xb_ld(&bar[XB_XGEN(b.x)]) == gen, bar);
            __builtin_amdgcn_fence(__ATOMIC_ACQUIRE, "agent");
            asm volatile("s_waitcnt vmcnt(0)" ::: "memory");
        }
    }
    __syncthreads();
}


#ifndef PROBE_MASK
#define PROBE_MASK 0
#endif
__device__ __forceinline__ void probe_end(int gid, unsigned long long& t0) {
    const unsigned long long t1 = __builtin_amdgcn_s_memrealtime();
    if ((PROBE_MASK >> gid) & 1) { const unsigned long long tend = t1 + (t1 - t0); while (__builtin_amdgcn_s_memrealtime() < tend) __builtin_amdgcn_s_sleep(8); }
    t0 = __builtin_amdgcn_s_memrealtime();
}
#define GSYNC(gid) do { xcd_barrier(xbar); if (PROBE_MASK) probe_end(gid, pt0); } while (0)
__device__ __forceinline__ void moe_phases(const Params& p, const XcdBarrier& xbar, PG8_LAS unsigned char* lds, int layer, unsigned long long& pt0) {
    unsigned char* ws = p.ws; unsigned* ctl = (unsigned*)(ws + WS_CTL);
    unsigned* pst = ctl + CW_PST + 40 * layer;
    unsigned* ntl = ctl + CW_NT + layer; int* texp = (int*)(ctl + CW_TEXP + 320 * layer);
    float* rowgate = (float*)(ctl + CW_ROWGATE + layer * MP_MAX);
    int2* toke = (int2*)(ws + WS_TOKE); float2* tokg = (float2*)(ws + WS_TOKG); int2* pos = (int2*)(ws + WS_POS);
    bf16_t* xn = (bf16_t*)(ws + WS_XN); bf16_t* big = (bf16_t*)(ws + WS_BIG); bf16_t* hs = (bf16_t*)(ws + WS_HS);
    const bf16_t* wexp = (const bf16_t*)(ws + WS_WEXP);
    const int lane = my_lane(), wave = __builtin_amdgcn_readfirstlane(threadIdx.x >> 6);
    float* rowscale = (float*)(ctl + CW_ROWSCALE + layer * MP_MAX); float* tokrs = (float*)(ws + WS_TOKRS);
    unsigned* tokrank = (unsigned*)(ws + WS_TOKRANK); unsigned* tilecnt = (unsigned*)(ws + WS_TILECNT);
    int* rowtok = (int*)(ctl + CW_ROWTOK + layer * MP_MAX);
    for (int t0 = blockIdx.x * 4; t0 < NTOK / 32; t0 += gridDim.x * 4) {
        router_tile(t0 + (wave & 3), wave >> 2, p.hbuf, (const float4*)(ws + WS_WR) + layer * 128 * 64, (const float4*)(ws + WS_WR2) + layer * 128 * 64, p.b_rg + layer * 4, p.b_re + layer * 32,
                    toke, tokg, tokrs, tokrank, tilecnt, (LAS float*)lds + (wave & 3) * (21 * 64), lane, p.ffn_norm + layer * D, xn);
        __syncthreads(); }
    GSYNC(7);
    { LAS int* sm = (LAS int*)lds;
      moe_plan_block(tilecnt, sm, pst, ntl, texp);
      if (threadIdx.x < 128) { const int q = threadIdx.x >> 5, tok = (blockIdx.x * 4 + q) * 32 + (threadIdx.x & 31);
          moe_scatter_idx(tok, toke, tokg, tokrs, tokrank, sm + 1064 + q * 32, rowtok, rowgate, rowscale, pos); } }
    GSYNC(9);
    const int mp = (int)ntl[0] * 256;
    { pg8::Gemm g{xn, wexp, mp, 1024, D, rowtok}; pg8::MoeOrder S_; S_.init(mp, 1024, (int)gridDim.x, (int)blockIdx.x); S_.texp = texp; S_.estride_bytes = WEXP_E * 2;
      pg8::EpiMoe1F E{hs, rowscale};
      pg8::gemm_phase<pg8::EpiMoe1F, pg8::MoeOrder, true, true, true>(lds, g, S_, E); }
    GSYNC(10);
    { pg8::Gemm g{hs, wexp + (size_t)D * D, mp, D, HID}; pg8::MoeOrder S_; S_.init(mp, D, (int)gridDim.x, (int)blockIdx.x); S_.texp = texp; S_.estride_bytes = WEXP_E * 2;
      pg8::EpiMoe2F E{big, rowgate};
      pg8::gemm_phase<pg8::EpiMoe2F, pg8::MoeOrder, true, true>(lds, g, S_, E); }
    GSYNC(11);
}

__global__ void __launch_bounds__(NTH, 2) mega(Params p) {
    extern __shared__ __attribute__((aligned(16))) unsigned char lds_raw[];
    PG8_LAS unsigned char* lds = (PG8_LAS unsigned char*)lds_raw;
    cg::grid_group grid = cg::this_grid();
    { volatile LAS unsigned* stw = (volatile LAS unsigned*)(lds + LDS_BYTES - 256); if (threadIdx.x < 2) stw[threadIdx.x] = 0u; }
    __syncthreads();
    const XcdBarrier xbar = xcd_barrier_post((unsigned*)(p.ws + WS_CTL) + CW_BAR, (volatile LAS unsigned*)(lds + LDS_BYTES - 256));
    unsigned long long pt0 = PROBE_MASK ? __builtin_amdgcn_s_memrealtime() : 0ull;
    unsigned char* ws = p.ws;
    float2* rot = (float2*)(ws + WS_ROT); float2* ret = (float2*)(ws + WS_RET);
    float* kmean = (float*)(ws + WS_KMEAN);
    int2* pos = (int2*)(ws + WS_POS);
    float* rstate = (float*)(ws + WS_RSTATE); float* rprev = (float*)(ws + WS_RPREV);
    bf16_t* xn = (bf16_t*)(ws + WS_XN); bf16_t* ao = (bf16_t*)(ws + WS_AO); bf16_t* big = (bf16_t*)(ws + WS_BIG);
    bf16_t* win0 = (bf16_t*)(ws + WS_WIN0); bf16_t* wout0 = (bf16_t*)(ws + WS_WOUT0); bf16_t* win1 = (bf16_t*)(ws + WS_WIN1); bf16_t* wout1 = (bf16_t*)(ws + WS_WOUT1);
    bf16_t* wexp = (bf16_t*)(ws + WS_WEXP);
    float* hbuf = p.hbuf;
    const int wave = __builtin_amdgcn_readfirstlane(threadIdx.x >> 6);
    const int gw = blockIdx.x * NWAVES + wave, NGW = gridDim.x * NWAVES;
    const int lane = my_lane();
    LAS float* scr = (LAS float*)(lds + wave * 8448);

    FOR_VB(S * 32 / NTH) d_tables(vb, rot, ret);
    for (int it = gw; it < 1536 + 512 + 1536 + 512 + 24576; it += NGW) {
        int r = it;
        if (r < 1536) { tr_inproj(r, p.w_in_even, win0, 0, scr, lane); continue; } r -= 1536;
        if (r < 512) { tr_outproj(r, p.w_out_even, wout0, scr, lane); continue; } r -= 512;
        if (r < 1536) { tr_inproj(r, p.w_in_odd, win1, 1, scr, lane); continue; } r -= 1536;
        if (r < 512) { tr_outproj(r, p.w_out_odd, wout1, scr, lane); continue; } r -= 512;
        tr_expert(r, p.w_eg, p.w_eu, p.w_ed, wexp, scr, lane);
    }
    FOR_VB(NTOK * 64 / NTH) d_rmsnorm(vb, p.x, p.mix_norm_even, xn);
    for (int i = blockIdx.x * NTH + (int)threadIdx.x; i < 2 * 128 * 64; i += gridDim.x * NTH) {
        const int ln = i & 63, g = (i >> 6) & 127, layer = i >> 13, k0 = 8 * g + 4 * (ln >> 5), col = ln & 31;
        const float* gn = p.ffn_norm + layer * D + k0; const float* w = p.w_re + ((size_t)layer * D + k0) * 32 + col;
        ((float4*)(ws + WS_WR))[i] = make_float4(gn[0] * w[0], gn[1] * w[32], gn[2] * w[64], gn[3] * w[96]);
        float4 v2 = make_float4(0.f, 0.f, 0.f, 0.f);
        if (col < 4) { const float* w2 = p.w_rg + ((size_t)layer * D + k0) * 4 + col; v2 = make_float4(gn[0] * w2[0], gn[1] * w2[4], gn[2] * w2[8], gn[3] * w2[12]); }
        ((float4*)(ws + WS_WR2))[i] = v2;
    }
    if (p.ws == nullptr) grid.sync();
    GSYNC(0);
    { pg8::EpiInprojF E{big, rot, ret, 0, 0}; run_gemm(lds, xn, win0, NTOK, PW, D, E); }
    GSYNC(1);
    FOR_VB(NB * 8 * 64 * 64 / NTH) d_kmean(vb, big, kmean);
    { const int lane2 = my_lane(); for (int it = blockIdx.x; it < NB * 4 * 128; it += gridDim.x) ret_state_item(it, big, rstate, (LAS char*)lds, wave, lane2); }
    GSYNC(2);
    unsigned* lcnt = (unsigned*)(ws + WS_CTL) + CW_LCNT;
    bf16_t* mpo = (bf16_t*)((unsigned char*)hbuf + HB_MPO); float* mpl = (float*)((unsigned char*)hbuf + HB_MPL); unsigned short* mlist = (unsigned short*)((unsigned char*)hbuf + HB_MLIST);
    if (threadIdx.x < 256) { for (int i = blockIdx.x * 256 + (int)threadIdx.x; i < NB * 4 * 8192; i += gridDim.x * 256) ret_scan_thread(i, rstate, (bf16_t*)rprev); }
    FOR_VB(NB * 8 * S / NTH) { const int rng = vb & 31, vb2 = (vb & ~31) | (((vb >> 8) & 1) ? 31 - rng : rng);
        d_moba_route(vb2, big, kmean, lcnt, mlist, mpl, (LAS unsigned*)lds); }
    GSYNC(3);
    { const int lane2 = my_lane(); LAS char* vl = (LAS char*)(lds + 65536 + wave * (32 * VP_R)); for (int it = gw; it < NB * 4 * 128 * 4; it += NGW) ret_out_item(it, big, (const bf16_t*)rprev, ao, vl, lane2); }
    {
      LAS int* pre = (LAS int*)(lds + 136192);
      { const int t = threadIdx.x; const int c0 = ((int)lcnt[2 * t] + 31) >> 5, c1 = ((int)lcnt[2 * t + 1] + 31) >> 5;
        LAS int* sc = (LAS int*)(lds + 141312);
        sc[t] = c0 + c1; __syncthreads();
        for (int o = 1; o < NTH; o <<= 1) { const int v = t >= o ? sc[t - o] : 0; __syncthreads(); sc[t] += v; __syncthreads(); }
        const int ex = sc[t] - (c0 + c1); pre[2 * t] = ex; pre[2 * t + 1] = ex + c0; if (t == NTH - 1) pre[1024] = sc[t];
        __syncthreads(); }
      const int lane2 = my_lane(), c = lane2 & 31, hh = lane2 >> 5; LAS char* vl = (LAS char*)(lds + wave * ENG_LDS_PER_WAVE);
      const int total = pre[1024];
      for (int ch = gw; ch < total; ch += NGW) {
          int l = 0;
#pragma unroll
          for (int st = 512; st > 0; st >>= 1) if (pre[l + st] <= ch) l += st;
          const int bh = l >> 6, n = l & 63, b = bh >> 3, h = bh & 7, idx = (ch - pre[l]) * 32 + c, cntl = (int)lcnt[l];
          const bool valid = idx < cntl;
          const unsigned ent = mlist[list_off(bh, n) + (valid ? idx : 0)];
          const int pos = ent & 16383, k = ent >> 14;
          const size_t rowb = (size_t)b * S, tok = rowb + pos;
          const bf16_t* qrow = big + L0_AQ + hm(b, 8, h, pos, 64) + 8 * hh;
          bf16x8 qf[4];
#pragma unroll
          for (int i = 0; i < 4; ++i) qf[i] = *(const bf16x8*)(qrow + 16 * i);
          AttnAcc a; acc_init64(a);
          const bf16_t* Kb = big + L0_AK + hm(b, 8, h, n * 256, 64) + lane2 * 8;
          const bf16_t* Vb = big + L0_AV + hm(b, 8, h, n * 256, 64) + lane2 * 8;
          auto kp = [&](int st, int sub) { return Kb + (size_t)(2 * st + sub) * 2048; };
          auto vp = [&](int st, int sub) { return Vb + (size_t)(2 * st + sub) * 2048; };
          auto mk = [&](int, int& m0, int& m1) { m0 = 0; m1 = 0; };
          attn_run64<512, 512>(a, qf, 0, 4, kp, vp, mk, vl, lane2);
          float inv, lse; attn_finish64(a, inv, lse);
          if (valid) { const size_t pi = (tok * 8 + h) * 3 + k; store_o_frag(mpo + pi * 64, a.o0, a.o1, inv, hh); if (hh == 0) mpl[pi] = lse; }
      } }
    GSYNC(4);
    {
      const int lane2 = my_lane(), c = lane2 & 31, hh = lane2 >> 5; LAS char* vl = (LAS char*)(lds + wave * ENG_LDS_PER_WAVE);
      for (int it = gw; it < NB * 8 * 512; it += NGW) {
          const int bh = it >> 9, qb = (it >> 3) & 63, j8 = ((bh >> 2) & 1) ? 7 - (it & 7) : (it & 7), b = bh >> 3, h = bh & 7;
          const size_t rowb = (size_t)b * S, tok = rowb + qb * 256 + j8 * 32 + c;
          const bf16_t* qrow = big + L0_AQ + hm(b, 8, h, qb * 256 + j8 * 32 + c, 64) + 8 * hh;
          bf16x8 qf[4];
#pragma unroll
          for (int i = 0; i < 4; ++i) qf[i] = *(const bf16x8*)(qrow + 16 * i);
          AttnAcc a; acc_init64(a);
          const bf16_t* Kb = big + L0_AK + hm(b, 8, h, qb * 256, 64) + lane2 * 8;
          const bf16_t* Vb = big + L0_AV + hm(b, 8, h, qb * 256, 64) + lane2 * 8;
          auto kp = [&](int st, int sub) { return Kb + (size_t)(2 * st + sub) * 2048; };
          auto vp = [&](int st, int sub) { return Vb + (size_t)(2 * st + sub) * 2048; };
          auto mk = [&](int st, int& m0, int& m1) { const int ta = 2 * st, tb = 2 * st + 1; m0 = ta == j8 ? 2 : 0; m1 = tb == j8 ? 2 : (tb > j8 ? 3 : 0); };
          attn_run64<512, 512>(a, qf, 0, (j8 >> 1) + 1, kp, vp, mk, vl, lane2);
          float inv, lse0; attn_finish64(a, inv, lse0);
          const size_t pi = (tok * 8 + h) * 3;
          const float l1 = mpl[pi], l2 = mpl[pi + 1], l3 = mpl[pi + 2], mxl = fmaxf(fmaxf(lse0, l1), fmaxf(l2, l3));
          const float w0 = __expf(lse0 - mxl), w1 = __expf(l1 - mxl), w2 = __expf(l2 - mxl), w3 = __expf(l3 - mxl), iw = 1.0f / (w0 + w1 + w2 + w3);
          const float s0 = w0 * inv;
#pragma unroll
          for (int q = 0; q < 16; ++q) { a.o0[q] *= s0; a.o1[q] *= s0; }
          { u32x4_t pf[4];
            if (w1 > 0.f) { load_frag(pf, mpo + pi * 64, hh); fma_frag(a.o0, a.o1, pf, w1); }
            if (w2 > 0.f) { load_frag(pf, mpo + (pi + 1) * 64, hh); fma_frag(a.o0, a.o1, pf, w2); }
            if (w3 > 0.f) { load_frag(pf, mpo + (pi + 2) * 64, hh); fma_frag(a.o0, a.o1, pf, w3); } }
          store_o(ao + tok * D + h * 64, a.o0, a.o1, iw, hh);
      } }
    GSYNC(5);
    { pg8::EpiOutprojF E{p.x, hbuf}; run_gemm(lds, ao, wout0, NTOK, D, D, E); }
    GSYNC(6);
    moe_phases(p, xbar, lds, 0, pt0);
    FOR_VB(NTOK * 64 / NTH) d_combine(vb, hbuf, big, pos, p.mix_norm_odd, xn, 0);
    { const int lane2 = my_lane(); LAS float* scr2 = (LAS float*)(lds + __builtin_amdgcn_readfirstlane(threadIdx.x >> 6) * 8448);
      for (int it = gw; it < 24576; it += NGW) tr_expert(it, p.w_eg + (size_t)NEXP * D * HID, p.w_eu + (size_t)NEXP * D * HID, p.w_ed + (size_t)NEXP * HID * D, wexp, scr2, lane2); }
    GSYNC(12);
    { pg8::EpiInprojF E{big, rot, ret, 1, 0}; run_gemm(lds, xn, win1, NTOK, PW, D, E); }
    GSYNC(1);
    { const int lane2 = my_lane(); dilated_coop<false>(big, (bf16_t*)(ws + WS_DPO), (float*)(ws + WS_DPL), ao, (LAS char*)lds, wave, lane2); }
    GSYNC(13);
    { const int lane2 = my_lane(); dilated_coop<true>(big, (bf16_t*)(ws + WS_DPO), (float*)(ws + WS_DPL), ao, (LAS char*)lds, wave, lane2); }
    GSYNC(14);
    { pg8::EpiOutprojF E{hbuf, hbuf}; run_gemm(lds, ao, wout1, NTOK, D, D, E); }
    GSYNC(6);
    moe_phases(p, xbar, lds, 1, pt0);
    FOR_VB(NTOK * 64 / NTH) d_combine(vb, hbuf, big, pos, p.final_norm, xn, 1);
}

extern "C" void kernel_launch(void* const* d_in, const int* in_sizes, int n_in, void* d_out, int out_size, void* d_ws, size_t ws_size, hipStream_t stream) {
    if (n_in != 16 || ws_size < WS_END || out_size != NTOK * D) { fprintf(stderr, "kernel_launch: unexpected sizes n_in %d ws %zu out %d\n", n_in, ws_size, out_size); return; }
    static int grid_blocks = 0;
    if (!grid_blocks) {
        int dev = 0, cus = 0, per_cu = 0;
        (void)hipGetDevice(&dev);
        (void)hipDeviceGetAttribute(&cus, hipDeviceAttributeMultiprocessorCount, dev);
        (void)hipFuncSetAttribute((const void*)mega, hipFuncAttributeMaxDynamicSharedMemorySize, LDS_BYTES);
        (void)hipOccupancyMaxActiveBlocksPerMultiprocessor(&per_cu, mega, NTH, LDS_BYTES);
        if (per_cu < 1) per_cu = 1;
        grid_blocks = cus * per_cu;
        fprintf(stderr, "kernel_launch: cus %d per_cu %d grid %d\n", cus, per_cu, grid_blocks);
    }
    Params p{};
    const float** pp = (const float**)&p;
    for (int i = 0; i < 16; ++i) pp[i] = (const float*)d_in[i];
    p.hbuf = (float*)d_out; p.ws = (unsigned char*)d_ws;
    (void)hipMemsetAsync((unsigned char*)d_ws + WS_CTL, 0, CTL_BYTES, stream);
    void* args[] = {&p};
    hipError_t e = hipLaunchCooperativeKernel((void*)mega, dim3(grid_blocks), dim3(NTH), args, LDS_BYTES, stream);
    if (e != hipSuccess) fprintf(stderr, "cooperative launch failed: %s (grid %d)\n", hipGetErrorString(e), grid_blocks);
}
```

```cpp
#include <hip/hip_runtime.h>
#include <hip/hip_cooperative_groups.h>
#include <cstdio>
#include <cstdint>
namespace cg = cooperative_groups;

typedef unsigned short bf16_t;
__device__ __forceinline__ float bf2f(bf16_t v) { return __uint_as_float(((unsigned)v) << 16); }
__device__ __forceinline__ bf16_t f2bf(float f) { unsigned u = __float_as_uint(f); return (bf16_t)((u + 0x7fffu + ((u >> 16) & 1u)) >> 16); }

constexpr int NB = 2, S = 16384, D = 1024, NTOK = NB * S;
constexpr int PW = 3072;
constexpr int NEXP = 32, HID = 512;
constexpr int MP_MAX = 2 * NTOK + NEXP * 256;
constexpr float EPS = 1e-6f;
constexpr int NTH = 512, NWAVES = 8;

constexpr size_t MiB = 1u << 20;
constexpr size_t WS_CTL = 0, CTL_BYTES = 2 * MiB;
constexpr size_t WS_ROT = 2 * MiB, WS_RET = 6 * MiB;
constexpr size_t WS_KMEAN = 10 * MiB;
constexpr size_t WS_TOKE = 12 * MiB, WS_TOKG = 13 * MiB, WS_POS = 14 * MiB, WS_TOKRS = 15 * MiB;
constexpr size_t WS_WR = 11 * MiB, WS_WR2 = 11 * MiB + 256 * 1024;
constexpr size_t WS_TOKRANK = 15 * MiB + 512 * 1024, WS_TILECNT = 11 * MiB + 512 * 1024;
constexpr size_t WS_WIN0 = 16 * MiB, WS_WOUT0 = 22 * MiB, WS_WIN1 = 24 * MiB, WS_WOUT1 = 30 * MiB;
constexpr size_t WS_WEXP = 32 * MiB;
constexpr size_t WEXP_E = 3 * MiB / 2;
constexpr size_t WS_XN = 128 * MiB, WS_AO = 128 * MiB;
constexpr size_t WS_BIG = 192 * MiB;
constexpr size_t WS_HS = 400 * MiB, WS_RSTATE = 400 * MiB, WS_RPREV = 432 * MiB;
constexpr size_t WS_DPO = 400 * MiB, WS_DPL = 528 * MiB;
constexpr size_t WS_XN2 = 336 * MiB;
constexpr size_t WS_X16 = 464 * MiB;
constexpr size_t WS_RSTD = 15 * MiB + 640 * 1024;
constexpr size_t WS_END = 532 * MiB;
constexpr int CW_CNT = 0;
constexpr int CW_CUR = 64;
constexpr int CW_PST = 128;
constexpr int CW_NT = 256;
constexpr int CW_TEXP = 512;
constexpr int CW_ROWGATE = 4096;
constexpr int CW_ROWSCALE = 4096 + 2 * MP_MAX;
constexpr int CW_BAR = ((CW_ROWSCALE + 2 * MP_MAX + 63) / 64) * 64;
constexpr int CW_ROWTOK = CW_BAR + 3584;
static_assert((CW_ROWTOK + 2 * MP_MAX) * 4 <= (int)CTL_BYTES, "ctl");

constexpr size_t L0_AQ = 0, L0_AK = (size_t)NTOK * 512, L0_AV = (size_t)NTOK * 1024, L0_RQ = (size_t)NTOK * 1536, L0_RK = (size_t)NTOK * 1792, L0_RV = (size_t)NTOK * 2048, L0_RG = (size_t)NTOK * 2560;
constexpr size_t L1_Q = 0, L1_K = (size_t)NTOK * 1024, L1_V = (size_t)NTOK * 2048;
__device__ __forceinline__ size_t hm(int b, int H, int h, int s, int W) { return ((size_t)(b * H + h) * S + s) * W; }
__device__ __forceinline__ size_t akf_off(int s, int d) { return ((size_t)((s >> 5) * 4 + (d >> 4)) * 64 + (((d >> 3) & 1) * 32 + (s & 31))) * 8 + (d & 7); }
__device__ __forceinline__ size_t avf_off(int s, int d) { return ((size_t)((s >> 5) * 4 + ((d >> 3) & 3)) * 64 + (2 * (s & 31) + (d >> 5))) * 8 + (d & 7); }
__device__ __forceinline__ size_t pcol_off(int layer, int col, int b, int s) {
    if (layer == 0) {
        if (col < 1536) { const int reg = col >> 9, w = col & 511, hd = w >> 6, d = w & 63;
            if (reg == 1) return L0_AK + hm(b, 8, hd, 0, 64) + akf_off(s, d);
            if (reg == 2) return L0_AV + hm(b, 8, hd, 0, 64) + avf_off(s, d);
            return hm(b, 8, hd, s, 64) + d; }
        if (col < 2048) { const int reg = (col - 1536) >> 8, w = (col - 1536) & 255;
            if (reg == 1) return L0_RK + hm(b, 4, w >> 6, 0, 64) + akf_off(s, w & 63);
            return L0_RQ + hm(b, 4, w >> 6, s, 64) + (w & 63); }
        const int reg = (col - 2048) >> 9, w = (col - 2048) & 511; return L0_RV + (size_t)reg * NTOK * 512 + hm(b, 4, w >> 7, s, 128) + (w & 127);
    }
    const int reg = col >> 10, w = col & 1023; return (size_t)reg * NTOK * 1024 + hm(b, 16, w >> 6, s, 64) + (w & 63);
}
__device__ __forceinline__ size_t pcol_off_u(int layer, int ucol, int lc, int b, int s) {
    ucol = __builtin_amdgcn_readfirstlane(ucol); b = __builtin_amdgcn_readfirstlane(b);
    if (layer == 0) {
        if (ucol < 1536) { const int reg = ucol >> 9, w = ucol & 511, hd = w >> 6, d = (w & 63) + lc;
            if (reg == 1) return L0_AK + hm(b, 8, hd, 0, 64) + akf_off(s, d);
            if (reg == 2) return L0_AV + hm(b, 8, hd, 0, 64) + avf_off(s, d);
            return hm(b, 8, hd, 0, 64) + (size_t)(s * 64 + d); }
        if (ucol < 2048) { const int reg = (ucol - 1536) >> 8, w = (ucol - 1536) & 255;
            if (reg == 1) return L0_RK + hm(b, 4, w >> 6, 0, 64) + akf_off(s, (w & 63) + lc);
            return L0_RQ + hm(b, 4, w >> 6, 0, 64) + (size_t)(s * 64 + (w & 63) + lc); }
        const int reg = (ucol - 2048) >> 9, w = (ucol - 2048) & 511; return L0_RV + (size_t)reg * NTOK * 512 + hm(b, 4, w >> 7, 0, 128) + (size_t)(s * 128 + (w & 127) + lc);
    }
    const int reg = ucol >> 10, w = ucol & 1023; return (size_t)reg * NTOK * 1024 + hm(b, 16, w >> 6, 0, 64) + (size_t)(s * 64 + (w & 63) + lc);
}
__device__ __forceinline__ float wave_sum(float v) {
#pragma unroll
    for (int o = 32; o > 0; o >>= 1) v += __shfl_xor(v, o);
    return v;
}
#define LAS __attribute__((address_space(3)))
typedef unsigned u32x4_t __attribute__((ext_vector_type(4)));
typedef float f32x4_t __attribute__((ext_vector_type(4)));
__device__ __forceinline__ int my_lane() { int l; asm volatile("v_mbcnt_lo_u32_b32 %0, -1, 0\n\tv_mbcnt_hi_u32_b32 %0, -1, %0" : "=v"(l)); return l; }
__device__ __forceinline__ float silu(float x) { return x * __builtin_amdgcn_rcpf(1.0f + __expf(-x)); }

__device__ __forceinline__ void d_tables(int vb, float2* rot, float2* ret) {
    int i = vb * blockDim.x + threadIdx.x;
    if (i >= S * 32) return;
    int pos = i >> 5, j = i & 31;
    float inv = 1.0f / powf(10000.0f, (float)j * (2.0f / 64.0f));
    float ang = (float)pos * inv;
    rot[(size_t)((((pos >> 4) * 4 + (j >> 3)) * 4 + ((j >> 1) & 3)) * 16 + (pos & 15)) * 2 + (j & 1)] = make_float2(cosf(ang), sinf(ang));
    float fr = 1.0f / powf(10000.0f, (float)j / 31.0f);
    float a2 = (float)pos * fr;
    ret[(size_t)(((((pos >> 4) * 2 + (j >> 4)) * 4 + ((j >> 2) & 3)) * 2 + ((j >> 1) & 1)) * 16 + (pos & 15)) * 2 + (j & 1)] = make_float2(cosf(a2), sinf(a2));
}

__device__ __forceinline__ void d_rmsnorm(int vb, const float* __restrict__ src, const float* __restrict__ gain, bf16_t* __restrict__ xn) {
    int row = (vb * blockDim.x + threadIdx.x) >> 6, lane = threadIdx.x & 63;
    if (row >= NTOK) return;
    const float4* xr = (const float4*)(src + (size_t)row * D);
    float4 v[4]; float ss = 0.f;
#pragma unroll
    for (int j = 0; j < 4; ++j) { v[j] = xr[64 * j + lane]; ss += v[j].x * v[j].x + v[j].y * v[j].y + v[j].z * v[j].z + v[j].w * v[j].w; }
    ss = wave_sum(ss);
    float rstd = rsqrtf(ss * (1.0f / D) + EPS);
#pragma unroll
    for (int j = 0; j < 4; ++j) {
        float4 g = ((const float4*)gain)[64 * j + lane];
        ushort4 o; o.x = f2bf(v[j].x * rstd * g.x); o.y = f2bf(v[j].y * rstd * g.y); o.z = f2bf(v[j].z * rstd * g.z); o.w = f2bf(v[j].w * rstd * g.w);
        ((ushort4*)(xn + (size_t)row * D))[64 * j + lane] = o;
    }
}


namespace pg8 {
#define PG8_LAS __attribute__((address_space(3)))
typedef unsigned short bf16_t;
typedef short bf16x8 __attribute__((ext_vector_type(8)));
typedef float f32x4 __attribute__((ext_vector_type(4)));
typedef unsigned u32x4 __attribute__((ext_vector_type(4)));
constexpr int BM = 256, BK = 64, HALF = 128, HTB = HALF * BK * 2  , STAGE_BYTES = 8 * HTB, NXCD = 8, WGM = 8;

__host__ __device__ __forceinline__ int lds_byte(int r, int c) { const int st = (r >> 4) * 2 + (c >> 5), rr = r & 15, cc = c & 31, ob = rr * 64 + cc * 2; return st * 1024 + (ob ^ (((ob >> 9) & 1) << 5)); }
__host__ __device__ __forceinline__ void stage_rc(int b, int& R, int& C) { const int st = b / 1024, sb = b % 1024, swz = sb ^ (((sb >> 9) & 1) << 5); R = (st >> 1) * 16 + swz / 64; C = (st & 1) * 32 + (swz % 64) / 2; }
__host__ __device__ __forceinline__ int perm32(int rho) { const int n = rho >> 4, i = rho & 15; return 8 * (i >> 2) + 4 * n + (i & 3); }

struct Unit { int pm, pn, half; };
struct Gemm { const bf16_t* A; const bf16_t* Bt; int M, N, K; const int* rowidx = nullptr; };

struct StaticOrder {
    int nM, nN, nwg, G, c;
    __host__ __device__ void init(int M, int N, int G_, int c_) { nM = M / BM; nN = N / BM; nwg = nM * nN; G = G_; c = c_; }
    static constexpr bool HAS_HALF = false;
    __host__ __device__ void unit_of(int L, Unit& u) const {
        int wgid = L; { const int q = nwg / NXCD, r = nwg % NXCD, xcd = wgid % NXCD, off = wgid / NXCD; wgid = (xcd < r ? xcd * (q + 1) : r * (q + 1) + (xcd - r) * q) + off; }
        const int nig = WGM * nN, gid = wgid / nig, fm = gid * WGM, gsz = (nM - fm) < WGM ? (nM - fm) : WGM;
        u.pm = fm + ((wgid % nig) % gsz); u.pn = (wgid % nig) / gsz; u.half = 0;
    }
    __host__ __device__ bool next(int i, Unit& u) const {
        const long L = (long)i * G + c; if (L >= nwg) return false;
        unit_of((int)L, u); return true;
    }
    __device__ __forceinline__ void a_ready(const Unit&) const {}
    __device__ __forceinline__ void done(const Unit&) const {}
    __device__ __forceinline__ size_t boff(const Unit&) const { return 0; }
};


__device__ __forceinline__ unsigned cvt_pk_bf16(float lo, float hi) { unsigned r; asm volatile("v_cvt_pk_bf16_f32 %0, %1, %2" : "=v"(r) : "v"(lo), "v"(hi)); return r; }
__device__ __forceinline__ u32x4 pack8(const f32x4& a, const f32x4& b) { u32x4 w; w.x = cvt_pk_bf16(a[0], a[1]); w.y = cvt_pk_bf16(a[2], a[3]); w.z = cvt_pk_bf16(b[0], b[1]); w.w = cvt_pk_bf16(b[2], b[3]); return w; }
struct MoeOrder : StaticOrder {
    static constexpr bool HAS_HALF = true;
    const int* texp; size_t estride_bytes;
    __device__ __forceinline__ bool next(int i, Unit& u) const {
        const int F = nwg / G, R = nwg - F * G;
        if (i < F) { unit_of(i * G + c, u); return true; }
        if (i > F || R == 0) return false;
        if (2 * R <= G) { if (c >= 2 * R) return false; unit_of(F * G + (c >> 1), u); u.half = 1 + (c & 1); return true; }
        if (c >= R) return false;
        unit_of(F * G + c, u); return true;
    }
    __device__ __forceinline__ size_t boff(const Unit& u) const { return (size_t)texp[u.pm] * estride_bytes; }
};
__device__ __forceinline__ u32x4 lane_tr(PG8_LAS unsigned char* sl, u32x4 v, int fr, int fq, int lane) {
    *(PG8_LAS u32x4*)(sl + fr * 80 + fq * 16) = v;
    __builtin_amdgcn_wave_barrier();
    const u32x4 r = *(const PG8_LAS u32x4*)(sl + (lane >> 2) * 80 + (lane & 3) * 16);
    __builtin_amdgcn_wave_barrier();
    return r;
}
struct EpiInprojF {
    static constexpr bool PERM = true, AFTER_DRAIN = false;
    bf16_t* P; const float2* rot; const float2* ret; const float* rstd; int mode, pad;
    __device__ __forceinline__ void operator()(const f32x4 (&acc)[2][2][4][2], const Unit& u, int wr, int wc, int fr, int fq, PG8_LAS unsigned char* sl, int lane) const {
        { const int ln = my_lane(); fr = ln & 15; fq = ln >> 4; }
        int kind;
        if (mode == 0) kind = u.pn < 4 ? 1 : (u.pn < 6 ? 0 : (u.pn == 6 ? 2 : (u.pn == 7 ? 3 : 0)));
        else kind = u.pn < 8 ? 1 : 0;
        const int row0 = u.pm * BM + wr * 64 + fr, pos0 = row0 & (S - 1), bbu = (u.pm * BM) >> 14;
        PG8_LAS float* rsl = (PG8_LAS float*)sl + 192;
        { const int ln = fq * 16 + fr; const int l0 = ln, l1 = ln + 64;
          const float r0 = rstd[u.pm * BM + wr * 64 + (l0 >> 6) * HALF + (l0 & 63)], r1 = rstd[u.pm * BM + wr * 64 + (l1 >> 6) * HALF + (l1 & 63)];
          rsl[l0] = r0; rsl[l1] = r1; }
        __builtin_amdgcn_wave_barrier();
#define ROT_STEP(T, Dl) { const f32x4 c_ = T; T[0] = c_[0] * Dl[0] - c_[1] * Dl[1]; T[1] = c_[1] * Dl[0] + c_[0] * Dl[1]; T[2] = c_[2] * Dl[2] - c_[3] * Dl[3]; T[3] = c_[3] * Dl[2] + c_[2] * Dl[3]; }
        if (kind == 1) {
            const float qs = (mode == 0 ? u.pn < 2 : u.pn < 4) ? 0.125f * 1.4426950408889634f : 1.0f;
            f32x4 tc[4];
            PG8_LAS const f32x4* dsl = (PG8_LAS const f32x4*)sl + fq * 4;
            { const f32x4* t = (const f32x4*)rot + (size_t)(((pos0 >> 4) * 4 + fq) * 4) * 16 + (pos0 & 15);
#pragma unroll
              for (int q = 0; q < 4; ++q) tc[q] = t[q * 16]; }
#pragma unroll
            for (int ai = 0; ai < 2; ++ai)
#pragma unroll
                for (int m = 0; m < 4; ++m) { const int row = row0 + ai * HALF + m * 16, pos = row & (S - 1);
                    const float qr = qs * rsl[ai * 64 + m * 16 + fr];
                    { f32x4 o[2];
#pragma unroll
                      for (int n = 0; n < 2; ++n) { const f32x4 ta = tc[2 * n], tb = tc[2 * n + 1]; const f32x4 x1 = acc[ai][0][m][n], x2 = acc[ai][1][m][n];
                        o[n][0] = (x1[0] * ta[0] - x2[0] * ta[1]) * qr; o[n][1] = (x1[1] * ta[2] - x2[1] * ta[3]) * qr; o[n][2] = (x1[2] * tb[0] - x2[2] * tb[1]) * qr; o[n][3] = (x1[3] * tb[2] - x2[3] * tb[3]) * qr; }
                      *(u32x4*)(P + pcol_off_u(mode, u.pn * BM + 64 * wc, 8 * fq, bbu, pos)) = pack8(o[0], o[1]); }
                    __builtin_amdgcn_sched_barrier(0);
                    { f32x4 o[2];
#pragma unroll
                      for (int n = 0; n < 2; ++n) { const f32x4 ta = tc[2 * n], tb = tc[2 * n + 1]; const f32x4 x1 = acc[ai][0][m][n], x2 = acc[ai][1][m][n];
                        o[n][0] = (x1[0] * ta[1] + x2[0] * ta[0]) * qr; o[n][1] = (x1[1] * ta[3] + x2[1] * ta[2]) * qr; o[n][2] = (x1[2] * tb[1] + x2[2] * tb[0]) * qr; o[n][3] = (x1[3] * tb[3] + x2[3] * tb[2]) * qr; }
                      *(u32x4*)(P + pcol_off_u(mode, u.pn * BM + 64 * wc + 32, 8 * fq, bbu, pos)) = pack8(o[0], o[1]); }
                    __builtin_amdgcn_sched_barrier(0);
                    if (ai * 4 + m < 7) {
#pragma unroll
                        for (int q = 0; q < 4; ++q) { const f32x4 d_ = dsl[(m == 3 ? 16 : 0) + q]; ROT_STEP(tc[q], d_) __builtin_amdgcn_sched_barrier(0); } }
                }
        } else if (kind >= 2) {
            const float sc = kind == 3 ? 0.125f : 1.0f;
            f32x4 tc[2];
            PG8_LAS const f32x4* dsl = (PG8_LAS const f32x4*)sl + 32 + fq * 2;
            { const f32x4* t = (const f32x4*)ret + (size_t)((((pos0 >> 4) * 2 + (wc & 1)) * 4 + fq) * 2) * 16 + (pos0 & 15); tc[0] = t[0]; tc[1] = t[16]; }
#pragma unroll
            for (int ai = 0; ai < 2; ++ai)
#pragma unroll
                for (int m = 0; m < 4; ++m) { const int row = row0 + ai * HALF + m * 16, pos = row & (S - 1); const f32x4 ta = tc[0], tb = tc[1]; const float sr = sc * rsl[ai * 64 + m * 16 + fr];
#pragma unroll
                    for (int bj = 0; bj < 2; ++bj) { const f32x4 x0 = acc[ai][bj][m][0], x1 = acc[ai][bj][m][1]; f32x4 o0, o1;
                        o0[0] = (x0[0] * ta[0] - x0[1] * ta[1]) * sr; o0[1] = (x0[0] * ta[1] + x0[1] * ta[0]) * sr;
                        o0[2] = (x0[2] * ta[2] - x0[3] * ta[3]) * sr; o0[3] = (x0[2] * ta[3] + x0[3] * ta[2]) * sr;
                        o1[0] = (x1[0] * tb[0] - x1[1] * tb[1]) * sr; o1[1] = (x1[0] * tb[1] + x1[1] * tb[0]) * sr;
                        o1[2] = (x1[2] * tb[2] - x1[3] * tb[3]) * sr; o1[3] = (x1[2] * tb[3] + x1[3] * tb[2]) * sr;
                        *(u32x4*)(P + pcol_off_u(mode, u.pn * BM + bj * HALF + 32 * wc, 8 * fq, bbu, pos)) = pack8(o0, o1); }
                    if (ai * 4 + m < 7) { const f32x4 d0_ = dsl[(m == 3 ? 8 : 0)], d1_ = dsl[(m == 3 ? 8 : 0) + 1]; ROT_STEP(tc[0], d0_) ROT_STEP(tc[1], d1_) }
                }
        } else {
#pragma unroll
            for (int ai = 0; ai < 2; ++ai)
#pragma unroll
                for (int m = 0; m < 4; ++m) { const int row = row0 + ai * HALF + m * 16, pos = row & (S - 1);
                    const float rs = rsl[ai * 64 + m * 16 + fr];
#pragma unroll
                    for (int bj = 0; bj < 2; ++bj) *(u32x4*)(P + pcol_off_u(mode, u.pn * BM + bj * HALF + 32 * wc, 8 * fq, bbu, pos)) = pack8(acc[ai][bj][m][0] * rs, acc[ai][bj][m][1] * rs); }
        }
#undef ROT_STEP
    }
};
template <bool RES16>
struct EpiOutprojF {
    static constexpr bool PERM = true, AFTER_DRAIN = false;
    const void* res; bf16_t* hx;
    __device__ __forceinline__ void operator()(const f32x4 (&acc)[2][2][4][2], const Unit& u, int wr, int wc, int fr, int fq, PG8_LAS unsigned char* sl, int lane) const {
        const int row0 = u.pm * BM + wr * 64 + fr, col0 = u.pn * BM + wc * 32 + 8 * fq;
#pragma unroll
        for (int ai = 0; ai < 2; ++ai) {
            if constexpr (RES16) {
                u32x4 rv[4][2];
#pragma unroll
                for (int m = 0; m < 4; ++m)
#pragma unroll
                    for (int bj = 0; bj < 2; ++bj) rv[m][bj] = *(const u32x4*)((const bf16_t*)res + (size_t)(row0 + ai * HALF + m * 16) * D + col0 + bj * HALF);
#pragma unroll
                for (int m = 0; m < 4; ++m)
#pragma unroll
                    for (int bj = 0; bj < 2; ++bj) { const u32x4 r = rv[m][bj]; f32x4 a = acc[ai][bj][m][0], b = acc[ai][bj][m][1];
                        a[0] += __uint_as_float(r.x << 16); a[1] += __uint_as_float(r.x & 0xffff0000u); a[2] += __uint_as_float(r.y << 16); a[3] += __uint_as_float(r.y & 0xffff0000u);
                        b[0] += __uint_as_float(r.z << 16); b[1] += __uint_as_float(r.z & 0xffff0000u); b[2] += __uint_as_float(r.w << 16); b[3] += __uint_as_float(r.w & 0xffff0000u);
                        *(u32x4*)(hx + (size_t)(row0 + ai * HALF + m * 16) * D + col0 + bj * HALF) = pack8(a, b); }
            } else {
                f32x4 rv[4][2][2];
#pragma unroll
                for (int m = 0; m < 4; ++m)
#pragma unroll
                    for (int bj = 0; bj < 2; ++bj) { const float* rp = (const float*)res + (size_t)(row0 + ai * HALF + m * 16) * D + col0 + bj * HALF; rv[m][bj][0] = *(const f32x4*)rp; rv[m][bj][1] = *(const f32x4*)(rp + 4); }
#pragma unroll
                for (int m = 0; m < 4; ++m)
#pragma unroll
                    for (int bj = 0; bj < 2; ++bj) *(u32x4*)(hx + (size_t)(row0 + ai * HALF + m * 16) * D + col0 + bj * HALF) = pack8(rv[m][bj][0] + acc[ai][bj][m][0], rv[m][bj][1] + acc[ai][bj][m][1]);
            }
        }
    }
};
struct EpiMoe1F {
    static constexpr bool PERM = true, AFTER_DRAIN = false;
    bf16_t* Hs; const float* rowscale;
    __device__ __forceinline__ void operator()(const f32x4 (&acc)[2][2][4][2], const Unit& u, int wr, int wc, int fr, int fq, PG8_LAS unsigned char* sl, int lane) const {
        const int row0 = u.pm * BM + (u.half == 2 ? HALF : 0) + wr * 64 + fr;
#pragma unroll
        for (int ai = 0; ai < 2; ++ai) {
            if (ai == 1 && u.half != 0) break;
            float rsv[4];
#pragma unroll
            for (int q = 0; q < 4; ++q) rsv[q] = rowscale[row0 + ai * HALF + q * 16];
#pragma unroll
            for (int m = 0; m < 4; ++m) { f32x4 o[2]; const float rs = rsv[m];
#pragma unroll
                for (int n = 0; n < 2; ++n)
#pragma unroll
                    for (int j = 0; j < 4; ++j) o[n][j] = silu(acc[ai][0][m][n][j] * rs) * (acc[ai][1][m][n][j] * rs);
                *(u32x4*)(Hs + (size_t)(row0 + ai * HALF + m * 16) * HID + u.pn * HALF + 32 * wc + 8 * fq) = pack8(o[0], o[1]); }
        }
    }
};
struct EpiMoe2F {
    static constexpr bool PERM = true, AFTER_DRAIN = false;
    bf16_t* ys; const float* rowgate;
    __device__ __forceinline__ void operator()(const f32x4 (&acc)[2][2][4][2], const Unit& u, int wr, int wc, int fr, int fq, PG8_LAS unsigned char* sl, int lane) const {
        const int row0 = u.pm * BM + (u.half == 2 ? HALF : 0) + wr * 64 + fr;
#pragma unroll
        for (int ai = 0; ai < 2; ++ai) {
            if (ai == 1 && u.half != 0) break;
            float gtv[4];
#pragma unroll
            for (int q = 0; q < 4; ++q) gtv[q] = rowgate[row0 + ai * HALF + q * 16];
#pragma unroll
            for (int m = 0; m < 4; ++m) { const int row = row0 + ai * HALF + m * 16; const float gt = gtv[m];
                const int row2 = row - fr + (lane >> 2);
#pragma unroll
                for (int bj = 0; bj < 2; ++bj) *(u32x4*)(ys + (size_t)row2 * D + u.pn * BM + bj * HALF + 32 * wc + 8 * (lane & 3)) = lane_tr(sl, pack8(acc[ai][bj][m][0] * gt, acc[ai][bj][m][1] * gt), fr, fq, lane); }
        }
    }
};

template <class Epi, class Sched, bool ALIGN_EPI = false, bool SP2 = false, bool GATHER = false>
__device__ __forceinline__ void gemm_phase(PG8_LAS unsigned char* lds, const Gemm g, const Sched& S, const Epi& E) {
    const int wid = __builtin_amdgcn_readfirstlane(threadIdx.x >> 6), lane = my_lane(), tid = wid * 64 + lane, wr = wid >> 2, wc = wid & 3, fr = lane & 15, fq = lane >> 4;
    const int K = g.K, nt = K / BK;
    unsigned voffA[2], voffB[2];
    static_assert(!GATHER || SP2, "the gathered A operand is wired into the SP2 loop only");
#pragma unroll
    for (int i = 0; i < 2; ++i) { int R, C; stage_rc(tid * 16 + i * 8192, R, C); const int Rb = Epi::PERM ? ((R & ~31) + perm32(R & 31)) : R;
        voffA[i] = (unsigned)(R * K + C) * 2u; voffB[i] = (unsigned)(Rb * K + C) * 2u; }
    const size_t kstep = (size_t)(BK * 2);
    const size_t hstep = (size_t)HALF * K * 2;
    const size_t tstep = 2 * hstep;
    const unsigned ldsw = (unsigned)wid * 1024u;
    const int aoff = lds_byte(wr * 64 + fr, fq * 8), boff = lds_byte(wc * 32 + fr, fq * 8);
#define PG8_SA(b, h) (((b) * 2 + (h)) * HTB)
#define PG8_SB(b, h) ((4 + (b) * 2 + (h)) * HTB)
#define PG8_STAGE(bufoff, gbase, voff) do { _Pragma("unroll") for (int _i = 0; _i < 2; ++_i) \
        __builtin_amdgcn_global_load_lds((const unsigned*)((const char*)(gbase) + (voff)[_i]), (PG8_LAS unsigned*)(lds + (bufoff) + ldsw + _i * 8192), 16, 0, 0); } while (0)
#define PG8_STAGE_G(bufoff, kbytes, vo) do { _Pragma("unroll") for (int _i = 0; _i < 2; ++_i) \
        __builtin_amdgcn_global_load_lds((const unsigned*)((const char*)g.A + (kbytes) + (vo)[_i]), (PG8_LAS unsigned*)(lds + (bufoff) + ldsw + _i * 8192), 16, 0, 0); } while (0)
#define PG8_LDA(dst, b, h) do { _Pragma("unroll") for (int m = 0; m < 4; ++m) _Pragma("unroll") for (int k = 0; k < 2; ++k) dst[m][k] = *(const PG8_LAS bf16x8*)(lds + PG8_SA(b, h) + aoff + m * 2048 + k * 1024); } while (0)
#define PG8_LDB(dst, b, h) do { _Pragma("unroll") for (int n = 0; n < 2; ++n) _Pragma("unroll") for (int k = 0; k < 2; ++k) dst[n][k] = *(const PG8_LAS bf16x8*)(lds + PG8_SB(b, h) + boff + n * 2048 + k * 1024); } while (0)
#define PG8_MMA(ai, bj, At, Bt) do { __builtin_amdgcn_s_setprio(1); _Pragma("unroll") for (int m = 0; m < 4; ++m) _Pragma("unroll") for (int n = 0; n < 2; ++n) _Pragma("unroll") for (int k = 0; k < 2; ++k) \
        acc[ai][bj][m][n] = __builtin_amdgcn_mfma_f32_16x16x32_bf16(Bt[n][k], At[m][k], acc[ai][bj][m][n], 0, 0, 0); __builtin_amdgcn_s_setprio(0); } while (0)
#define PG8_WAIT_V(n) asm volatile("s_waitcnt vmcnt(" #n ")" ::: "memory")
#define PG8_WAIT_L(n) asm volatile("s_waitcnt lgkmcnt(" #n ")" ::: "memory")
#define PG8_BAR __builtin_amdgcn_s_barrier()
#define PG8_SCHED __builtin_amdgcn_sched_barrier(0)
    Unit cur, nxt; int ui = 0;
    if (!S.next(0, cur)) return;
    unsigned voC0[2], voC1[2];
#define PG8_GOFF(dst0, dst1, u_) do { const int o0_ = (u_).half == 2 ? HALF : 0, o1_ = (u_).half == 0 ? HALF : o0_;     \
        _Pragma("unroll") for (int _i = 0; _i < 2; ++_i) { int R_, C_; stage_rc((wid * 64 + my_lane()) * 16 + _i * 8192, R_, C_);   \
        dst0[_i] = (unsigned)g.rowidx[(u_).pm * BM + o0_ + R_] * (unsigned)(K * 2) + (unsigned)C_ * 2u; dst1[_i] = (unsigned)g.rowidx[(u_).pm * BM + o1_ + R_] * (unsigned)(K * 2) + (unsigned)C_ * 2u; } } while (0)
    if constexpr (GATHER) { PG8_GOFF(voC0, voC1, cur); }
    f32x4 acc[2][2][4][2];
#pragma unroll
    for (int a = 0; a < 2; ++a)
#pragma unroll
        for (int b = 0; b < 2; ++b)
#pragma unroll
            for (int m = 0; m < 4; ++m)
#pragma unroll
                for (int n = 0; n < 2; ++n) acc[a][b][m][n] = (f32x4){0.f, 0.f, 0.f, 0.f};
    bf16x8 At[4][2], B0[2][2], B1[2][2];
    const char* cA = (const char*)g.A + (size_t)cur.pm * tstep + (cur.half == 2 ? hstep : (size_t)0); const char* cB = (const char*)g.Bt + (size_t)cur.pn * tstep + S.boff(cur);
    S.a_ready(cur);
    if constexpr (SP2) {
        PG8_STAGE(PG8_SB(0, 0), cB, voffB); PG8_STAGE(PG8_SB(0, 1), cB + hstep, voffB);
        if constexpr (GATHER) { PG8_STAGE_G(PG8_SA(0, 0), 0, voC0); PG8_STAGE_G(PG8_SA(0, 1), 0, voC1); } else { PG8_STAGE(PG8_SA(0, 0), cA, voffA); PG8_STAGE(PG8_SA(0, 1), cA + hstep, voffA); }
        if (wr == 1) PG8_BAR;
        PG8_WAIT_V(2); PG8_BAR;
        PG8_STAGE(PG8_SB(1, 0), cB + kstep, voffB); if constexpr (GATHER) { PG8_STAGE_G(PG8_SA(1, 0), kstep, voC0); } else { PG8_STAGE(PG8_SA(1, 0), cA + kstep, voffA); } PG8_STAGE(PG8_SB(1, 1), cB + hstep + kstep, voffB);
        PG8_WAIT_V(6); PG8_BAR;
    } else {
        PG8_STAGE(PG8_SB(0, 0), cB, voffB); PG8_STAGE(PG8_SA(0, 0), cA, voffA); PG8_STAGE(PG8_SB(0, 1), cB + hstep, voffB); PG8_STAGE(PG8_SA(0, 1), cA + hstep, voffA);
        if (wr == 1) PG8_BAR;
        PG8_WAIT_V(4); PG8_BAR;
        PG8_STAGE(PG8_SB(1, 0), cB + kstep, voffB); PG8_STAGE(PG8_SA(1, 0), cA + kstep, voffA); PG8_STAGE(PG8_SB(1, 1), cB + hstep + kstep, voffB);
        PG8_WAIT_V(6); PG8_BAR;
    }
    for (;;) {
        const bool has_next = S.next(ui + 1, nxt);
        const char* nA = has_next ? (const char*)g.A + (size_t)nxt.pm * tstep + (nxt.half == 2 ? hstep : (size_t)0) : cA; const char* nB = has_next ? (const char*)g.Bt + (size_t)nxt.pn * tstep + S.boff(nxt) : cB;
        for (int t = 0; t < nt; t += 2) {
            const bool last = (t == nt - 2);
            const char* a1 = cA + (size_t)(t + 1) * kstep;
            const char* a2 = last ? nA : cA + (size_t)(t + 2) * kstep; const char* b2 = last ? nB : cB + (size_t)(t + 2) * kstep;
            const char* a3 = a2 + kstep; const char* b3 = b2 + kstep;
            if (last && has_next) S.a_ready(nxt);
            if constexpr (SP2) {
            const size_t k2b = last ? (size_t)0 : (size_t)(t + 2) * kstep;
            PG8_LDB(B0, 0, 0); PG8_LDB(B1, 0, 1); PG8_SCHED; PG8_LDA(At, 0, 0); if constexpr (GATHER) { PG8_STAGE_G(PG8_SA(1, 1), (size_t)(t + 1) * kstep, voC1); if (last && has_next) { PG8_GOFF(voC0, voC1, nxt); }   } else { PG8_STAGE(PG8_SA(1, 1), a1 + hstep, voffA); }
            PG8_WAIT_V(8); PG8_WAIT_L(0); PG8_BAR; PG8_MMA(0, 0, At, B0); PG8_MMA(0, 1, At, B1); PG8_BAR; PG8_SCHED;
            PG8_LDA(At, 0, 1); PG8_STAGE(PG8_SB(0, 0), b2, voffB); PG8_STAGE(PG8_SB(0, 1), b2 + hstep, voffB); if constexpr (GATHER) { PG8_STAGE_G(PG8_SA(0, 0), k2b, voC0); } else { PG8_STAGE(PG8_SA(0, 0), a2, voffA); }
            PG8_WAIT_V(8); PG8_WAIT_L(0); PG8_BAR; if (!Sched::HAS_HALF || cur.half == 0) { PG8_MMA(1, 0, At, B0); PG8_MMA(1, 1, At, B1); } PG8_BAR; PG8_SCHED;
            PG8_LDB(B0, 1, 0); PG8_LDB(B1, 1, 1); PG8_SCHED; PG8_LDA(At, 1, 0); if constexpr (GATHER) { PG8_STAGE_G(PG8_SA(0, 1), k2b, voC1); } else { PG8_STAGE(PG8_SA(0, 1), a2 + hstep, voffA); }
            PG8_WAIT_V(8); PG8_WAIT_L(0); PG8_BAR; PG8_MMA(0, 0, At, B0); PG8_MMA(0, 1, At, B1); PG8_BAR; PG8_SCHED;
            PG8_LDA(At, 1, 1); PG8_STAGE(PG8_SB(1, 0), b3, voffB); PG8_STAGE(PG8_SB(1, 1), b3 + hstep, voffB); if constexpr (GATHER) { PG8_STAGE_G(PG8_SA(1, 0), k2b + kstep, voC0); } else { PG8_STAGE(PG8_SA(1, 0), a3, voffA); }
            PG8_WAIT_V(8); PG8_WAIT_L(0); PG8_BAR; if (!Sched::HAS_HALF || cur.half == 0) { PG8_MMA(1, 0, At, B0); PG8_MMA(1, 1, At, B1); } PG8_BAR; PG8_SCHED;
            } else {
            PG8_LDB(B0, 0, 0); PG8_SCHED; PG8_LDA(At, 0, 0); PG8_STAGE(PG8_SA(1, 1), a1 + hstep, voffA);
            PG8_WAIT_L(8); PG8_BAR; PG8_WAIT_L(0); PG8_MMA(0, 0, At, B0); PG8_BAR; PG8_SCHED;
            PG8_LDB(B1, 0, 1); PG8_STAGE(PG8_SB(0, 0), b2, voffB);
            PG8_BAR; PG8_WAIT_L(0); PG8_MMA(0, 1, At, B1); PG8_BAR;
            PG8_LDA(At, 0, 1); PG8_STAGE(PG8_SA(0, 0), a2, voffA);
            PG8_BAR; PG8_WAIT_L(0); PG8_MMA(1, 0, At, B0); PG8_BAR; PG8_SCHED;
            PG8_STAGE(PG8_SB(0, 1), b2 + hstep, voffB);
            PG8_WAIT_V(6); PG8_BAR; PG8_MMA(1, 1, At, B1); PG8_BAR;
            PG8_LDB(B0, 1, 0); PG8_SCHED; PG8_LDA(At, 1, 0); PG8_STAGE(PG8_SA(0, 1), a2 + hstep, voffA);
            PG8_WAIT_L(8); PG8_BAR; PG8_WAIT_L(0); PG8_MMA(0, 0, At, B0); PG8_BAR; PG8_SCHED;
            PG8_LDB(B1, 1, 1); PG8_STAGE(PG8_SB(1, 0), b3, voffB);
            PG8_BAR; PG8_WAIT_L(0); PG8_MMA(0, 1, At, B1); PG8_BAR;
            PG8_LDA(At, 1, 1); PG8_STAGE(PG8_SA(1, 0), a3, voffA);
            PG8_BAR; PG8_WAIT_L(0); PG8_MMA(1, 0, At, B0); PG8_BAR; PG8_SCHED;
            PG8_STAGE(PG8_SB(1, 1), b3 + hstep, voffB);
            PG8_WAIT_V(6); PG8_BAR; PG8_MMA(1, 1, At, B1); PG8_BAR;
            }
        }
        if constexpr (ALIGN_EPI) { if (wr == 0) PG8_BAR; }
        if constexpr (!Epi::AFTER_DRAIN) { E(acc, cur, wr, wc, fr, fq, lds + STAGE_BYTES + wid * 2016, lane); S.done(cur); }
        if (!has_next) break;
#pragma unroll
        for (int a = 0; a < 2; ++a)
#pragma unroll
            for (int b = 0; b < 2; ++b)
#pragma unroll
                for (int m = 0; m < 4; ++m)
#pragma unroll
                    for (int n = 0; n < 2; ++n) acc[a][b][m][n] = (f32x4){0.f, 0.f, 0.f, 0.f};
        cur = nxt; cA = nA; cB = nB; ++ui;
        if constexpr (ALIGN_EPI) { if (wr == 1) PG8_BAR; }
    }
    PG8_WAIT_V(0);
    if constexpr (!ALIGN_EPI) { if (wr == 0) PG8_BAR; }
    PG8_BAR;
    if constexpr (Epi::AFTER_DRAIN) { E.fused(acc, cur, wr, wc, fr, fq, lds, wid, lane); S.done(cur); }
#undef PG8_SA
#undef PG8_SB
#undef PG8_STAGE
#undef PG8_STAGE_G
#undef PG8_GOFF
#undef PG8_LDA
#undef PG8_LDB
#undef PG8_MMA
#undef PG8_WAIT_V
#undef PG8_WAIT_L
#undef PG8_BAR
#undef PG8_SCHED
}
}

__device__ __forceinline__ void d_kmean(int vb, const bf16_t* __restrict__ P, float* __restrict__ kmean) {
    int i = vb * blockDim.x + threadIdx.x;
    if (i >= NB * 8 * 64 * 64) return;
    int d = i & 63, n = (i >> 6) & 63, h = (i >> 12) & 7, b = i >> 15;
    float s = 0.f;
    const bf16_t* p = P + L0_AK + hm(b, 8, h, 0, 64) + akf_off(n * 256, d);
    for (int j = 0; j < 256; ++j) s += bf2f(p[(size_t)(j >> 5) * 2048 + (j & 31) * 8]);
    kmean[i] = s * (1.0f / 256.0f);
}
__device__ __forceinline__ void kmean_item(int item, const bf16_t* __restrict__ P, float* __restrict__ kmean, LAS float* red  , int lane) {
    const int n = item & 63, h = (item >> 6) & 7, b = item >> 9;
    const u32x4_t* src = (const u32x4_t*)(P + L0_AK + hm(b, 8, h, n * 256, 64)) + lane;
    float acc[4][8];
#pragma unroll
    for (int q = 0; q < 4; ++q)
#pragma unroll
        for (int e = 0; e < 8; ++e) acc[q][e] = 0.f;
#pragma unroll
    for (int hf = 0; hf < 2; ++hf) { u32x4_t v[16];
#pragma unroll
        for (int i = 0; i < 16; ++i) v[i] = src[(hf * 16 + i) * 64];
#pragma unroll
        for (int i = 0; i < 16; ++i)
#pragma unroll
            for (int w = 0; w < 4; ++w) { acc[i & 3][2 * w] += __uint_as_float(v[i][w] << 16); acc[i & 3][2 * w + 1] += __uint_as_float(v[i][w] & 0xffff0000u); } }
#pragma unroll
    for (int a = 0; a < 32; ++a) red[a * 64 + lane] = acc[a >> 3][a & 7];
    __builtin_amdgcn_wave_barrier();
    const int dg = lane >> 3, e = lane & 7, q = dg >> 1, hh = dg & 1;
    const LAS f32x4_t* rp = (const LAS f32x4_t*)(red + (q * 8 + e) * 64 + hh * 32);
    float sm = 0.f;
#pragma unroll
    for (int k = 0; k < 8; ++k) { const f32x4_t t = rp[k]; sm += (t[0] + t[1]) + (t[2] + t[3]); }
    kmean[item * 64 + lane] = sm * (1.0f / 256.0f);
    __builtin_amdgcn_wave_barrier();
}
__device__ __forceinline__ void d_combine(int vb, float* __restrict__ h, const bf16_t* __restrict__ ys, const int2* __restrict__ pos, const float* __restrict__ gain, bf16_t* __restrict__ xn, int final) {
    int row = (vb * blockDim.x + threadIdx.x) >> 6, lane = threadIdx.x & 63;
    if (row >= NTOK) return;
    int2 p = pos[row];
    float4* xr = (float4*)(h + (size_t)row * D);
    const ushort4* y0 = (const ushort4*)(ys + (size_t)p.x * D); const ushort4* y1 = (const ushort4*)(ys + (size_t)p.y * D);
    float4 v[4]; float ss = 0.f;
#pragma unroll
    for (int j = 0; j < 4; ++j) { v[j] = xr[64 * j + lane]; ushort4 a = y0[64 * j + lane], c = y1[64 * j + lane];
        v[j].x += bf2f(a.x) + bf2f(c.x); v[j].y += bf2f(a.y) + bf2f(c.y); v[j].z += bf2f(a.z) + bf2f(c.z); v[j].w += bf2f(a.w) + bf2f(c.w);
        ss += v[j].x * v[j].x + v[j].y * v[j].y + v[j].z * v[j].z + v[j].w * v[j].w; }
    ss = wave_sum(ss);
    float rstd = rsqrtf(ss * (1.0f / D) + EPS);
#pragma unroll
    for (int j = 0; j < 4; ++j) {
        float4 g = ((const float4*)gain)[64 * j + lane];
        float4 o = make_float4(v[j].x * rstd * g.x, v[j].y * rstd * g.y, v[j].z * rstd * g.z, v[j].w * rstd * g.w);
        if (final) xr[64 * j + lane] = o;
        else { xr[64 * j + lane] = v[j]; ushort4 ob; ob.x = f2bf(o.x); ob.y = f2bf(o.y); ob.z = f2bf(o.z); ob.w = f2bf(o.w); ((ushort4*)(xn + (size_t)row * D))[64 * j + lane] = ob; }
    }
}


template <int MODE>
__device__ __forceinline__ void rows_pipeline(const float* src, float* h, const bf16_t* ys, const int2* pos, const float* gain, bf16_t* xn, int wave, int lane, float* rso = nullptr  ) {
    const int first = blockIdx.x * NWAVES + wave, step = gridDim.x * NWAVES;
    if (first >= NTOK) return;
    const int n = (NTOK - first + step - 1) / step;
    float4 g[4];
#pragma unroll
    for (int j = 0; j < 4; ++j) g[j] = ((const float4*)gain)[64 * j + lane];
#define RP_ROW(k) (first + ((k) < n ? (k) : n - 1) * step)
#define RP_ISSUE(V, A, C, r, p) { const float4* xr_ = (const float4*)((MODE == 0 ? src : (const float*)h) + (size_t)(r) * D); \
        _Pragma("unroll") for (int j = 0; j < 4; ++j) V[j] = xr_[64 * j + lane]; \
        if (MODE != 0) { const uint2* y0_ = (const uint2*)(ys + (size_t)(p).x * D); const uint2* y1_ = (const uint2*)(ys + (size_t)(p).y * D); \
            _Pragma("unroll") for (int j = 0; j < 4; ++j) { A[j] = y0_[64 * j + lane]; C[j] = y1_[64 * j + lane]; } } }
#define RP_FINISH(V, A, C, r) { float ss_ = 0.f; \
        _Pragma("unroll") for (int j = 0; j < 4; ++j) { \
            if (MODE != 0) { V[j].x += __uint_as_float(A[j].x << 16) + __uint_as_float(C[j].x << 16); V[j].y += __uint_as_float(A[j].x & 0xffff0000u) + __uint_as_float(C[j].x & 0xffff0000u); \
                             V[j].z += __uint_as_float(A[j].y << 16) + __uint_as_float(C[j].y << 16); V[j].w += __uint_as_float(A[j].y & 0xffff0000u) + __uint_as_float(C[j].y & 0xffff0000u); } \
            ss_ += V[j].x * V[j].x + V[j].y * V[j].y + V[j].z * V[j].z + V[j].w * V[j].w; } \
        ss_ = wave_sum(ss_); const float rstd_ = rsqrtf(ss_ * (1.0f / D) + EPS); \
        if (MODE == 0 && lane == 0) rso[(r)] = rstd_; \
        _Pragma("unroll") for (int j = 0; j < 4; ++j) { const float4 o_ = MODE == 0 ? V[j] : make_float4(V[j].x * rstd_ * g[j].x, V[j].y * rstd_ * g[j].y, V[j].z * rstd_ * g[j].z, V[j].w * rstd_ * g[j].w); \
            if (MODE == 2) ((float4*)(h + (size_t)(r) * D))[64 * j + lane] = o_; \
            else { if (MODE == 1) ((float4*)(h + (size_t)(r) * D))[64 * j + lane] = V[j]; \
                   ushort4 ob_; ob_.x = f2bf(o_.x); ob_.y = f2bf(o_.y); ob_.z = f2bf(o_.z); ob_.w = f2bf(o_.w); ((ushort4*)(xn + (size_t)(r) * D))[64 * j + lane] = ob_; } } }
    float4 va[4], vb[4]; uint2 aa[4], ca[4], ab[4], cb[4];
    int2 pA = make_int2(0, 0), pB = make_int2(0, 0);
    if (MODE != 0) { pA = pos[RP_ROW(0)]; pB = pos[RP_ROW(1)]; }
    RP_ISSUE(va, aa, ca, RP_ROW(0), pA)
    for (int k = 0; k < n; k += 2) {
        RP_ISSUE(vb, ab, cb, RP_ROW(k + 1), pB)
        if (MODE != 0) pA = pos[RP_ROW(k + 2)];
        RP_FINISH(va, aa, ca, RP_ROW(k))
        if (k + 1 >= n) break;
        RP_ISSUE(va, aa, ca, RP_ROW(k + 2), pA)
        if (MODE != 0) pB = pos[RP_ROW(k + 3)];
        RP_FINISH(vb, ab, cb, RP_ROW(k + 1))
    }
#undef RP_ROW
#undef RP_ISSUE
#undef RP_FINISH
}

typedef float f32x16 __attribute__((ext_vector_type(16)));
typedef short bf16x8 __attribute__((ext_vector_type(8)));
typedef short s16x4 __attribute__((ext_vector_type(4)));
typedef float f32x2_t __attribute__((ext_vector_type(2)));
typedef __bf16 bf16x2_t __attribute__((ext_vector_type(2)));
__device__ __forceinline__ unsigned cvtpk(float lo, float hi) { f32x2_t v = {lo, hi}; bf16x2_t b = __builtin_convertvector(v, bf16x2_t); return __builtin_bit_cast(unsigned, b); }
template <int MODE>
__device__ __forceinline__ void rows_pipeline16(const bf16_t* hin, const bf16_t* ys, const int2* pos, const float* gain, bf16_t* hout, float* rso, float* out, int wave, int lane) {
    const int first = blockIdx.x * NWAVES + wave, step = gridDim.x * NWAVES;
    if (first >= NTOK) return;
    const int n = (NTOK - first + step - 1) / step;
    float4 g[4];
#pragma unroll
    for (int j = 0; j < 4; ++j) g[j] = ((const float4*)gain)[(64 * (j >> 1) + lane) * 2 + (j & 1)];
#define RP_ROW(k) (first + ((k) < n ? (k) : n - 1) * step)
#define RP_ISSUE(H, A, C, r, p) { const u32x4_t* h_ = (const u32x4_t*)(hin + (size_t)(r) * D); const u32x4_t* y0_ = (const u32x4_t*)(ys + (size_t)(p).x * D); const u32x4_t* y1_ = (const u32x4_t*)(ys + (size_t)(p).y * D); \
        _Pragma("unroll") for (int j = 0; j < 2; ++j) { H[j] = h_[64 * j + lane]; A[j] = y0_[64 * j + lane]; C[j] = y1_[64 * j + lane]; } }
#define RP_LO(u) __uint_as_float((u) << 16)
#define RP_HI(u) __uint_as_float((u) & 0xffff0000u)
#define RP_FINISH(H, A, C, r) { float v_[2][8]; float ss_ = 0.f; \
        _Pragma("unroll") for (int j = 0; j < 2; ++j) { _Pragma("unroll") for (int q = 0; q < 4; ++q) { \
            v_[j][2 * q] = RP_LO(H[j][q]) + RP_LO(A[j][q]) + RP_LO(C[j][q]); v_[j][2 * q + 1] = RP_HI(H[j][q]) + RP_HI(A[j][q]) + RP_HI(C[j][q]); \
            ss_ += v_[j][2 * q] * v_[j][2 * q] + v_[j][2 * q + 1] * v_[j][2 * q + 1]; } } \
        ss_ = wave_sum(ss_); const float rstd_ = rsqrtf(ss_ * (1.0f / D) + EPS); \
        _Pragma("unroll") for (int j = 0; j < 2; ++j) { const float4 ga_ = g[2 * j], gb_ = g[2 * j + 1]; \
            const float4 oa_ = make_float4(v_[j][0] * rstd_ * ga_.x, v_[j][1] * rstd_ * ga_.y, v_[j][2] * rstd_ * ga_.z, v_[j][3] * rstd_ * ga_.w); \
            const float4 ob_ = make_float4(v_[j][4] * rstd_ * gb_.x, v_[j][5] * rstd_ * gb_.y, v_[j][6] * rstd_ * gb_.z, v_[j][7] * rstd_ * gb_.w); \
            if (MODE == 2) { float4* o_ = (float4*)(out + (size_t)(r) * D) + (64 * j + lane) * 2; o_[0] = oa_; o_[1] = ob_; } \
            else { u32x4_t hv_; hv_.x = cvtpk(v_[j][0], v_[j][1]); hv_.y = cvtpk(v_[j][2], v_[j][3]); hv_.z = cvtpk(v_[j][4], v_[j][5]); hv_.w = cvtpk(v_[j][6], v_[j][7]); \
                   ((u32x4_t*)(hout + (size_t)(r) * D))[64 * j + lane] = hv_; } } \
        if (MODE == 1 && lane == 0) rso[(r)] = rstd_; }
    u32x4_t ha[2], aa[2], ca[2], hb[2], ab[2], cb[2];
    int2 pA = pos[RP_ROW(0)], pB = pos[RP_ROW(1)];
    RP_ISSUE(ha, aa, ca, RP_ROW(0), pA)
    for (int k = 0; k < n; k += 2) {
        RP_ISSUE(hb, ab, cb, RP_ROW(k + 1), pB)
        pA = pos[RP_ROW(k + 2)];
        RP_FINISH(ha, aa, ca, RP_ROW(k))
        if (k + 1 >= n) break;
        RP_ISSUE(ha, aa, ca, RP_ROW(k + 2), pA)
        pB = pos[RP_ROW(k + 3)];
        RP_FINISH(hb, ab, cb, RP_ROW(k + 1))
    }
#undef RP_ROW
#undef RP_ISSUE
#undef RP_FINISH
#undef RP_LO
#undef RP_HI
}

__device__ __forceinline__ s16x4 lds_tr16(LAS const char* p) { return __builtin_bit_cast(s16x4, __builtin_amdgcn_ds_read_tr16_b64_v4i16((LAS s16x4*)p)); }
constexpr int VPITCH = 144;
constexpr int ENG_LDS_PER_WAVE = 64 * VPITCH;
constexpr float SM_SCALE = 0.125f * 1.4426950408889634f;
constexpr float NEG_BIG = -1e30f;
struct AttnAcc { f32x16 o0, o1; float m, l; };
__device__ __forceinline__ void acc_init(AttnAcc& a) {
#pragma unroll
    for (int r = 0; r < 16; ++r) { a.o0[r] = 0.f; a.o1[r] = 0.f; }
    a.m = NEG_BIG; a.l = 0.f;
}
__device__ __forceinline__ void attn_tile(AttnAcc& a, const bf16x8 (&qf)[4], const bf16x8 (&kf)[4], LAS const char* vl, int lane, int lo, int hi) {
    const int hh = lane >> 5;
    f32x16 s;
#pragma unroll
    for (int r = 0; r < 16; ++r) s[r] = 0.f;
#pragma unroll
    for (int d0 = 0; d0 < 4; ++d0) s = __builtin_amdgcn_mfma_f32_32x32x16_bf16(kf[d0], qf[d0], s, 0, 0, 0);
    float mx = NEG_BIG;
#pragma unroll
    for (int r = 0; r < 16; ++r) { const int kr = (r & 3) + 8 * (r >> 2) + 4 * hh; s[r] = (kr >= lo && kr <= hi) ? s[r] * SM_SCALE : NEG_BIG; mx = fmaxf(mx, s[r]); }
    mx = fmaxf(mx, __shfl_xor(mx, 32));
    const float mn = fmaxf(a.m, mx), al = __builtin_amdgcn_exp2f(a.m - mn);
    a.m = mn;
    float ps = 0.f;
#pragma unroll
    for (int r = 0; r < 16; ++r) { s[r] = __builtin_amdgcn_exp2f(s[r] - mn); ps += s[r]; }
    a.l = a.l * al + ps;
#pragma unroll
    for (int r = 0; r < 16; ++r) { a.o0[r] *= al; a.o1[r] *= al; }
    bf16x8 pb[2];
#pragma unroll
    for (int ks = 0; ks < 2; ++ks) { u32x4_t w; w.x = cvtpk(s[8 * ks], s[8 * ks + 1]); w.y = cvtpk(s[8 * ks + 2], s[8 * ks + 3]); w.z = cvtpk(s[8 * ks + 4], s[8 * ks + 5]); w.w = cvtpk(s[8 * ks + 6], s[8 * ks + 7]); pb[ks] = __builtin_bit_cast(bf16x8, w); }
    const int li = lane & 15;
    LAS const char* vb = vl + (4 * hh + (li >> 2)) * VPITCH + (16 * ((lane >> 4) & 1) + 4 * (li & 3)) * 2;
#pragma unroll
    for (int ks = 0; ks < 2; ++ks) {
        { const s16x4 lo4 = lds_tr16(vb + (16 * ks) * VPITCH), hi4 = lds_tr16(vb + (16 * ks + 8) * VPITCH);
          const bf16x8 vf = {lo4[0], lo4[1], lo4[2], lo4[3], hi4[0], hi4[1], hi4[2], hi4[3]};
          a.o0 = __builtin_amdgcn_mfma_f32_32x32x16_bf16(vf, pb[ks], a.o0, 0, 0, 0); }
        { const s16x4 lo4 = lds_tr16(vb + (16 * ks) * VPITCH + 64), hi4 = lds_tr16(vb + (16 * ks + 8) * VPITCH + 64);
          const bf16x8 vf = {lo4[0], lo4[1], lo4[2], lo4[3], hi4[0], hi4[1], hi4[2], hi4[3]};
          a.o1 = __builtin_amdgcn_mfma_f32_32x32x16_bf16(vf, pb[ks], a.o1, 0, 0, 0); }
    }
}
template <class KP, class VP, class LH>
__device__ __forceinline__ void attn_run(AttnAcc& a, const bf16x8 (&qf)[4], int t0, int t1, const KP& kp, const VP& vp, const LH& lh, LAS char* vl, int lane) {
    if (t0 >= t1) return;
    bf16x8 kn[4]; u32x4_t vn[4];
    { const bf16_t* k = kp(t0); const bf16_t* v = vp(t0);
#pragma unroll
      for (int i = 0; i < 4; ++i) { kn[i] = *(const bf16x8*)(k + 16 * i); vn[i] = *(const u32x4_t*)(v + 8 * i); } }
    LAS char* vw = vl + (lane >> 1) * VPITCH + (lane & 1) * 64;
    for (int t = t0; t < t1; ++t) {
        bf16x8 kf[4];
#pragma unroll
        for (int i = 0; i < 4; ++i) { kf[i] = kn[i]; *(LAS u32x4_t*)(vw + 16 * i) = vn[i]; }
        if (t + 1 < t1) { const bf16_t* k = kp(t + 1); const bf16_t* v = vp(t + 1);
#pragma unroll
            for (int i = 0; i < 4; ++i) { kn[i] = *(const bf16x8*)(k + 16 * i); vn[i] = *(const u32x4_t*)(v + 8 * i); } }
        int lo, hi; lh(t, lo, hi);
        attn_tile(a, qf, kf, vl, lane, lo, hi);
    }
}

constexpr float SENT = -3.0e38f;
__device__ __forceinline__ float half_max(float v) { auto rr = __builtin_amdgcn_permlane32_swap(__float_as_uint(v), __float_as_uint(v), false, false); return fmaxf(__uint_as_float(rr[0]), __uint_as_float(rr[1])); }
__device__ __forceinline__ float half_sum(float v) { auto rr = __builtin_amdgcn_permlane32_swap(__float_as_uint(v), __float_as_uint(v), false, false); return __uint_as_float(rr[0]) + __uint_as_float(rr[1]); }
__device__ __forceinline__ void acc_init64(AttnAcc& a) {
#pragma unroll
    for (int r = 0; r < 16; ++r) { a.o0[r] = 0.f; a.o1[r] = 0.f; }
    a.m = 0.f; a.l = 0.f;
}
__device__ __forceinline__ void attn_qk64(f32x16& s0, f32x16& s1, const bf16x8 (&qf)[4], const bf16x8 (&kf)[8], float negm) {
#pragma unroll
    for (int r = 0; r < 16; ++r) { s0[r] = negm; s1[r] = negm; }
#pragma unroll
    for (int d0 = 0; d0 < 4; ++d0) { s0 = __builtin_amdgcn_mfma_f32_32x32x16_bf16(kf[d0], qf[d0], s0, 0, 0, 0); s1 = __builtin_amdgcn_mfma_f32_32x32x16_bf16(kf[4 + d0], qf[d0], s1, 0, 0, 0); }
}
__device__ __forceinline__ float max3f(float a, float b, float c) { float r; asm("v_max3_f32 %0, %1, %2, %3" : "=v"(r) : "v"(a), "v"(b), "v"(c)); return r; }
__device__ __forceinline__ void mask_sub(f32x16& s, int mode, int dq  ) {
    if (mode == 1) {
#pragma unroll
        for (int r = 0; r < 16; ++r) if (((r & 3) + 8 * (r >> 2)) < dq) s[r] = SENT;
    } else if (mode == 2) {
#pragma unroll
        for (int r = 0; r < 16; ++r) if (((r & 3) + 8 * (r >> 2)) > dq) s[r] = SENT;
    } else if (mode == 3) {
#pragma unroll
        for (int r = 0; r < 16; ++r) s[r] = SENT;
    }
}
__device__ __forceinline__ void attn_sv64(AttnAcc& a, f32x16& s0, f32x16& s1, LAS const char* vl, int lane, int m0, int m1) {
    const int hh = lane >> 5;
    if (m0 | m1) { const int dq = (lane & 31) - 4 * hh; mask_sub(s0, m0, dq); mask_sub(s1, m1, dq); }
    float mx;
    {
      const float a0 = max3f(s0[0], s0[1], s0[2]), a1 = max3f(s0[3], s0[4], s0[5]), a2 = max3f(s0[6], s0[7], s0[8]), a3 = max3f(s0[9], s0[10], s0[11]), a4 = max3f(s0[12], s0[13], s0[14]);
      const float b0 = max3f(s1[0], s1[1], s1[2]), b1 = max3f(s1[3], s1[4], s1[5]), b2 = max3f(s1[6], s1[7], s1[8]), b3 = max3f(s1[9], s1[10], s1[11]), b4 = max3f(s1[12], s1[13], s1[14]);
      const float c0 = max3f(a0, a1, a2), c1 = max3f(a3, a4, s0[15]), c2 = max3f(b0, b1, b2), c3 = max3f(b3, b4, s1[15]);
      mx = max3f(max3f(c0, c1, c2), c3, SENT); }
    mx = half_max(mx);
    if (__any(mx > 8.0f)) {
        const float dl = mx > 8.0f ? mx : 0.f, al = __builtin_amdgcn_exp2f(-dl);
        a.m += dl; a.l *= al;
#pragma unroll
        for (int r = 0; r < 16; ++r) { a.o0[r] *= al; a.o1[r] *= al; s0[r] -= dl; s1[r] -= dl; }
    }
    float ps = 0.f;
#pragma unroll
    for (int r = 0; r < 16; ++r) {
        const float p0 = __builtin_amdgcn_exp2f(s0[r]), p1 = __builtin_amdgcn_exp2f(s1[r]);
        s0[r] = p0; s1[r] = p1; ps += p0 + p1;
    }
    a.l += ps;
    bf16x8 pb[4];
#pragma unroll
    for (int ks = 0; ks < 2; ++ks) {
        u32x4_t w; w.x = cvtpk(s0[8 * ks], s0[8 * ks + 1]); w.y = cvtpk(s0[8 * ks + 2], s0[8 * ks + 3]); w.z = cvtpk(s0[8 * ks + 4], s0[8 * ks + 5]); w.w = cvtpk(s0[8 * ks + 6], s0[8 * ks + 7]); pb[ks] = __builtin_bit_cast(bf16x8, w);
        u32x4_t v; v.x = cvtpk(s1[8 * ks], s1[8 * ks + 1]); v.y = cvtpk(s1[8 * ks + 2], s1[8 * ks + 3]); v.z = cvtpk(s1[8 * ks + 4], s1[8 * ks + 5]); v.w = cvtpk(s1[8 * ks + 6], s1[8 * ks + 7]); pb[2 + ks] = __builtin_bit_cast(bf16x8, v); }
    const int li = lane & 15;
    LAS const char* vb = vl + (4 * hh + (li >> 2)) * VPITCH + (16 * ((lane >> 4) & 1) + 4 * (li & 3)) * 2;
#pragma unroll
    for (int kh = 0; kh < 2; ++kh) {
        s16x4 t0[4], t1[4];
#pragma unroll
        for (int kk = 0; kk < 2; ++kk) { const int ks = 2 * kh + kk; t0[2 * kk] = lds_tr16(vb + (16 * ks) * VPITCH); t0[2 * kk + 1] = lds_tr16(vb + (16 * ks + 8) * VPITCH); t1[2 * kk] = lds_tr16(vb + (16 * ks) * VPITCH + 64); t1[2 * kk + 1] = lds_tr16(vb + (16 * ks + 8) * VPITCH + 64); }
#pragma unroll
        for (int kk = 0; kk < 2; ++kk) { const int ks = 2 * kh + kk;
            const bf16x8 vf0 = {t0[2 * kk][0], t0[2 * kk][1], t0[2 * kk][2], t0[2 * kk][3], t0[2 * kk + 1][0], t0[2 * kk + 1][1], t0[2 * kk + 1][2], t0[2 * kk + 1][3]};
            const bf16x8 vf1 = {t1[2 * kk][0], t1[2 * kk][1], t1[2 * kk][2], t1[2 * kk][3], t1[2 * kk + 1][0], t1[2 * kk + 1][1], t1[2 * kk + 1][2], t1[2 * kk + 1][3]};
            a.o0 = __builtin_amdgcn_mfma_f32_32x32x16_bf16(vf0, pb[ks], a.o0, 0, 0, 0);
            a.o1 = __builtin_amdgcn_mfma_f32_32x32x16_bf16(vf1, pb[ks], a.o1, 0, 0, 0); }
    }
}
constexpr int KT_BYTES = 64 * 128;
__device__ __forceinline__ void stage_load(u32x4_t (&kn)[8], u32x4_t (&vn)[8], const bf16_t* k0, const bf16_t* k1, const bf16_t* v0, const bf16_t* v1, int rstride, int lane) {
    const size_t o = (size_t)(lane >> 3) * rstride + (lane & 7) * 8, st8 = (size_t)8 * rstride;
#pragma unroll
    for (int i = 0; i < 4; ++i) { kn[i] = *(const u32x4_t*)(k0 + o + i * st8); kn[4 + i] = *(const u32x4_t*)(k1 + o + i * st8); vn[i] = *(const u32x4_t*)(v0 + o + i * st8); vn[4 + i] = *(const u32x4_t*)(v1 + o + i * st8); }
}
__device__ __forceinline__ void stage_write(LAS char* kl, LAS char* vl, const u32x4_t (&kn)[8], const u32x4_t (&vn)[8], int lane) {
    const int r0 = lane >> 3, ch = lane & 7;
#pragma unroll
    for (int i = 0; i < 8; ++i) { const int row = 32 * (i >> 2) + r0 + 8 * (i & 3);
        *(LAS u32x4_t*)(kl + row * 128 + ((ch ^ ((row >> 1) & 7)) * 16)) = kn[i];
        *(LAS u32x4_t*)(vl + row * VPITCH + ch * 16) = vn[i]; }
}
__device__ __forceinline__ void kfrag_read(bf16x8 (&kf)[8], LAS const char* kl, int lane) {
    const int c = lane & 31, hh = lane >> 5, sw = (c >> 1) & 7;
#pragma unroll
    for (int sub = 0; sub < 2; ++sub)
#pragma unroll
        for (int d0 = 0; d0 < 4; ++d0) kf[4 * sub + d0] = __builtin_bit_cast(bf16x8, *(LAS const u32x4_t*)(kl + (32 * sub + c) * 128 + (((2 * d0 + hh) ^ sw) * 16)));
}
template <int KSTR = 16, int VSTR = 8, class KP, class VP, class MK>
__device__ __forceinline__ void attn_run64(AttnAcc& a, const bf16x8 (&qf)[4], int st0, int st1, const KP& kp, const VP& vp, const MK& mk, LAS char* vl, int lane) {
    if (st0 >= st1) return;
    bf16x8 kn[8]; u32x4_t vn[8];
#pragma unroll
    for (int sub = 0; sub < 2; ++sub) { const bf16_t* k = kp(st0, sub); const bf16_t* v = vp(st0, sub);
#pragma unroll
        for (int i = 0; i < 4; ++i) { kn[4 * sub + i] = *(const bf16x8*)(k + KSTR * i); vn[4 * sub + i] = *(const u32x4_t*)(v + VSTR * i); } }
    LAS char* vw = vl + (lane >> 1) * VPITCH + (lane & 1) * 64;
#pragma unroll 1
    for (int st = st0; st < st1; ++st) {
#pragma unroll
        for (int i = 0; i < 8; ++i) *(LAS u32x4_t*)(vw + (i >> 2) * 32 * VPITCH + 16 * (i & 3)) = vn[i];
        if (st + 1 < st1) {
#pragma unroll
            for (int sub = 0; sub < 2; ++sub) { const bf16_t* v = vp(st + 1, sub);
#pragma unroll
                for (int i = 0; i < 4; ++i) vn[4 * sub + i] = *(const u32x4_t*)(v + VSTR * i); } }
        f32x16 s0, s1;
        attn_qk64(s0, s1, qf, kn, -a.m);
        asm volatile("" : "+v"(s0), "+v"(s1));
        if (st + 1 < st1) {
#pragma unroll
            for (int sub = 0; sub < 2; ++sub) { const bf16_t* k = kp(st + 1, sub);
#pragma unroll
                for (int i = 0; i < 4; ++i) kn[4 * sub + i] = *(const bf16x8*)(k + KSTR * i); } }
        int m0, m1; mk(st, m0, m1);
        attn_sv64(a, s0, s1, vl, lane, m0, m1);
    }
}
__device__ __forceinline__ void attn_finish64(const AttnAcc& a, float& inv_l, float& lse) {
    const float l = half_sum(a.l);
    inv_l = 1.0f / l; lse = (a.m + __log2f(l)) * 0.6931471805599453f;
}
__device__ __forceinline__ void attn_finish(const AttnAcc& a, float& inv_l, float& lse) {
    const float l = a.l + __shfl_xor(a.l, 32);
    inv_l = 1.0f / l; lse = (a.m + __log2f(l)) * 0.6931471805599453f;
}
__device__ __forceinline__ void store_o(bf16_t* op, const f32x16& o0, const f32x16& o1, float sc, int hh) {
#pragma unroll
    for (int rr = 0; rr < 4; ++rr) {
        uint2 w0, w1; w0.x = cvtpk(o0[4 * rr] * sc, o0[4 * rr + 1] * sc); w0.y = cvtpk(o0[4 * rr + 2] * sc, o0[4 * rr + 3] * sc);
        w1.x = cvtpk(o1[4 * rr] * sc, o1[4 * rr + 1] * sc); w1.y = cvtpk(o1[4 * rr + 2] * sc, o1[4 * rr + 3] * sc);
        *(uint2*)(op + 8 * rr + 4 * hh) = w0; *(uint2*)(op + 32 + 8 * rr + 4 * hh) = w1; }
}

__device__ __forceinline__ void store_o_frag(bf16_t* op, const f32x16& o0, const f32x16& o1, float sc, int hh) {
    u32x4_t* q = (u32x4_t*)(op + 32 * hh);
#pragma unroll
    for (int g = 0; g < 2; ++g) { u32x4_t w0, w1;
        w0.x = cvtpk(o0[8 * g] * sc, o0[8 * g + 1] * sc); w0.y = cvtpk(o0[8 * g + 2] * sc, o0[8 * g + 3] * sc); w0.z = cvtpk(o0[8 * g + 4] * sc, o0[8 * g + 5] * sc); w0.w = cvtpk(o0[8 * g + 6] * sc, o0[8 * g + 7] * sc);
        w1.x = cvtpk(o1[8 * g] * sc, o1[8 * g + 1] * sc); w1.y = cvtpk(o1[8 * g + 2] * sc, o1[8 * g + 3] * sc); w1.z = cvtpk(o1[8 * g + 4] * sc, o1[8 * g + 5] * sc); w1.w = cvtpk(o1[8 * g + 6] * sc, o1[8 * g + 7] * sc);
        q[g] = w0; q[2 + g] = w1; }
}
__device__ __forceinline__ void fma_frag(f32x16& o0, f32x16& o1, const u32x4_t (&v)[4], float w) {
#pragma unroll
    for (int g = 0; g < 2; ++g)
#pragma unroll
        for (int i = 0; i < 4; ++i) { const unsigned a = v[g][i], b = v[2 + g][i];
            o0[8 * g + 2 * i] += w * __uint_as_float(a << 16); o0[8 * g + 2 * i + 1] += w * __uint_as_float(a & 0xffff0000u);
            o1[8 * g + 2 * i] += w * __uint_as_float(b << 16); o1[8 * g + 2 * i + 1] += w * __uint_as_float(b & 0xffff0000u); }
}
__device__ __forceinline__ void load_frag(u32x4_t (&v)[4], const bf16_t* pp, int hh) {
    const u32x4_t* q = (const u32x4_t*)(pp + 32 * hh);
#pragma unroll
    for (int g = 0; g < 4; ++g) v[g] = q[g];
}
__device__ __forceinline__ void add_partial(f32x16& o0, f32x16& o1, const bf16_t* pp, float w, int hh) {
#pragma unroll
    for (int rr = 0; rr < 4; ++rr) {
        const uint2 w0 = *(const uint2*)(pp + 8 * rr + 4 * hh), w1 = *(const uint2*)(pp + 32 + 8 * rr + 4 * hh);
        o0[4 * rr] += w * __uint_as_float(w0.x << 16); o0[4 * rr + 1] += w * __uint_as_float(w0.x & 0xffff0000u); o0[4 * rr + 2] += w * __uint_as_float(w0.y << 16); o0[4 * rr + 3] += w * __uint_as_float(w0.y & 0xffff0000u);
        o1[4 * rr] += w * __uint_as_float(w1.x << 16); o1[4 * rr + 1] += w * __uint_as_float(w1.x & 0xffff0000u); o1[4 * rr + 2] += w * __uint_as_float(w1.y << 16); o1[4 * rr + 3] += w * __uint_as_float(w1.y & 0xffff0000u); }
}


constexpr size_t HB_H16 = 64 * MiB;
constexpr size_t HB_MPO = 0, HB_MPL = 96 * MiB, HB_MLIST = 100 * MiB;
constexpr int CW_LCNT = 2048;
constexpr int LIST_PER_BH = 64 * 16384 - 128 * 64 * 65;
__device__ __forceinline__ int list_off(int bh, int n) { return bh * LIST_PER_BH + n * 16384 - 128 * n * (n + 1); }
__device__ __forceinline__ void d_moba_route(int vb, const bf16_t* __restrict__ P, const float* __restrict__ kmean, unsigned* __restrict__ lcnt, unsigned short* __restrict__ lists, float* __restrict__ mpl, LAS unsigned* lc  ) {
    const int lane = my_lane(), wave = __builtin_amdgcn_readfirstlane(threadIdx.x >> 6), tid = wave * 64 + lane, c = lane & 31, hh = lane >> 5;
    const int i0 = vb * NTH;
    const int pos0 = i0 & (S - 1), h = (i0 >> 14) & 7, b = i0 >> 17, bh = b * 8 + h;
    if (tid < 64) lc[tid] = 0u;
    constexpr int KMP = 144;
    LAS char* kmh = (LAS char*)(lc + 256); LAS char* kml = kmh + 64 * KMP;
    { const float* src = kmean + (size_t)bh * 64 * 64 + tid * 8; const f32x4_t v0 = *(const f32x4_t*)src, v1 = *(const f32x4_t*)(src + 4);
      const float v[8] = {v0[0], v0[1], v0[2], v0[3], v1[0], v1[1], v1[2], v1[3]}; u32x4_t hi, lo;
#pragma unroll
      for (int q = 0; q < 4; ++q) { const unsigned h0 = f2bf(v[2 * q]), h1 = f2bf(v[2 * q + 1]);
          hi[q] = h0 | (h1 << 16); lo[q] = (unsigned)f2bf(v[2 * q] - __uint_as_float(h0 << 16)) | ((unsigned)f2bf(v[2 * q + 1] - __uint_as_float(h1 << 16)) << 16); }
      const int n = tid >> 3, d0 = (tid & 7) * 8;
      *(LAS u32x4_t*)(kmh + n * KMP + d0 * 2) = hi; *(LAS u32x4_t*)(kml + n * KMP + d0 * 2) = lo; }
    __syncthreads();
    const int qb = pos0 >> 8;
    int bi[2][3]; unsigned lr[2][3];
#pragma unroll
    for (int t2 = 0; t2 < 2; ++t2) {
        const int pt = pos0 + 64 * wave + 32 * t2, pos = pt + c, nb = pt >> 8;
        bf16x8 qf[4];
        { const bf16_t* qp = P + L0_AQ + hm(b, 8, h, pos, 64) + 8 * hh;
#pragma unroll
          for (int s4 = 0; s4 < 4; ++s4) qf[s4] = *(const bf16x8*)(qp + 16 * s4); }
        float bv[3] = {-INFINITY, -INFINITY, -INFINITY}; int bx[3] = {-1, -1, -1};
#pragma unroll
        for (int t = 0; t < 2; ++t) {
            if (32 * t < nb) {
                f32x16 g;
#pragma unroll
                for (int r = 0; r < 16; ++r) g[r] = 0.f;
#pragma unroll
                for (int s4 = 0; s4 < 4; ++s4) { const int off = (32 * t + c) * KMP + (16 * s4 + 8 * hh) * 2;
                    const bf16x8 ah = __builtin_bit_cast(bf16x8, *(LAS const u32x4_t*)(kmh + off)), al = __builtin_bit_cast(bf16x8, *(LAS const u32x4_t*)(kml + off));
                    g = __builtin_amdgcn_mfma_f32_32x32x16_bf16(ah, qf[s4], g, 0, 0, 0); g = __builtin_amdgcn_mfma_f32_32x32x16_bf16(al, qf[s4], g, 0, 0, 0); }
#pragma unroll
                for (int r = 0; r < 16; ++r) { const int n = 32 * t + (r & 3) + 8 * (r >> 2) + 4 * hh; const float gv = n < nb ? g[r] : -INFINITY;
                    if (gv > bv[0]) { bv[2] = bv[1]; bx[2] = bx[1]; bv[1] = bv[0]; bx[1] = bx[0]; bv[0] = gv; bx[0] = n; }
                    else if (gv > bv[1]) { bv[2] = bv[1]; bx[2] = bx[1]; bv[1] = gv; bx[1] = n; }
                    else if (gv > bv[2]) { bv[2] = gv; bx[2] = n; } }
            }
        }
        float ovs[3]; int oxs[3];
#pragma unroll
        for (int k = 0; k < 3; ++k) { ovs[k] = __shfl_xor(bv[k], 32); oxs[k] = __shfl_xor(bx[k], 32); }
#pragma unroll
        for (int k = 0; k < 3; ++k) { const float ov = ovs[k]; const int ox = oxs[k];
            if (ox >= 0) {
                if (ov > bv[0] || (ov == bv[0] && ox < bx[0])) { bv[2] = bv[1]; bx[2] = bx[1]; bv[1] = bv[0]; bx[1] = bx[0]; bv[0] = ov; bx[0] = ox; }
                else if (ov > bv[1] || (ov == bv[1] && ox < bx[1])) { bv[2] = bv[1]; bx[2] = bx[1]; bv[1] = ov; bx[1] = ox; }
                else if (ov > bv[2] || (ov == bv[2] && ox < bx[2])) { bv[2] = ov; bx[2] = ox; } } }
#pragma unroll
        for (int k = 0; k < 3; ++k) { bi[t2][k] = bx[k]; lr[t2][k] = (hh == 0 && bx[k] >= 0) ? __hip_atomic_fetch_add(&lc[bx[k]], 1u, __ATOMIC_RELAXED, __HIP_MEMORY_SCOPE_WORKGROUP) : 0u; }
    }
    __syncthreads();
    if (tid < 64) { const unsigned n = lc[tid]; lc[64 + tid] = n ? atomicAdd(&lcnt[bh * 64 + tid], n) : 0u; }
    __syncthreads();
    if (hh == 0) {
#pragma unroll
        for (int t2 = 0; t2 < 2; ++t2) { const int pos = pos0 + 64 * wave + 32 * t2 + c; const size_t tok = (size_t)b * S + pos;
#pragma unroll
            for (int k = 0; k < 3; ++k) {
                if (bi[t2][k] >= 0) lists[list_off(bh, bi[t2][k]) + lc[64 + bi[t2][k]] + lr[t2][k]] = (unsigned short)(pos | (k << 14));
                else mpl[(tok * 8 + h) * 3 + k] = NEG_BIG; } }
    }
    __syncthreads();
}
constexpr int KP_R = 144, VP_R = 272;
__device__ __forceinline__ float ret_log2gamma(int h) { return __log2f(1.0f - exp2f(-5.0f - (float)h)); }
__device__ __forceinline__ void ret_state_item(int item, const bf16_t* __restrict__ P, float* __restrict__ stateT, LAS char* lds, int wave, int lane) {
    const int n = item & 127, h = (item >> 7) & 3, b = item >> 9;
    const float l2g = ret_log2gamma(h);
    const int t = wave * 64 + lane, row = t >> 2, part = t & 3;
    LAS char* Ks = lds; LAS char* Vs = lds + 128 * KP_R;
    const bf16_t* rkb = P + L0_RK + hm(b, 4, h, 0, 64); const bf16_t* rvp = P + L0_RV + hm(b, 4, h, n * 128 + row, 128);
    { const float sc = __builtin_amdgcn_exp2f(l2g * (float)(127 - row));
#pragma unroll
      for (int i = 0; i < 2; ++i) { const uint4 u = *(const uint4*)(rkb + akf_off(n * 128 + row, part * 16 + 8 * i)); const unsigned w[4] = {u.x, u.y, u.z, u.w}; u32x4_t o;
#pragma unroll
          for (int q = 0; q < 4; ++q) o[q] = cvtpk(__uint_as_float(w[q] << 16) * sc, __uint_as_float(w[q] & 0xffff0000u) * sc);
          *(LAS u32x4_t*)(Ks + row * KP_R + part * 32 + i * 16) = o; }
      const u32x4_t* vp = (const u32x4_t*)(rvp + part * 32);
#pragma unroll
      for (int i = 0; i < 4; ++i) *(LAS u32x4_t*)(Vs + row * VP_R + part * 64 + i * 16) = vp[i]; }
    __syncthreads();
    const int et = wave >> 1, dt = wave & 1, li = lane & 15, hh = lane >> 5, c = lane & 31;
    const int rsel = 4 * hh + (li >> 2), csel = 16 * ((lane >> 4) & 1) + 4 * (li & 3);
    LAS const char* va = Vs + rsel * VP_R + (32 * et + csel) * 2;
    LAS const char* ka = Ks + rsel * KP_R + (32 * dt + csel) * 2;
    f32x16 acc;
#pragma unroll
    for (int r = 0; r < 16; ++r) acc[r] = 0.f;
#pragma unroll
    for (int ks = 0; ks < 8; ++ks) {
        const s16x4 v0 = lds_tr16(va + (16 * ks) * VP_R), v1 = lds_tr16(va + (16 * ks + 8) * VP_R);
        const s16x4 k0 = lds_tr16(ka + (16 * ks) * KP_R), k1 = lds_tr16(ka + (16 * ks + 8) * KP_R);
        const bf16x8 af = {v0[0], v0[1], v0[2], v0[3], v1[0], v1[1], v1[2], v1[3]}, bfr = {k0[0], k0[1], k0[2], k0[3], k1[0], k1[1], k1[2], k1[3]};
        acc = __builtin_amdgcn_mfma_f32_32x32x16_bf16(af, bfr, acc, 0, 0, 0);
    }
    float* op = stateT + (size_t)item * 8192 + 32 * dt + c;
#pragma unroll
    for (int r = 0; r < 16; ++r) op[(32 * et + (r & 3) + 8 * (r >> 2) + 4 * hh) * 64] = acc[r];
    __syncthreads();
}
__device__ __forceinline__ void ret_scan_thread(int i, const float* __restrict__ stateT, bf16_t* __restrict__ rprevT) {
    const int ed = i & 8191, bh = i >> 13, h = bh & 3;
    const float gc = __builtin_amdgcn_exp2f(ret_log2gamma(h) * 128.0f); float r = 0.f;
    const int e_ = ed >> 6, d_ = ed & 63;
    const float* sp = stateT + (size_t)bh * 128 * 8192 + ed; bf16_t* op = rprevT + (size_t)bh * 128 * 8192 + akf_off(e_, d_);
    for (int n0 = 0; n0 < 128; n0 += 8) { float v[8];
#pragma unroll
        for (int q = 0; q < 8; ++q) v[q] = sp[(size_t)(n0 + q) * 8192];
#pragma unroll
        for (int q = 0; q < 8; ++q) { op[(size_t)(n0 + q) * 8192] = f2bf(r); r = gc * r + v[q]; } }
}
__device__ __forceinline__ void ret_out_item(int item, const bf16_t* __restrict__ P, const bf16_t* __restrict__ rprevT, bf16_t* __restrict__ AO, LAS char* vl, int lane) {
    const int n = (item >> 2) & 127, h = (item >> 9) & 3, b = item >> 11, j = b ? 3 - (item & 3) : (item & 3);
    const int c = lane & 31, hh = lane >> 5, li = lane & 15;
    const float l2g = ret_log2gamma(h);
    const size_t tok0 = (size_t)b * S + n * 128, tok = tok0 + 32 * j + c;
    const int posr = n * 128 + 32 * j + c;
    const bf16_t* qrow = P + L0_RQ + hm(b, 4, h, posr, 64) + 8 * hh;
    bf16x8 qf[4];
#pragma unroll
    for (int i = 0; i < 4; ++i) qf[i] = *(const bf16x8*)(qrow + 16 * i);
    f32x16 acc[4];
#pragma unroll
    for (int et = 0; et < 4; ++et)
#pragma unroll
        for (int r = 0; r < 16; ++r) acc[et][r] = 0.f;
    { const bf16_t* rp = rprevT + ((size_t)((b * 4 + h) * 128 + n)) * 8192 + lane * 8;
#pragma unroll
      for (int et = 0; et < 4; ++et)
#pragma unroll
          for (int ks = 0; ks < 4; ++ks) { const bf16x8 af = *(const bf16x8*)(rp + (et * 4 + ks) * 512); acc[et] = __builtin_amdgcn_mfma_f32_32x32x16_bf16(af, qf[ks], acc[et], 0, 0, 0); } }
    const int iq = 32 * j + c;
    { const float sc = __builtin_amdgcn_exp2f(l2g * (float)(iq + 1));
#pragma unroll
      for (int et = 0; et < 4; ++et)
#pragma unroll
          for (int r = 0; r < 16; ++r) acc[et][r] *= sc; }
    const bf16_t* Kb = P + L0_RK + hm(b, 4, h, n * 128, 64) + lane * 8;
    const bf16_t* Vb = P + L0_RV + hm(b, 4, h, n * 128, 128) + (lane & 1) * 64;
    LAS char* vw = vl + (lane >> 1) * VP_R + (lane & 1) * 128;
    LAS const char* vb = vl + (4 * hh + (li >> 2)) * VP_R + (16 * ((lane >> 4) & 1) + 4 * (li & 3)) * 2;
    for (int tt = 0; tt <= j; ++tt) {
        bf16x8 kf[4]; u32x4_t vn[8];
        { const bf16_t* k = Kb + (size_t)tt * 2048; const bf16_t* v = Vb + (size_t)(32 * tt + (lane >> 1)) * 128;
#pragma unroll
          for (int i = 0; i < 4; ++i) kf[i] = *(const bf16x8*)(k + 512 * i);
#pragma unroll
          for (int i = 0; i < 8; ++i) vn[i] = *(const u32x4_t*)(v + 8 * i); }
#pragma unroll
        for (int i = 0; i < 8; ++i) *(LAS u32x4_t*)(vw + 16 * i) = vn[i];
        f32x16 s;
#pragma unroll
        for (int r = 0; r < 16; ++r) s[r] = 0.f;
#pragma unroll
        for (int d0 = 0; d0 < 4; ++d0) s = __builtin_amdgcn_mfma_f32_32x32x16_bf16(kf[d0], qf[d0], s, 0, 0, 0);
#pragma unroll
        for (int r = 0; r < 16; ++r) { const int dlt = iq - (32 * tt + (r & 3) + 8 * (r >> 2) + 4 * hh); s[r] = dlt >= 0 ? s[r] * __builtin_amdgcn_exp2f(l2g * (float)dlt) : 0.f; }
        bf16x8 pb[2];
#pragma unroll
        for (int ks = 0; ks < 2; ++ks) { u32x4_t w; w.x = cvtpk(s[8 * ks], s[8 * ks + 1]); w.y = cvtpk(s[8 * ks + 2], s[8 * ks + 3]); w.z = cvtpk(s[8 * ks + 4], s[8 * ks + 5]); w.w = cvtpk(s[8 * ks + 6], s[8 * ks + 7]); pb[ks] = __builtin_bit_cast(bf16x8, w); }
#pragma unroll
        for (int ks = 0; ks < 2; ++ks)
#pragma unroll
            for (int et = 0; et < 4; ++et) { const s16x4 lo4 = lds_tr16(vb + (16 * ks) * VP_R + et * 64), hi4 = lds_tr16(vb + (16 * ks + 8) * VP_R + et * 64);
                const bf16x8 vf = {lo4[0], lo4[1], lo4[2], lo4[3], hi4[0], hi4[1], hi4[2], hi4[3]};
                acc[et] = __builtin_amdgcn_mfma_f32_32x32x16_bf16(vf, pb[ks], acc[et], 0, 0, 0); }
    }
    float sum = 0.f;
#pragma unroll
    for (int et = 0; et < 4; ++et)
#pragma unroll
        for (int r = 0; r < 16; ++r) sum += acc[et][r];
    sum += __shfl_xor(sum, 32);
    const float mu = sum * (1.0f / 128.0f); float sq = 0.f;
#pragma unroll
    for (int et = 0; et < 4; ++et)
#pragma unroll
        for (int r = 0; r < 16; ++r) { const float dl = acc[et][r] - mu; sq += dl * dl; }
    sq += __shfl_xor(sq, 32);
    const float rs = rsqrtf(sq * (1.0f / 128.0f) + EPS);
    const bf16_t* gp = P + L0_RG + hm(b, 4, h, posr, 128) + 4 * hh;
    bf16_t* op = AO + tok * D + 512 + h * 128 + 4 * hh;
#pragma unroll
    for (int et = 0; et < 4; ++et)
#pragma unroll
        for (int rr = 0; rr < 4; ++rr) { const uint2 g = *(const uint2*)(gp + 32 * et + 8 * rr);
            const float g0 = __uint_as_float(g.x << 16), g1 = __uint_as_float(g.x & 0xffff0000u), g2 = __uint_as_float(g.y << 16), g3 = __uint_as_float(g.y & 0xffff0000u);
            uint2 w; w.x = cvtpk((acc[et][4 * rr] - mu) * rs * silu(g0), (acc[et][4 * rr + 1] - mu) * rs * silu(g1)); w.y = cvtpk((acc[et][4 * rr + 2] - mu) * rs * silu(g2), (acc[et][4 * rr + 3] - mu) * rs * silu(g3));
            *(uint2*)(op + 32 * et + 8 * rr) = w; }
}
constexpr int CB_BYTES = KT_BYTES + 64 * VPITCH;
template <bool PHASEB>
__device__ __forceinline__ void dilated_coop(const bf16_t* __restrict__ P, bf16_t* __restrict__ dpo, float* __restrict__ dpl, bf16_t* __restrict__ AO, LAS char* lds, int wave, int lane) {
    constexpr int SEG = PHASEB ? 16 : 32;
    const int c = lane & 31, hh = lane >> 5, t = wave * 64 + lane, key = t >> 3, chunk = t & 7;
    const int nseg = PHASEB ? NB * 16 * 16 : NB * 16 * 16;
    for (int sg = blockIdx.x; sg < nseg; sg += gridDim.x) {
        int b, h, dil, r, s0, br;
        if (!PHASEB) { const int q = sg & 7; br = (sg >> 3) & 1; h = (sg >> 4) & 15; b = sg >> 8; dil = br ? 4 : 1; if (br) { r = q >> 1; s0 = (q & 1) * 32; } else { r = 0; s0 = q * 32; } }
        else { br = 2; r = sg & 15; h = (sg >> 4) & 15; b = sg >> 8; dil = 16; s0 = 0; }
        const int nst = (S / dil) / 64;
        const int sbeg = s0 >= 2 ? s0 - 2 : 0, send = s0 + SEG;
        const bf16_t* Kb = P + L1_K + hm(b, 16, h, r, 64) + chunk * 8; const bf16_t* Vb = P + L1_V + hm(b, 16, h, r, 64) + chunk * 8;
        const size_t rs = (size_t)dil * 64;
        int j = 2 * s0 + wave; const int jend = 2 * s0 + 2 * SEG;
        bf16x8 qf[4];
        { const bf16_t* q = P + L1_Q + hm(b, 16, h, r + dil * (32 * j + c), 64) + 8 * hh;
#pragma unroll
          for (int i = 0; i < 4; ++i) qf[i] = *(const bf16x8*)(q + 16 * i); }
        AttnAcc a; acc_init64(a);
        float pl1 = 0.f, pl2 = 0.f; u32x4_t po1[4], po2[4];
        LAS char* kw = lds + key * 128 + ((chunk ^ ((key >> 1) & 7)) * 16); LAS char* vw = lds + KT_BYTES + key * VPITCH + chunk * 16;
        u32x4_t k1, v1, k2, v2;
        { const u32x4_t k0 = *(const u32x4_t*)(Kb + (size_t)(64 * sbeg + key) * rs), v0 = *(const u32x4_t*)(Vb + (size_t)(64 * sbeg + key) * rs);
          const int s1 = sbeg + 1 < nst ? sbeg + 1 : sbeg;
          k1 = *(const u32x4_t*)(Kb + (size_t)(64 * s1 + key) * rs); v1 = *(const u32x4_t*)(Vb + (size_t)(64 * s1 + key) * rs);
          *(LAS u32x4_t*)(kw + (sbeg & 1) * CB_BYTES) = k0; *(LAS u32x4_t*)(vw + (sbeg & 1) * CB_BYTES) = v0; }
        __syncthreads();
#pragma unroll 1
        for (int s = sbeg; s < send; ++s) {
            { const int s2 = s + 2 < nst ? s + 2 : nst - 1;
              k2 = *(const u32x4_t*)(Kb + (size_t)(64 * s2 + key) * rs); v2 = *(const u32x4_t*)(Vb + (size_t)(64 * s2 + key) * rs); }
            const int fs = j >= 4 ? (j - 4) >> 1 : 0, ls = j >> 1;
            if (j < jend && s >= fs && s <= ls) {
                LAS char* kl = lds + (s & 1) * CB_BYTES;
                if (PHASEB && s == fs) { const size_t tok = (size_t)b * S + r + (size_t)dil * (32 * j + c), pi = (tok * 16 + h) * 2; pl1 = dpl[pi]; pl2 = dpl[pi + 1];
                    load_frag(po1, dpo + pi * 64, hh); load_frag(po2, dpo + (pi + 1) * 64, hh); }
                bf16x8 kf[8]; kfrag_read(kf, kl, lane);
                f32x16 s0v, s1v;
                attn_qk64(s0v, s1v, qf, kf, -a.m);
                const int tta = 2 * s - (j - 4), ttb = tta + 1;
                const int m0 = (tta < 0 || tta > 4) ? 3 : (tta == 0 ? 1 : (tta == 4 ? 2 : 0)), m1 = (ttb < 0 || ttb > 4) ? 3 : (ttb == 0 ? 1 : (ttb == 4 ? 2 : 0));
                attn_sv64(a, s0v, s1v, kl + KT_BYTES, lane, m0, m1);
                if (s == ls) {
                    float inv, lse; attn_finish64(a, inv, lse);
                    const size_t tok = (size_t)b * S + r + (size_t)dil * (32 * j + c);
                    if (!PHASEB) { const size_t pi = (tok * 16 + h) * 2 + br; store_o_frag(dpo + pi * 64, a.o0, a.o1, inv, hh); if (hh == 0) dpl[pi] = lse; }
                    else { const float mxl = fmaxf(fmaxf(pl1, pl2), lse);
                        const float w1 = __expf(pl1 - mxl), w2 = __expf(pl2 - mxl), w3 = __expf(lse - mxl), iw = 1.0f / (w1 + w2 + w3), s3 = w3 * inv;
#pragma unroll
                        for (int q = 0; q < 16; ++q) { a.o0[q] *= s3; a.o1[q] *= s3; }
                        fma_frag(a.o0, a.o1, po1, w1); fma_frag(a.o0, a.o1, po2, w2);
                        store_o(AO + tok * D + h * 64, a.o0, a.o1, iw, hh); }
                    j += 8; acc_init64(a);
                    if (j < jend) { const bf16_t* q = P + L1_Q + hm(b, 16, h, r + dil * (32 * j + c), 64) + 8 * hh;
#pragma unroll
                        for (int i = 0; i < 4; ++i) qf[i] = *(const bf16x8*)(q + 16 * i); }
                }
            }
            if (s + 1 < send) { const int bn = ((s + 1) & 1) * CB_BYTES; *(LAS u32x4_t*)(kw + bn) = k1; *(LAS u32x4_t*)(vw + bn) = v1; }
            asm volatile("s_waitcnt lgkmcnt(0)" ::: "memory"); __builtin_amdgcn_s_barrier(); asm volatile("" ::: "memory");
            k1 = k2; v1 = v2;
        }
    }
}
__device__ __forceinline__ void router_tile(int tile, int khalf, const bf16_t* __restrict__ h, const bf16x8* __restrict__ WR, const bf16x8* __restrict__ WR2, const float* __restrict__ bg, const float* __restrict__ bfine,
                                            int2* __restrict__ toke, float2* __restrict__ tokg, float* __restrict__ tokrs, unsigned* __restrict__ tokrank, unsigned* __restrict__ tilecnt, LAS float* xch, int lane,
                                            int pad_) {
    const int c = lane & 31, hh = lane >> 5, tok = tile * 32 + c;
    const bf16x8* hp = (const bf16x8*)(h + (size_t)tok * D + 512 * khalf + 8 * hh);
    const bf16x8* w1h = WR + (32 * khalf) * 64 + lane; const bf16x8* w1l = w1h + 2 * 64 * 64;
    const bf16x8* w2h = WR2 + (32 * khalf) * 64 + lane; const bf16x8* w2l = w2h + 2 * 64 * 64;
    f32x16 acc, acc2;
#pragma unroll
    for (int r = 0; r < 16; ++r) { acc[r] = 0.f; acc2[r] = 0.f; }
    float ss = 0.f;
#pragma unroll 8
    for (int g = 0; g < 32; ++g) {
        const bf16x8 x = hp[2 * g]; const bf16x8 a1h = w1h[g * 64], a1l = w1l[g * 64], a2h = w2h[g * 64], a2l = w2l[g * 64];
        acc = __builtin_amdgcn_mfma_f32_32x32x16_bf16(a1h, x, acc, 0, 0, 0);   acc2 = __builtin_amdgcn_mfma_f32_32x32x16_bf16(a2h, x, acc2, 0, 0, 0);
        acc = __builtin_amdgcn_mfma_f32_32x32x16_bf16(a1l, x, acc, 0, 0, 0);   acc2 = __builtin_amdgcn_mfma_f32_32x32x16_bf16(a2l, x, acc2, 0, 0, 0);
        const u32x4_t xu = __builtin_bit_cast(u32x4_t, x);
#pragma unroll
        for (int q = 0; q < 4; ++q) { const float lo = __uint_as_float(xu[q] << 16), hi = __uint_as_float(xu[q] & 0xffff0000u); ss += lo * lo + hi * hi; }
    }
    if (khalf == 1) {
#pragma unroll
        for (int r = 0; r < 16; ++r) xch[r * 64 + lane] = acc[r];
#pragma unroll
        for (int r = 0; r < 4; ++r) xch[(16 + r) * 64 + lane] = acc2[r];
        xch[20 * 64 + lane] = ss;
    }
    __syncthreads();
    if (khalf == 1) return;
#pragma unroll
    for (int r = 0; r < 16; ++r) acc[r] += xch[r * 64 + lane];
#pragma unroll
    for (int r = 0; r < 4; ++r) acc2[r] += xch[(16 + r) * 64 + lane];
    ss += xch[20 * 64 + lane];
    ss += __shfl_xor(ss, 32);
    const float rstd = rsqrtf(ss * (1.0f / D) + EPS);
    float gl[4] = {acc2[0] * rstd + bg[0], acc2[1] * rstd + bg[1], acc2[2] * rstd + bg[2], acc2[3] * rstd + bg[3]};
    int grp = 0; float gm = gl[0];
#pragma unroll
    for (int q = 1; q < 4; ++q) if (gl[q] > gm) { gm = gl[q]; grp = q; }
    float gs = 0.f;
#pragma unroll
    for (int q = 0; q < 4; ++q) gs += __expf(gl[q] - gm);
    const float gval = 1.0f / gs;
    { const int og = __shfl_xor(grp, 32); if (hh) grp = og; }
    float mine[4], oth[4];
#pragma unroll
    for (int q = 0; q < 4; ++q) { mine[q] = grp == 0 ? acc[q] : (grp == 1 ? acc[4 + q] : (grp == 2 ? acc[8 + q] : acc[12 + q])); oth[q] = __shfl_xor(mine[q], 32); }
    float fl[8];
#pragma unroll
    for (int q = 0; q < 4; ++q) { fl[q] = hh == 0 ? mine[q] : oth[q]; fl[4 + q] = hh == 0 ? oth[q] : mine[q]; }
#pragma unroll
    for (int q = 0; q < 8; ++q) fl[q] = fl[q] * rstd + bfine[grp * 8 + q];
    int i0 = 0; float v0 = fl[0];
#pragma unroll
    for (int q = 1; q < 8; ++q) if (fl[q] > v0) { v0 = fl[q]; i0 = q; }
    int i1 = -1; float v1 = -INFINITY;
#pragma unroll
    for (int q = 0; q < 8; ++q) if (q != i0 && fl[q] > v1) { v1 = fl[q]; i1 = q; }
    const float w0 = 1.0f / (1.0f + __expf(v1 - v0)), w1 = 1.0f - w0;
    const int e0 = hh == 0 ? grp * 8 + i0 : -1, e1 = hh == 0 ? grp * 8 + i1 : -1;
    const unsigned long long lt = (1ull << lane) - 1ull;
    unsigned r0 = 0, r1 = 0, mycnt = 0;
    for (int e = 0; e < NEXP; ++e) {
        const unsigned long long b0 = __ballot(e0 == e), b1 = __ballot(e1 == e);
        const unsigned n0 = __popcll(b0);
        if (e0 == e) r0 = __popcll(b0 & lt);
        if (e1 == e) r1 = n0 + __popcll(b1 & lt);
        if (lane == e) mycnt = n0 + __popcll(b1);
    }
    if (hh == 0) {
        toke[tok] = make_int2(e0, e1); tokg[tok] = make_float2(gval * w0, gval * w1); tokrs[tok] = rstd; tokrank[tok] = r0 | (r1 << 16);
        tilecnt[tile * 32 + lane] = mycnt;
    }
}
__device__ __forceinline__ void moe_plan_block(const unsigned* __restrict__ tilecnt, LAS int* sm, unsigned* pst_g, unsigned* ntl_g, int* texp_g) {
    const int t = threadIdx.x, e = t & 31, ch = t >> 5;
    LAS int* cs = sm; LAS int* cp = sm + 512; LAS int* pst = sm + 1024; LAS int* tb = sm + 1064;
    { int sacc = 0;
#pragma unroll 8
      for (int i = 0; i < 64; ++i) sacc += (int)tilecnt[(ch * 64 + i) * 32 + e];
      cs[ch * 32 + e] = sacc; }
    __syncthreads();
    if (t < 32) { int run = 0; for (int q = 0; q < 16; ++q) { cp[q * 32 + t] = run; run += cs[q * 32 + t]; } cs[t] = run;   }
    __syncthreads();
    if (t == 0) { int pacc = 0; for (int q = 0; q < NEXP; ++q) { pst[q] = pacc; const int pad = ((cs[q] + 255) >> 8) << 8;
            if (blockIdx.x == 0) { pst_g[q] = pacc; for (int tt = pacc >> 8; tt < (pacc + pad) >> 8; ++tt) texp_g[tt] = q; }
            pacc += pad; }
        pst[NEXP] = pacc; if (blockIdx.x == 0) { pst_g[NEXP] = pacc; ntl_g[0] = pacc >> 8; } }
    __syncthreads();
    if (t < 128) { const int q = t >> 5, tile = blockIdx.x * 4 + q; int base = pst[e] + cp[(tile >> 6) * 32 + e];
        for (int i = (tile >> 6) * 64; i < tile; ++i) base += (int)tilecnt[i * 32 + e];
        tb[q * 32 + e] = base; }
    __syncthreads();
}
__device__ __forceinline__ void moe_scatter_idx(int tok, const int2* toke, const float2* tokg, const float* tokrs, const unsigned* tokrank, LAS const int* tbq, int* rowtok, float* rowgate, float* rowscale, int2* pos) {
    const int2 e = toke[tok]; const unsigned rk = tokrank[tok];
    const int d0 = tbq[e.x] + (int)(rk & 0xffffu), d1 = tbq[e.y] + (int)(rk >> 16);
    const float2 g = tokg[tok]; const float rs = tokrs[tok];
    rowtok[d0] = tok; rowtok[d1] = tok; rowgate[d0] = g.x; rowgate[d1] = g.y; rowscale[d0] = rs; rowscale[d1] = rs; pos[tok] = make_int2(d0, d1);
}
__device__ __forceinline__ void d_moe_scatter_gather(int tok, int lane, const int2* toke, const float2* tokg, const unsigned* pst, unsigned* cur, float* rowgate, int2* pos, const bf16_t* __restrict__ xn, bf16_t* __restrict__ xs) {
    int2 e = toke[tok]; float2 g = tokg[tok];
    unsigned d0 = 0, d1 = 0;
    if (lane == 0) { d0 = pst[e.x] + atomicAdd(&cur[e.x], 1u); d1 = pst[e.y] + atomicAdd(&cur[e.y], 1u); rowgate[d0] = g.x; rowgate[d1] = g.y; pos[tok] = make_int2((int)d0, (int)d1); }
    d0 = __shfl(d0, 0); d1 = __shfl(d1, 0);
    const uint4* src = (const uint4*)(xn + (size_t)tok * D);
    uint4 a = src[lane], b = src[lane + 64];
    uint4* o0 = (uint4*)(xs + (size_t)d0 * D); uint4* o1 = (uint4*)(xs + (size_t)d1 * D);
    o0[lane] = a; o0[lane + 64] = b; o1[lane] = a; o1[lane + 64] = b;
}

__device__ __forceinline__ unsigned pk2(float lo, float hi) { return (unsigned)f2bf(lo) | ((unsigned)f2bf(hi) << 16); }
__device__ __forceinline__ void transpose_item(const float* __restrict__ W, int ldw, int k0, int c0, bf16_t* __restrict__ dlo  , bf16_t* __restrict__ dhi  , int K, LAS float* scr  , int lane, const float* __restrict__ kgain = nullptr  ) {
    float4 ga = make_float4(1.f, 1.f, 1.f, 1.f), gb = ga;
    if (kgain) { ga = *(const float4*)(kgain + k0 + 8 * (lane & 7)); gb = *(const float4*)(kgain + k0 + 8 * (lane & 7) + 4); }
#pragma unroll 8
    for (int i = 0; i < 32; ++i) { const int kk = 2 * i + (lane >> 5); const float2 v = *(const float2*)(W + (size_t)(k0 + kk) * ldw + c0 + 2 * (lane & 31)); scr[kk * 65 + 2 * (lane & 31)] = v.x; scr[kk * 65 + 2 * (lane & 31) + 1] = v.y; }
    asm volatile("s_waitcnt lgkmcnt(0)" ::: "memory");
    const int c = lane & 7;
#pragma unroll
    for (int j = 0; j < 8; ++j) { const int n = (lane >> 3) + 8 * j; const LAS float* s = scr + (8 * c) * 65 + n;
        uint4 o; o.x = cvtpk(s[0 * 65] * ga.x, s[1 * 65] * ga.y); o.y = cvtpk(s[2 * 65] * ga.z, s[3 * 65] * ga.w); o.z = cvtpk(s[4 * 65] * gb.x, s[5 * 65] * gb.y); o.w = cvtpk(s[6 * 65] * gb.z, s[7 * 65] * gb.w);
        *(uint4*)((j < 4 ? dlo + (size_t)n * K : dhi + (size_t)(n - 32) * K) + k0 + 8 * c) = o; }
    asm volatile("s_waitcnt lgkmcnt(0)" ::: "memory");
}
__device__ __forceinline__ void tr_inproj(int it, const float* W, bf16_t* WT, int layer, LAS float* scr, int lane, const float* kgain) {
    const int kb = it / 48, g2 = it % 48, pn = g2 >> 2, q2 = g2 & 3;
    const bool rotary = layer == 0 ? (pn < 4) : (pn < 8);
    const int glo = rotary ? pn * 8 + q2 : pn * 8 + 2 * q2, ghi = rotary ? glo + 4 : glo + 1;
    transpose_item(W, PW, 64 * kb, 256 * pn + 64 * q2, WT + (size_t)(32 * glo) * D, WT + (size_t)(32 * ghi) * D, D, scr, lane, kgain);
}
__device__ __forceinline__ void tr_outproj(int it, const float* W, bf16_t* WT, LAS float* scr, int lane) {
    const int kb = it / 16, g2 = it % 16;
    transpose_item(W, D, 64 * kb, 64 * g2, WT + (size_t)(64 * g2) * D, WT + (size_t)(64 * g2 + 32) * D, D, scr, lane);
}
__device__ __forceinline__ void tr_expert(int it, const float* wg, const float* wu, const float* wd, bf16_t* WE, LAS float* scr, int lane, const float* kgain) {
    const int e = it / 384, r = it % 384;
    bf16_t* base = WE + (size_t)e * WEXP_E;
    if (r < 256) { const int kb = r / 16, p2 = r % 16, pn = p2 >> 2, bj = (p2 >> 1) & 1, wcp = p2 & 1, g = pn * 8 + bj * 4 + 2 * wcp;
        const float* W = (bj ? wu : wg) + (size_t)e * D * HID;
        transpose_item(W, HID, 64 * kb, 128 * pn + 64 * wcp, base + (size_t)(32 * g) * D, base + (size_t)(32 * g + 32) * D, D, scr, lane, kgain);
    } else { const int r2 = r - 256, kb = r2 / 16, g2 = r2 % 16;
        transpose_item(wd + (size_t)e * HID * D, D, 64 * kb, 64 * g2, base + (size_t)D * D + (size_t)(64 * g2) * HID, base + (size_t)D * D + (size_t)(64 * g2 + 32) * HID, HID, scr, lane); }
}

struct Params {
    const float *x, *mix_norm_even, *w_in_even, *w_out_even, *mix_norm_odd, *w_in_odd, *w_out_odd, *ffn_norm, *w_rg, *b_rg, *w_re, *b_re, *w_eg, *w_eu, *w_ed, *final_norm;
    float* hbuf; unsigned char* ws;
};
#define FOR_VB(n) for (int vb = blockIdx.x; vb < (int)(n); vb += gridDim.x)
constexpr int LDS_BYTES = 147456;

__device__ __forceinline__ void inproj_steps(PG8_LAS unsigned char* lds, const float2* rot, const float2* ret, int wave, int lane) {
    PG8_LAS pg8::f32x4* sl = (PG8_LAS pg8::f32x4*)(lds + pg8::STAGE_BYTES + wave * 2016);
    if (lane < 32) { const int which = lane >> 4, fq = (lane >> 2) & 3, q = lane & 3; sl[lane] = ((const pg8::f32x4*)rot)[(size_t)((((which ? 5 : 1) * 4 + fq) * 4 + q) * 16)]; }
    else if (lane < 48) { const int l = lane - 32, which = l >> 3, fq = (l >> 1) & 3, q = l & 1; sl[lane] = ((const pg8::f32x4*)ret)[(size_t)(((((which ? 5 : 1) * 2 + (wave & 1)) * 4 + fq) * 2 + q) * 16)]; }
    __syncthreads();
}
template <class Epi>
__device__ __forceinline__ void run_gemm(PG8_LAS unsigned char* lds, const bf16_t* A, const bf16_t* Bt, int M, int N, int K, const Epi& E) {
    pg8::Gemm g{A, Bt, M, N, K}; pg8::StaticOrder S_; S_.init(M, N, (int)gridDim.x, (int)blockIdx.x);
    pg8::gemm_phase<Epi, pg8::StaticOrder, true, true>(lds, g, S_, E);
}

#define XB_TMO      128
#define XB_XCNT(j)  (256  + 64 * (j))
#define XB_XSUB(j)  (1280 + 64 * (j))
#define XB_XGEN(j)  (2304 + 64 * (j))
#define XB_TOP      3328
#define XB_TOPGEN   3392
#define XCD_BAR_WORDS 3456
#define XB_SPIN_CAP (1u << 18)

__device__ __forceinline__ unsigned xb_ld(unsigned* p)              { return __hip_atomic_load(p, __ATOMIC_RELAXED, __HIP_MEMORY_SCOPE_AGENT); }
__device__ __forceinline__ unsigned xb_add(unsigned* p, unsigned v) { return __hip_atomic_fetch_add(p, v, __ATOMIC_RELAXED, __HIP_MEMORY_SCOPE_AGENT); }
__device__ __forceinline__ unsigned xb_xcc_id() { return (unsigned)__builtin_amdgcn_s_getreg((3 << 11) | 20) & 0xFu; }
#define XB_SPIN(cond, bar) do { unsigned _sp = 0; while (cond) { __builtin_amdgcn_s_sleep(1); \
    if ((++_sp & 255u) == 0u) { if (xb_ld(&(bar)[XB_TMO])) break; if (_sp > XB_SPIN_CAP) { atomicAdd(&(bar)[XB_TMO], 1u); break; } } } } while (0)

struct XcdBarrier {
    unsigned* bar; unsigned x;
    volatile LAS unsigned* st;
};

__device__ __forceinline__ XcdBarrier xcd_barrier_post(unsigned* bar, volatile LAS unsigned* st) {
    XcdBarrier b; b.bar = bar; b.x = xb_xcc_id(); b.st = st;
    if (threadIdx.x == 0) (void)xb_add(&bar[XB_XCNT(b.x)], 1u);
    return b;
}
__device__ __forceinline__ void xcd_barrier_complete(unsigned* bar, unsigned x, unsigned& nloc, unsigned& nx) {
    const unsigned G = gridDim.x * gridDim.y * gridDim.z;
    unsigned sum, cnt, mine, sp = 0u;
    for (;;) {
        sum = 0u; cnt = 0u; mine = 0u;
#pragma unroll
        for (unsigned j = 0; j < 16; ++j) { const unsigned c = xb_ld(&bar[XB_XCNT(j)]); sum += c; cnt += (c > 0u) ? 1u : 0u; mine = (j == x) ? c : mine; }
        if (sum == G) break;
        __builtin_amdgcn_s_sleep(1);
        if ((++sp & 255u) == 0u) { if (xb_ld(&bar[XB_TMO])) break; if (sp > XB_SPIN_CAP) { atomicAdd(&bar[XB_TMO], 1u); break; } }
    }
    nloc = mine > 0u ? mine : 1u; nx = cnt > 0u ? cnt : 1u;
}

__device__ __forceinline__ void xcd_barrier(const XcdBarrier& b) {
    asm volatile("s_waitcnt vmcnt(0)" ::: "memory");
    __syncthreads();
    if (threadIdx.x == 0) {
        unsigned* bar = b.bar;
        __builtin_amdgcn_s_waitcnt(0);
        unsigned nloc = b.st[0], nx = b.st[1];
        if (nloc == 0u) { xcd_barrier_complete(bar, b.x, nloc, nx); b.st[0] = nloc; b.st[1] = nx; }
        const unsigned old = xb_add(&bar[XB_XSUB(b.x)], 1u);
        const unsigned gen = old / nloc;
        if (old + 1u == (gen + 1u) * nloc) {
            __builtin_amdgcn_fence(__ATOMIC_RELEASE, "agent");
            asm volatile("s_waitcnt vmcnt(0)" ::: "memory");
            const unsigned og = xb_add(&bar[XB_TOP], 1u);
            const unsigned tg = og / nx;
            if (og + 1u == (tg + 1u) * nx) xb_add(&bar[XB_TOPGEN], 1u);
            else XB_SPIN(xb_ld(&bar[XB_TOPGEN]) == tg, bar);
            __builtin_amdgcn_fence(__ATOMIC_ACQUIRE, "agent");
            xb_add(&bar[XB_XGEN(b.x)], 1u);
            asm volatile("s_waitcnt vmcnt(0)" ::: "memory");
        } else {
            XB_SPIN(xb_ld(&bar[XB_XGEN(b.x)]) == gen, bar);
            __builtin_amdgcn_fence(__ATOMIC_ACQUIRE, "agent");
            asm volatile("s_waitcnt vmcnt(0)" ::: "memory");
        }
    }
    __syncthreads();
}


#ifndef PROBE_MASK
#define PROBE_MASK 0
#endif
__device__ __forceinline__ void probe_end(int gid, unsigned long long& t0) {
    const unsigned long long t1 = __builtin_amdgcn_s_memrealtime();
    if ((PROBE_MASK >> gid) & 1) { const unsigned long long tend = t1 + (t1 - t0); while (__builtin_amdgcn_s_memrealtime() < tend) __builtin_amdgcn_s_sleep(8); }
    t0 = __builtin_amdgcn_s_memrealtime();
}
#define GSYNC(gid) do { xcd_barrier(xbar); if (PROBE_MASK) probe_end(gid, pt0); } while (0)
__device__ __forceinline__ void moe_phases(const Params& p, const XcdBarrier& xbar, PG8_LAS unsigned char* lds, int layer, unsigned long long& pt0) {
    unsigned char* ws = p.ws; unsigned* ctl = (unsigned*)(ws + WS_CTL);
    unsigned* pst = ctl + CW_PST + 40 * layer;
    unsigned* ntl = ctl + CW_NT + layer; int* texp = (int*)(ctl + CW_TEXP + 320 * layer);
    float* rowgate = (float*)(ctl + CW_ROWGATE + layer * MP_MAX);
    int2* toke = (int2*)(ws + WS_TOKE); float2* tokg = (float2*)(ws + WS_TOKG); int2* pos = (int2*)(ws + WS_POS);
    bf16_t* xn = (bf16_t*)(ws + WS_XN); bf16_t* big = (bf16_t*)(ws + WS_BIG); bf16_t* hs = (bf16_t*)(ws + WS_HS);
    const bf16_t* wexp = (const bf16_t*)(ws + WS_WEXP);
    const int lane = my_lane(), wave = __builtin_amdgcn_readfirstlane(threadIdx.x >> 6);
    float* rowscale = (float*)(ctl + CW_ROWSCALE + layer * MP_MAX); float* tokrs = (float*)(ws + WS_TOKRS);
    unsigned* tokrank = (unsigned*)(ws + WS_TOKRANK); unsigned* tilecnt = (unsigned*)(ws + WS_TILECNT);
    int* rowtok = (int*)(ctl + CW_ROWTOK + layer * MP_MAX);
    for (int t0 = blockIdx.x * 4; t0 < NTOK / 32; t0 += gridDim.x * 4) {
        router_tile(t0 + (wave & 3), wave >> 2, (const bf16_t*)(ws + WS_XN2), (const bf16x8*)(ws + WS_WR) + layer * 64 * 64, (const bf16x8*)(ws + WS_WR2) + layer * 64 * 64, p.b_rg + layer * 4, p.b_re + layer * 32,
                    toke, tokg, tokrs, tokrank, tilecnt, (LAS float*)lds + (wave & 3) * (21 * 64), lane, 0);
        __syncthreads(); }
    GSYNC(7);
    { LAS int* sm = (LAS int*)lds;
      moe_plan_block(tilecnt, sm, pst, ntl, texp);
      if (threadIdx.x < 128) { const int q = threadIdx.x >> 5, tok = (blockIdx.x * 4 + q) * 32 + (threadIdx.x & 31);
          moe_scatter_idx(tok, toke, tokg, tokrs, tokrank, sm + 1064 + q * 32, rowtok, rowgate, rowscale, pos); } }
    GSYNC(9);
    const int mp = (int)ntl[0] * 256;
    { pg8::Gemm g{(const bf16_t*)(ws + WS_XN2), wexp, mp, 1024, D, rowtok}; pg8::MoeOrder S_; S_.init(mp, 1024, (int)gridDim.x, (int)blockIdx.x); S_.texp = texp; S_.estride_bytes = WEXP_E * 2;
      pg8::EpiMoe1F E{hs, rowscale};
      pg8::gemm_phase<pg8::EpiMoe1F, pg8::MoeOrder, true, true, true>(lds, g, S_, E); }
    GSYNC(10);
    { pg8::Gemm g{hs, wexp + (size_t)D * D, mp, D, HID}; pg8::MoeOrder S_; S_.init(mp, D, (int)gridDim.x, (int)blockIdx.x); S_.texp = texp; S_.estride_bytes = WEXP_E * 2;
      pg8::EpiMoe2F E{big, rowgate};
      pg8::gemm_phase<pg8::EpiMoe2F, pg8::MoeOrder, true, true>(lds, g, S_, E); }
    GSYNC(11);
}

__global__ void __launch_bounds__(NTH, 2) mega(Params p) {
    extern __shared__ __attribute__((aligned(16))) unsigned char lds_raw[];
    PG8_LAS unsigned char* lds = (PG8_LAS unsigned char*)lds_raw;
    cg::grid_group grid = cg::this_grid();
    { volatile LAS unsigned* stw = (volatile LAS unsigned*)(lds + LDS_BYTES - 256); if (threadIdx.x < 2) stw[threadIdx.x] = 0u; }
    __syncthreads();
    const XcdBarrier xbar = xcd_barrier_post((unsigned*)(p.ws + WS_CTL) + CW_BAR, (volatile LAS unsigned*)(lds + LDS_BYTES - 256));
    unsigned long long pt0 = PROBE_MASK ? __builtin_amdgcn_s_memrealtime() : 0ull;
    unsigned char* ws = p.ws;
    float2* rot = (float2*)(ws + WS_ROT); float2* ret = (float2*)(ws + WS_RET);
    float* kmean = (float*)(ws + WS_KMEAN);
    int2* pos = (int2*)(ws + WS_POS);
    float* rstate = (float*)(ws + WS_RSTATE); float* rprev = (float*)(ws + WS_RPREV);
    bf16_t* xn = (bf16_t*)(ws + WS_XN); bf16_t* ao = (bf16_t*)(ws + WS_AO); bf16_t* big = (bf16_t*)(ws + WS_BIG);
    bf16_t* win0 = (bf16_t*)(ws + WS_WIN0); bf16_t* wout0 = (bf16_t*)(ws + WS_WOUT0); bf16_t* win1 = (bf16_t*)(ws + WS_WIN1); bf16_t* wout1 = (bf16_t*)(ws + WS_WOUT1);
    bf16_t* wexp = (bf16_t*)(ws + WS_WEXP);
    float* hbuf = p.hbuf;
    const int wave = __builtin_amdgcn_readfirstlane(threadIdx.x >> 6);
    const int gw = blockIdx.x * NWAVES + wave, NGW = gridDim.x * NWAVES;
    const int lane = my_lane();
    LAS float* scr = (LAS float*)(lds + wave * 16640);

    { unsigned* ctlz = (unsigned*)(ws + WS_CTL);
      for (int i = blockIdx.x * NTH + wave * 64 + lane; i < (int)(CTL_BYTES / 4); i += gridDim.x * NTH) if (i < CW_BAR || i >= CW_BAR + 3584) ctlz[i] = 0u; }
    FOR_VB(S * 32 / NTH) d_tables(vb, rot, ret);
    for (int it = gw; it < 768 + 256 + 768 + 256 + 12288; it += NGW) {
        int r = it;
        if (r < 768) { tr_inproj(r, p.w_in_even, win0, 0, scr, lane, p.mix_norm_even); continue; } r -= 768;
        if (r < 256) { tr_outproj(r, p.w_out_even, wout0, scr, lane); continue; } r -= 256;
        if (r < 768) { tr_inproj(r, p.w_in_odd, win1, 1, scr, lane, p.mix_norm_odd); continue; } r -= 768;
        if (r < 256) { tr_outproj(r, p.w_out_odd, wout1, scr, lane); continue; } r -= 256;
        tr_expert(r, p.w_eg, p.w_eu, p.w_ed, wexp, scr, lane, p.ffn_norm);
    }
    rows_pipeline<0>(p.x, nullptr, nullptr, nullptr, p.mix_norm_even, (bf16_t*)(ws + WS_X16), wave, lane, (float*)(ws + WS_RSTD));
    for (int i = blockIdx.x * NTH + (int)threadIdx.x; i < 2 * 64 * 64; i += gridDim.x * NTH) {
        const int ln = i & 63, ks = (i >> 6) & 63, layer = i >> 12, k0 = 16 * ks + 8 * (ln >> 5), col = ln & 31;
        const float* gn = p.ffn_norm + layer * D + k0; const float* w = p.w_re + ((size_t)layer * D + k0) * 32 + col; const float* w2 = p.w_rg + ((size_t)layer * D + k0) * 4 + (col & 3);
        unsigned fh[4], fl[4], gh[4], gl2[4];
#pragma unroll
        for (int q = 0; q < 4; ++q) {
            const float a0 = gn[2 * q] * w[(2 * q) * 32], a1 = gn[2 * q + 1] * w[(2 * q + 1) * 32];
            const float b0 = col < 4 ? gn[2 * q] * w2[(2 * q) * 4] : 0.f, b1 = col < 4 ? gn[2 * q + 1] * w2[(2 * q + 1) * 4] : 0.f;
            const unsigned ah0 = f2bf(a0), ah1 = f2bf(a1), bh0 = f2bf(b0), bh1 = f2bf(b1);
            fh[q] = ah0 | (ah1 << 16); fl[q] = (unsigned)f2bf(a0 - __uint_as_float(ah0 << 16)) | ((unsigned)f2bf(a1 - __uint_as_float(ah1 << 16)) << 16);
            gh[q] = bh0 | (bh1 << 16); gl2[q] = (unsigned)f2bf(b0 - __uint_as_float(bh0 << 16)) | ((unsigned)f2bf(b1 - __uint_as_float(bh1 << 16)) << 16);
        }
        uint4* t1 = (uint4*)(ws + WS_WR); uint4* t2 = (uint4*)(ws + WS_WR2);
        t1[i] = make_uint4(fh[0], fh[1], fh[2], fh[3]); t1[i + 2 * 64 * 64] = make_uint4(fl[0], fl[1], fl[2], fl[3]);
        t2[i] = make_uint4(gh[0], gh[1], gh[2], gh[3]); t2[i + 2 * 64 * 64] = make_uint4(gl2[0], gl2[1], gl2[2], gl2[3]);
    }
    if (p.ws == nullptr) grid.sync();
    GSYNC(0);
    { inproj_steps(lds, rot, ret, wave, my_lane()); pg8::EpiInprojF E{big, rot, ret, (const float*)(ws + WS_RSTD), 0, 0}; run_gemm(lds, (const bf16_t*)(ws + WS_X16), win0, NTOK, PW, D, E); }
    GSYNC(1);
    { const int lk = my_lane(); for (int item = blockIdx.x + gridDim.x * wave; item < NB * 8 * 64; item += gridDim.x * NWAVES) kmean_item(item, big, kmean, (LAS float*)(lds + wave * 8192), lk); __syncthreads(); }
    { const int lane2 = my_lane(); for (int it = blockIdx.x; it < NB * 4 * 128; it += gridDim.x) ret_state_item(it, big, rstate, (LAS char*)lds, wave, lane2); }
    GSYNC(2);
    unsigned* lcnt = (unsigned*)(ws + WS_CTL) + CW_LCNT;
    bf16_t* mpo = (bf16_t*)((unsigned char*)hbuf + HB_MPO); float* mpl = (float*)((unsigned char*)hbuf + HB_MPL); unsigned short* mlist = (unsigned short*)((unsigned char*)hbuf + HB_MLIST);
    if (threadIdx.x < 256) { for (int i = blockIdx.x * 256 + (int)threadIdx.x; i < NB * 4 * 8192; i += gridDim.x * 256) ret_scan_thread(i, rstate, (bf16_t*)rprev); }
    FOR_VB(NB * 8 * S / NTH) { const int rng = vb & 31, vb2 = (vb & ~31) | (((vb >> 8) & 1) ? 31 - rng : rng);
        d_moba_route(vb2, big, kmean, lcnt, mlist, mpl, (LAS unsigned*)lds); }
    GSYNC(3);
    { const int lane2 = my_lane(); LAS char* vl = (LAS char*)(lds + 65536 + wave * (32 * VP_R)); for (int it = gw; it < NB * 4 * 128 * 4; it += NGW) ret_out_item(it, big, (const bf16_t*)rprev, ao, vl, lane2); }
    {
      LAS int* pre = (LAS int*)(lds + 136192);
      { const int t = threadIdx.x; const int c0 = ((int)lcnt[2 * t] + 31) >> 5, c1 = ((int)lcnt[2 * t + 1] + 31) >> 5;
        LAS int* sc = (LAS int*)(lds + 141312);
        sc[t] = c0 + c1; __syncthreads();
        for (int o = 1; o < NTH; o <<= 1) { const int v = t >= o ? sc[t - o] : 0; __syncthreads(); sc[t] += v; __syncthreads(); }
        const int ex = sc[t] - (c0 + c1); pre[2 * t] = ex; pre[2 * t + 1] = ex + c0; if (t == NTH - 1) pre[1024] = sc[t];
        __syncthreads(); }
      const int lane2 = my_lane(), c = lane2 & 31, hh = lane2 >> 5; LAS char* vl = (LAS char*)(lds + wave * ENG_LDS_PER_WAVE);
      const int total = pre[1024];
      for (int ch = gw; ch < total; ch += NGW) {
          int l = 0;
#pragma unroll
          for (int st = 512; st > 0; st >>= 1) if (pre[l + st] <= ch) l += st;
          const int bh = l >> 6, n = l & 63, b = bh >> 3, h = bh & 7, idx = (ch - pre[l]) * 32 + c, cntl = (int)lcnt[l];
          const bool valid = idx < cntl;
          const unsigned ent = mlist[list_off(bh, n) + (valid ? idx : 0)];
          const int pos = ent & 16383, k = ent >> 14;
          const size_t rowb = (size_t)b * S, tok = rowb + pos;
          const bf16_t* qrow = big + L0_AQ + hm(b, 8, h, pos, 64) + 8 * hh;
          bf16x8 qf[4];
#pragma unroll
          for (int i = 0; i < 4; ++i) qf[i] = *(const bf16x8*)(qrow + 16 * i);
          AttnAcc a; acc_init64(a);
          const bf16_t* Kb = big + L0_AK + hm(b, 8, h, n * 256, 64) + lane2 * 8;
          const bf16_t* Vb = big + L0_AV + hm(b, 8, h, n * 256, 64) + lane2 * 8;
          auto kp = [&](int st, int sub) { return Kb + (size_t)(2 * st + sub) * 2048; };
          auto vp = [&](int st, int sub) { return Vb + (size_t)(2 * st + sub) * 2048; };
          auto mk = [&](int, int& m0, int& m1) { m0 = 0; m1 = 0; };
          attn_run64<512, 512>(a, qf, 0, 4, kp, vp, mk, vl, lane2);
          float inv, lse; attn_finish64(a, inv, lse);
          if (valid) { const size_t pi = (tok * 8 + h) * 3 + k; store_o_frag(mpo + pi * 64, a.o0, a.o1, inv, hh); if (hh == 0) mpl[pi] = lse; }
      } }
    GSYNC(4);
    {
      const int lane2 = my_lane(), c = lane2 & 31, hh = lane2 >> 5; LAS char* vl = (LAS char*)(lds + wave * ENG_LDS_PER_WAVE);
      for (int it = gw; it < NB * 8 * 512; it += NGW) {
          const int bh = it >> 9, qb = (it >> 3) & 63, j8 = ((bh >> 2) & 1) ? 7 - (it & 7) : (it & 7), b = bh >> 3, h = bh & 7;
          const size_t rowb = (size_t)b * S, tok = rowb + qb * 256 + j8 * 32 + c;
          const bf16_t* qrow = big + L0_AQ + hm(b, 8, h, qb * 256 + j8 * 32 + c, 64) + 8 * hh;
          bf16x8 qf[4];
#pragma unroll
          for (int i = 0; i < 4; ++i) qf[i] = *(const bf16x8*)(qrow + 16 * i);
          AttnAcc a; acc_init64(a);
          const bf16_t* Kb = big + L0_AK + hm(b, 8, h, qb * 256, 64) + lane2 * 8;
          const bf16_t* Vb = big + L0_AV + hm(b, 8, h, qb * 256, 64) + lane2 * 8;
          auto kp = [&](int st, int sub) { return Kb + (size_t)(2 * st + sub) * 2048; };
          auto vp = [&](int st, int sub) { return Vb + (size_t)(2 * st + sub) * 2048; };
          auto mk = [&](int st, int& m0, int& m1) { const int ta = 2 * st, tb = 2 * st + 1; m0 = ta == j8 ? 2 : 0; m1 = tb == j8 ? 2 : (tb > j8 ? 3 : 0); };
          attn_run64<512, 512>(a, qf, 0, (j8 >> 1) + 1, kp, vp, mk, vl, lane2);
          float inv, lse0; attn_finish64(a, inv, lse0);
          const size_t pi = (tok * 8 + h) * 3;
          const float l1 = mpl[pi], l2 = mpl[pi + 1], l3 = mpl[pi + 2], mxl = fmaxf(fmaxf(lse0, l1), fmaxf(l2, l3));
          const float w0 = __expf(lse0 - mxl), w1 = __expf(l1 - mxl), w2 = __expf(l2 - mxl), w3 = __expf(l3 - mxl), iw = 1.0f / (w0 + w1 + w2 + w3);
          const float s0 = w0 * inv;
#pragma unroll
          for (int q = 0; q < 16; ++q) { a.o0[q] *= s0; a.o1[q] *= s0; }
          { u32x4_t pf[4];
            if (w1 > 0.f) { load_frag(pf, mpo + pi * 64, hh); fma_frag(a.o0, a.o1, pf, w1); }
            if (w2 > 0.f) { load_frag(pf, mpo + (pi + 1) * 64, hh); fma_frag(a.o0, a.o1, pf, w2); }
            if (w3 > 0.f) { load_frag(pf, mpo + (pi + 2) * 64, hh); fma_frag(a.o0, a.o1, pf, w3); } }
          store_o(ao + tok * D + h * 64, a.o0, a.o1, iw, hh);
      } }
    GSYNC(5);
    { pg8::EpiOutprojF<true> E{(const bf16_t*)(ws + WS_X16), (bf16_t*)(ws + WS_XN2)}; run_gemm(lds, ao, wout0, NTOK, D, D, E); }
    GSYNC(6);
    moe_phases(p, xbar, lds, 0, pt0);
    { const int lane3 = my_lane(); rows_pipeline16<1>((const bf16_t*)(ws + WS_XN2), big, pos, p.mix_norm_odd, (bf16_t*)((unsigned char*)hbuf + HB_H16), (float*)(ws + WS_RSTD), nullptr, wave, lane3); }
    { const int lane2 = my_lane(); LAS float* scr2 = (LAS float*)(lds + __builtin_amdgcn_readfirstlane(threadIdx.x >> 6) * 16640);
      for (int it = gw; it < 12288; it += NGW) tr_expert(it, p.w_eg + (size_t)NEXP * D * HID, p.w_eu + (size_t)NEXP * D * HID, p.w_ed + (size_t)NEXP * HID * D, wexp, scr2, lane2, p.ffn_norm + D); }
    GSYNC(12);
    { inproj_steps(lds, rot, ret, wave, my_lane()); pg8::EpiInprojF E{big, rot, ret, (const float*)(ws + WS_RSTD), 1, 0}; run_gemm(lds, (const bf16_t*)((unsigned char*)hbuf + HB_H16), win1, NTOK, PW, D, E); }
    GSYNC(1);
    { const int lane2 = my_lane(); dilated_coop<false>(big, (bf16_t*)(ws + WS_DPO), (float*)(ws + WS_DPL), ao, (LAS char*)lds, wave, lane2); }
    GSYNC(13);
    { const int lane2 = my_lane(); dilated_coop<true>(big, (bf16_t*)(ws + WS_DPO), (float*)(ws + WS_DPL), ao, (LAS char*)lds, wave, lane2); }
    GSYNC(14);
    { pg8::EpiOutprojF<true> E{(const bf16_t*)((unsigned char*)hbuf + HB_H16), (bf16_t*)(ws + WS_XN2)}; run_gemm(lds, ao, wout1, NTOK, D, D, E); }
    GSYNC(6);
    moe_phases(p, xbar, lds, 1, pt0);
    { const int lane3 = my_lane(); rows_pipeline16<2>((const bf16_t*)(ws + WS_XN2), big, pos, p.final_norm, nullptr, nullptr, hbuf, wave, lane3); }
}

extern "C" void kernel_launch(void* const* d_in, const int* in_sizes, int n_in, void* d_out, int out_size, void* d_ws, size_t ws_size, hipStream_t stream) {
    if (n_in != 16 || ws_size < WS_END || out_size != NTOK * D) { fprintf(stderr, "kernel_launch: unexpected sizes n_in %d ws %zu out %d\n", n_in, ws_size, out_size); return; }
    static int grid_blocks = 0;
    if (!grid_blocks) {
        int dev = 0, cus = 0, per_cu = 0;
        (void)hipGetDevice(&dev);
        (void)hipDeviceGetAttribute(&cus, hipDeviceAttributeMultiprocessorCount, dev);
        (void)hipFuncSetAttribute((const void*)mega, hipFuncAttributeMaxDynamicSharedMemorySize, LDS_BYTES);
        (void)hipOccupancyMaxActiveBlocksPerMultiprocessor(&per_cu, mega, NTH, LDS_BYTES);
        if (per_cu < 1) per_cu = 1;
        grid_blocks = cus * per_cu;
        fprintf(stderr, "kernel_launch: cus %d per_cu %d grid %d\n", cus, per_cu, grid_blocks);
    }
    Params p{};
    const float** pp = (const float**)&p;
    for (int i = 0; i < 16; ++i) pp[i] = (const float*)d_in[i];
    p.hbuf = (float*)d_out; p.ws = (unsigned char*)d_ws;
    (void)hipMemsetAsync((unsigned char*)d_ws + WS_CTL + (size_t)CW_BAR * 4, 0, 3584 * 4, stream);
    void* args[] = {&p};
    hipError_t e = hipLaunchCooperativeKernel((void*)mega, dim3(grid_blocks), dim3(NTH), args, LDS_BYTES, stream);
    if (e != hipSuccess) fprintf(stderr, "cooperative launch failed: %s (grid %d)\n", hipGetErrorString(e), grid_blocks);
}
```
